# Optimizing an MI355X kernel written in HIP

```python
import math
import jax, jax.numpy as jnp
from jax import lax
import numpy as np

D_MODEL = 1024
BATCH = 8
SEQ = 4096
DEPTH = 4

CHUNK = 64
Q_BLOCK = 128
SPARSE_Q_BLOCK = 64
TOKEN_BLOCK = 128

D_MIX = D_MODEL
DIFF_WIDTH = D_MIX // 2
DSA_WIDTH = D_MIX - DIFF_WIDTH
DIFF_HEAD_DIM = 64
DIFF_V_DIM = 2 * DIFF_HEAD_DIM
DIFF_HEADS = DIFF_WIDTH // DIFF_V_DIM
DSA_HEAD_DIM = 64
DSA_HEADS = DSA_WIDTH // DSA_HEAD_DIM
IDX_HEADS = 4
IDX_DIM = 64
IDX_TOPK_MAX = 256

DIFF_QK_COLS = DIFF_HEADS * 2 * DIFF_HEAD_DIM
DIFF_V_COLS = DIFF_HEADS * DIFF_V_DIM
DSA_COLS = DSA_HEADS * DSA_HEAD_DIM
IDX_Q_COLS = IDX_HEADS * IDX_DIM
IN_WIDTHS = (DIFF_QK_COLS, DIFF_QK_COLS, DIFF_V_COLS, DSA_COLS, DSA_COLS, DSA_COLS, IDX_Q_COLS, IDX_DIM, IDX_HEADS)
V_SEGMENTS = (2, 5)
IN_COLS = sum(IN_WIDTHS)

PEER_HEADS = 8
PEER_N_KEYS = 128
PEER_N_EXPERTS = PEER_N_KEYS * PEER_N_KEYS
PEER_QUERY_DIM = 256
PEER_HALF_DIM = PEER_QUERY_DIM // 2
PEER_TOPK = 16

PLE_DIM = 256

LN_EPS = 1e-5
DEEPNORM_ALPHA = (2 * DEPTH) ** 0.25
DEEPNORM_BETA = (8 * DEPTH) ** -0.25
NEG_INF = -1e30

kernel_name = "hybrid_diffattn_dsa_peer_deepnorm"


def layer_norm(x, g, b):
    xf = x.astype(jnp.float32)
    mu = jnp.mean(xf, axis=-1, keepdims=True)
    xc = xf - mu
    var = jnp.mean(xc * xc, axis=-1, keepdims=True)
    y = xc * lax.rsqrt(var + LN_EPS) * g.astype(jnp.float32) + b.astype(jnp.float32)
    return y.astype(x.dtype)


def rms_norm(x, g):
    xf = x.astype(jnp.float32)
    y = xf * lax.rsqrt(jnp.mean(xf * xf, axis=-1, keepdims=True) + LN_EPS)
    return y * g.astype(jnp.float32)


def alibi_slopes(n):
    return 2.0 ** (-8.0 * jnp.arange(1, n + 1, dtype=jnp.float32) / n)


def chunk_end(t):
    return (t // CHUNK + 1) * CHUNK


def diff_attention(q, k, v, lam, slopes):
    B, S, H = q.shape[:3]
    nb = S // Q_BLOCK
    scale = DIFF_HEAD_DIM ** -0.5
    kf = k.astype(jnp.float32)
    vf = v.astype(jnp.float32)
    key_pos = jnp.arange(S)
    q_blocks = jnp.moveaxis(q.reshape(B, nb, Q_BLOCK, H, 2, DIFF_HEAD_DIM), 1, 0)

    def block(args):
        qb, bi = args
        t = bi * Q_BLOCK + jnp.arange(Q_BLOCK)
        visible = key_pos[None, :] < chunk_end(t)[:, None]
        bias = -slopes[:, None, None] * jnp.abs(t[:, None] - key_pos[None, :]).astype(jnp.float32)
        s = jnp.einsum('bqhmd,bkhmd->bmhqk', qb.astype(jnp.float32), kf) * scale + bias
        s = jnp.where(visible, s, NEG_INF)
        a = jax.nn.softmax(s, axis=-1)
        w = a[:, 0] - lam * a[:, 1]
        return jnp.einsum('bhqk,bkhe->bqhe', w, vf)

    out = lax.map(block, (q_blocks, jnp.arange(nb)))
    return jnp.moveaxis(out, 0, 1).reshape(B, S, H, DIFF_V_DIM)


def indexed_sparse_attention(q, k, v, qi, ki, wi, slopes, topk):
    B, S, H, d = q.shape
    nb = S // SPARSE_Q_BLOCK
    scale = DSA_HEAD_DIM ** -0.5
    kf = k.astype(jnp.float32)
    vf = v.astype(jnp.float32)
    kif = ki.astype(jnp.float32)
    key_pos = jnp.arange(S)

    def to_blocks(a):
        return jnp.moveaxis(a.reshape((B, nb, SPARSE_Q_BLOCK) + a.shape[2:]), 1, 0)

    def block(args):
        qb, qib, wib, bi = args
        t = bi * SPARSE_Q_BLOCK + jnp.arange(SPARSE_Q_BLOCK)
        end = chunk_end(t)
        visible = key_pos[None, :] < end[:, None]
        dots = jax.nn.relu(jnp.einsum('bqjd,bsd->bqjs', qib.astype(jnp.float32), kif))
        iscore = jnp.einsum('bqj,bqjs->bqs', wib.astype(jnp.float32), dots)
        iscore = jnp.where(visible[None], iscore, NEG_INF)
        _, sel = lax.top_k(iscore, topk)
        valid = sel < end[None, :, None]
        kg = jax.vmap(lambda kk, ii: kk[ii])(kf, sel)
        vg = jax.vmap(lambda vv, ii: vv[ii])(vf, sel)
        s = jnp.einsum('bqhd,bqkhd->bhqk', qb.astype(jnp.float32), kg) * scale
        dist = jnp.abs(t[None, :, None] - sel).astype(jnp.float32)
        s = s - slopes[None, :, None, None] * dist[:, None]
        s = jnp.where(valid[:, None], s, NEG_INF)
        a = jax.nn.softmax(s, axis=-1)
        return jnp.einsum('bhqk,bqkhd->bqhd', a, vg)

    out = lax.map(block, (to_blocks(q), to_blocks(qi), to_blocks(wi), jnp.arange(nb)))
    return jnp.moveaxis(out, 0, 1).reshape(B, S, H, d)


def token_mixers(h, w_in, w_out, lam_vecs, subln_g, lam_init):
    B, S, _ = h.shape
    proj = h @ w_in
    split_points = np.cumsum(IN_WIDTHS)[:-1].tolist()
    dq, dk, dv, sq, sk, sv, iq, ik, iw = jnp.split(proj, split_points, axis=-1)

    lv = lam_vecs.astype(jnp.float32)
    lam = jnp.exp(jnp.sum(lv[0] * lv[1])) - jnp.exp(jnp.sum(lv[2] * lv[3])) + lam_init
    dq = dq.reshape(B, S, DIFF_HEADS, 2, DIFF_HEAD_DIM)
    dk = dk.reshape(B, S, DIFF_HEADS, 2, DIFF_HEAD_DIM)
    dv = dv.reshape(B, S, DIFF_HEADS, DIFF_V_DIM)
    a_out = diff_attention(dq, dk, dv, lam, alibi_slopes(DIFF_HEADS))
    a_out = rms_norm(a_out, subln_g) * (1.0 - lam_init)

    topk = min(IDX_TOPK_MAX, S // 4)
    sq = sq.reshape(B, S, DSA_HEADS, DSA_HEAD_DIM)
    sk = sk.reshape(B, S, DSA_HEADS, DSA_HEAD_DIM)
    sv = sv.reshape(B, S, DSA_HEADS, DSA_HEAD_DIM)
    iq = iq.reshape(B, S, IDX_HEADS, IDX_DIM) * (IDX_DIM ** -0.5)
    iw = iw * (IDX_HEADS ** -0.5)
    b_out = indexed_sparse_attention(sq, sk, sv, iq, ik, iw, alibi_slopes(DSA_HEADS), topk)

    mixed = jnp.concatenate([a_out.reshape(B, S, DIFF_WIDTH), b_out.reshape(B, S, DSA_WIDTH)], axis=-1)
    return mixed.astype(h.dtype) @ w_out


def peer_ffn(h, w_q, sub_keys, u_tab, v_tab):
    B, S, D = h.shape
    nb = (B * S) // TOKEN_BLOCK
    xb = h.reshape(nb, TOKEN_BLOCK, D)
    skf = sub_keys.astype(jnp.float32)

    def block(xt):
        q = (xt @ w_q).reshape(TOKEN_BLOCK, PEER_HEADS, 2, PEER_HALF_DIM).astype(jnp.float32)
        s = jnp.einsum('thcd,hckd->thck', q, skf)
        s1, i1 = lax.top_k(s[:, :, 0], PEER_TOPK)
        s2, i2 = lax.top_k(s[:, :, 1], PEER_TOPK)
        cand = (s1[..., :, None] + s2[..., None, :]).reshape(TOKEN_BLOCK, PEER_HEADS, PEER_TOPK * PEER_TOPK)
        cidx = (i1[..., :, None] * PEER_N_KEYS + i2[..., None, :]).reshape(TOKEN_BLOCK, PEER_HEADS, PEER_TOPK * PEER_TOPK)
        best, pos = lax.top_k(cand, PEER_TOPK)
        eidx = jnp.take_along_axis(cidx, pos, axis=-1)
        g = jax.nn.softmax(best, axis=-1)
        u = u_tab[eidx]
        act = jax.nn.gelu(jnp.einsum('thkd,td->thk', u, xt).astype(jnp.float32), approximate=False)
        vv = v_tab[eidx]
        return jnp.einsum('thk,thkd->td', (g * act).astype(xt.dtype), vv)

    out = lax.map(block, xb)
    return out.reshape(B, S, D)


def setup_inputs(seed: int = 0) -> dict:
    key = jax.random.key(seed)
    ks = jax.random.split(key, 20)
    f32 = jnp.float32
    x = jax.random.normal(ks[0], (BATCH, SEQ, D_MODEL), f32)
    p = jax.random.normal(ks[1], (DEPTH, BATCH, SEQ, PLE_DIM), f32)
    ln_in_g = 1.0 + 0.02 * jax.random.normal(ks[2], (D_MODEL,), f32)
    ln_in_b = 0.02 * jax.random.normal(ks[3], (D_MODEL,), f32)
    col_scale = jnp.concatenate([
        jnp.full((w,), DEEPNORM_BETA if i in V_SEGMENTS else 1.0, f32) for i, w in enumerate(IN_WIDTHS)])
    w_in = jax.random.normal(ks[4], (DEPTH, D_MODEL, IN_COLS), f32) * (D_MODEL ** -0.5) * col_scale
    w_out = jax.random.normal(ks[5], (DEPTH, D_MIX, D_MODEL), f32) * (D_MIX ** -0.5) * DEEPNORM_BETA
    diff_lambda = 0.1 * jax.random.normal(ks[6], (DEPTH, 4, DIFF_HEAD_DIM), f32)
    diff_subln_g = 1.0 + 0.02 * jax.random.normal(ks[7], (DEPTH, DIFF_V_DIM), f32)
    ln1_g = 1.0 + 0.02 * jax.random.normal(ks[8], (DEPTH, D_MODEL), f32)
    ln1_b = 0.02 * jax.random.normal(ks[9], (DEPTH, D_MODEL), f32)
    peer_wq = jax.random.normal(ks[10], (DEPTH, D_MODEL, PEER_HEADS * PEER_QUERY_DIM), f32) * (D_MODEL ** -0.5)
    peer_subkeys = jax.random.normal(ks[11], (DEPTH, PEER_HEADS, 2, PEER_N_KEYS, PEER_HALF_DIM), f32) * (PEER_HALF_DIM ** -0.5)
    peer_u = jax.random.normal(ks[12], (DEPTH, PEER_N_EXPERTS, D_MODEL), f32) * (D_MODEL ** -0.5)
    peer_v = jax.random.normal(ks[13], (DEPTH, PEER_N_EXPERTS, D_MODEL), f32) * (PEER_HEADS ** -0.5) * DEEPNORM_BETA
    ple_wg = jax.random.normal(ks[14], (DEPTH, D_MODEL, D_MODEL), f32) * (D_MODEL ** -0.5)
    ple_bg = 0.02 * jax.random.normal(ks[15], (DEPTH, D_MODEL), f32)
    ple_wp = jax.random.normal(ks[16], (DEPTH, PLE_DIM, D_MODEL), f32) * (PLE_DIM ** -0.5) * DEEPNORM_BETA
    ln2_g = 1.0 + 0.02 * jax.random.normal(ks[17], (DEPTH, D_MODEL), f32)
    ln2_b = 0.02 * jax.random.normal(ks[18], (DEPTH, D_MODEL), f32)
    return {"x": x, "p": p, "ln_in_g": ln_in_g, "ln_in_b": ln_in_b, "w_in": w_in, "w_out": w_out,
            "diff_lambda": diff_lambda, "diff_subln_g": diff_subln_g, "ln1_g": ln1_g, "ln1_b": ln1_b,
            "peer_wq": peer_wq, "peer_subkeys": peer_subkeys, "peer_u": peer_u, "peer_v": peer_v,
            "ple_wg": ple_wg, "ple_bg": ple_bg, "ple_wp": ple_wp, "ln2_g": ln2_g, "ln2_b": ln2_b}


def reference(x, p, ln_in_g, ln_in_b, w_in, w_out, diff_lambda, diff_subln_g, ln1_g, ln1_b,
              peer_wq, peer_subkeys, peer_u, peer_v, ple_wg, ple_bg, ple_wp, ln2_g, ln2_b):
    h = layer_norm(x, ln_in_g, ln_in_b)
    for i in range(DEPTH):
        lam_init = 0.8 - 0.6 * math.exp(-0.3 * i)
        mix = token_mixers(h, w_in[i], w_out[i], diff_lambda[i], diff_subln_g[i], lam_init)
        h = layer_norm(DEEPNORM_ALPHA * h + mix, ln1_g[i], ln1_b[i])
        r = DEEPNORM_ALPHA * h + peer_ffn(h, peer_wq[i], peer_subkeys[i], peer_u[i], peer_v[i])
        gate = jax.nn.sigmoid((r @ ple_wg[i] + ple_bg[i]).astype(jnp.float32)).astype(r.dtype)
        r = r + gate * (p[i] @ ple_wp[i])
        h = layer_norm(r, ln2_g[i], ln2_b[i])
    return h
```

```cpp
#include <hip/hip_runtime.h>
#include <cstdio>
#include <cstdint>
#include <cmath>

#ifndef MK_PER_PHASE
#define MK_PER_PHASE 0
#endif

#define LAS __attribute__((address_space(3)))
typedef unsigned short bf16_t;
typedef short bf16x8 __attribute__((ext_vector_type(8)));
typedef float f32x4 __attribute__((ext_vector_type(4)));
typedef float f32x2 __attribute__((ext_vector_type(2)));
typedef unsigned u32x4 __attribute__((ext_vector_type(4)));
typedef unsigned u32x2 __attribute__((ext_vector_type(2)));
typedef unsigned long long u64;

constexpr int D = 1024, BATCH = 8, SEQ = 4096, DEPTH = 4, T = BATCH * SEQ;
constexpr int IN_COLS = 3396;
constexpr int NMAIN = 2560;
constexpr int NVV = 1024;
constexpr int NWAVES = 8, NTHREADS = 512;
constexpr float LN_EPS = 1e-5f;
constexpr float ALPHA = 1.6817928305074290f;
constexpr float LOG2E = 1.4426950408889634f;

constexpr size_t MiB = 1u << 20;
constexpr size_t WS_CTL = 0, CTL_ZERO_BYTES = 1 * MiB;
constexpr size_t WS_WIN = 1 * MiB;
constexpr size_t WS_WINV = 21 * MiB;
constexpr size_t WS_WOUT = 29 * MiB;
constexpr size_t WS_WPQ = 37 * MiB;
constexpr size_t WS_WG = 53 * MiB;
constexpr size_t WS_WP = 61 * MiB;
constexpr size_t WS_SUBK = 63 * MiB;
constexpr size_t WS_U8 = 65 * MiB;
constexpr size_t WS_V8 = 129 * MiB;
constexpr size_t WS_USC = 193 * MiB;
constexpr size_t WS_VSC = 194 * MiB;
constexpr size_t WS_KN = 195 * MiB;
constexpr size_t WS_P16 = 321 * MiB;
constexpr size_t WS_H = 385 * MiB;
constexpr size_t WS_H1 = 449 * MiB;
constexpr size_t WS_MIX = 513 * MiB;
constexpr size_t WS_R2 = 577 * MiB;
constexpr size_t WS_RF = 641 * MiB;
constexpr size_t WS_PROJ = 769 * MiB;
constexpr size_t WS_DQ = WS_PROJ + 0 * MiB, WS_DK = WS_PROJ + 32 * MiB, WS_DVT = WS_PROJ + 64 * MiB, WS_SQ = WS_PROJ + 96 * MiB, WS_SK = WS_PROJ + 128 * MiB,
                 WS_SVT = WS_PROJ + 160 * MiB, WS_IQ = WS_PROJ + 192 * MiB, WS_IK = WS_PROJ + 208 * MiB, WS_IW = WS_PROJ + 212 * MiB;
constexpr size_t WS_PQ = WS_PROJ;
constexpr size_t PQ_PLANE = 32 * MiB / 2;
constexpr size_t WS_EG = WS_PROJ + 128 * MiB;
constexpr size_t WS_MASK = 993 * MiB;
constexpr size_t WS_END = 1009 * MiB;

constexpr int LDS_A = 0;
constexpr int LDS_B = 131072;
constexpr int LDS_CTL = 153600;
constexpr int LDS_BYTES = 155648;

__device__ __forceinline__ unsigned cvt_pk_bf16(float lo, float hi) { unsigned r; asm volatile("v_cvt_pk_bf16_f32 %0, %1, %2" : "=v"(r) : "v"(lo), "v"(hi)); return r; }
__device__ __forceinline__ float bf_lo(unsigned w) { return __uint_as_float(w << 16); }
__device__ __forceinline__ float bf_hi(unsigned w) { return __uint_as_float(w & 0xffff0000u); }
__device__ __forceinline__ float wave_sum(float v) {
#pragma unroll
    for (int o = 1; o < 64; o <<= 1) v += __shfl_xor(v, o);
    return v;
}
__device__ __forceinline__ unsigned f2sort(float f) { const unsigned u = __float_as_uint(f); return (u & 0x80000000u) ? ~u : (u | 0x80000000u); }
__device__ __forceinline__ float sort2f(unsigned s) { const unsigned u = (s & 0x80000000u) ? (s & 0x7fffffffu) : ~s; return __uint_as_float(u); }
__device__ __forceinline__ int lane_id_fresh() { int l; asm volatile("v_mbcnt_lo_u32_b32 %0, -1, 0\n\tv_mbcnt_hi_u32_b32 %0, -1, %0" : "=v"(l)); return l; }
#define WAVE_FRESH() ({ int w_ = F.wave; asm volatile("" : "+s"(w_)); w_; })
#define LDS_WAIT() asm volatile("s_waitcnt lgkmcnt(0)" ::: "memory")
#define VM_WAIT() asm volatile("s_waitcnt vmcnt(0)" ::: "memory")
namespace pg8 {
#define PG8_LAS __attribute__((address_space(3)))
constexpr int BM = 256, BK = 64, HALF = 128, HTB = HALF * BK * 2  , STAGE_BYTES = 8 * HTB, NXCD = 8, WGM = 8;

__host__ __device__ __forceinline__ int lds_byte(int r, int c) { const int st = (r >> 4) * 2 + (c >> 5), rr = r & 15, cc = c & 31, ob = rr * 64 + cc * 2; return st * 1024 + (ob ^ (((ob >> 9) & 1) << 5)); }
__host__ __device__ __forceinline__ void stage_rc(int b, int& R, int& C) { const int st = b / 1024, sb = b % 1024, swz = sb ^ (((sb >> 9) & 1) << 5); R = (st >> 1) * 16 + swz / 64; C = (st & 1) * 32 + (swz % 64) / 2; }
__host__ __device__ __forceinline__ int perm32(int rho) { const int n = rho >> 4, i = rho & 15; return 8 * (i >> 2) + 4 * n + (i & 3); }

struct Unit { int pm, pn; };
struct Gemm { const bf16_t* A; const bf16_t* Bt; int M, N, K; };

struct StaticOrder {
    int nM, nN, nwg, G, c, tile;
    __host__ __device__ void init(int M, int N, int G_, int c_) { nM = M / BM; nN = N / BM; nwg = nM * nN; G = G_; c = c_; tile = -1; }
    __host__ __device__ void init_tile(int N, int tile_, int par) { nM = 0; nN = N / BM; nwg = 0; G = 0; c = par; tile = tile_; }
    __host__ __device__ bool next(int i, Unit& u) const {
        if (tile >= 0) { const int pn = c + 2 * i; if (pn >= nN) return false; u.pm = tile; u.pn = pn; return true; }
        const long L = (long)i * G + c; if (L >= nwg) return false;
        int wgid = (int)L; { const int q = nwg / NXCD, r = nwg % NXCD, xcd = wgid % NXCD, off = wgid / NXCD; wgid = (xcd < r ? xcd * (q + 1) : r * (q + 1) + (xcd - r) * q) + off; }
        const int nig = WGM * nN, gid = wgid / nig, fm = gid * WGM, gsz = (nM - fm) < WGM ? (nM - fm) : WGM;
        u.pm = fm + ((wgid % nig) % gsz); u.pn = (wgid % nig) / gsz; return true;
    }
    __device__ __forceinline__ void a_ready(const Unit&) const {}
    __device__ __forceinline__ void done(const Unit&) const {}
};

template <class Epi, class Sched, bool ALIGN_EPI = false, bool SP2 = false>
__device__ __forceinline__ void gemm_phase(PG8_LAS unsigned char* lds, const Gemm g, const Sched& S, const Epi& E, int wave_id) {
    const int lane = lane_id_fresh(), wid = wave_id, tid = wid * 64 + lane,
              wr = wid >> 2, wc = wid & 3, fr = lane & 15, fq = lane >> 4;
    const int K = g.K, nt = K / BK;
    unsigned voffA[2], voffB[2];
#pragma unroll
    for (int i = 0; i < 2; ++i) { int R, C; stage_rc(tid * 16 + i * 8192, R, C); const int Rb = Epi::PERM ? ((R & ~31) + perm32(R & 31)) : R;
        voffA[i] = (unsigned)(R * K + C) * 2u; voffB[i] = (unsigned)(Rb * K + C) * 2u; }
    const size_t kstep = (size_t)(BK * 2);
    const size_t hstep = (size_t)HALF * K * 2;
    const size_t tstep = 2 * hstep;
    const unsigned ldsw = (unsigned)wid * 1024u;
    const int aoff = lds_byte(wr * 64 + fr, fq * 8), boff = lds_byte(wc * 32 + fr, fq * 8);
#define PG8_SA(b, h) (((b) * 2 + (h)) * HTB)
#define PG8_SB(b, h) ((4 + (b) * 2 + (h)) * HTB)
#define PG8_STAGE(bufoff, gbase, voff) do { _Pragma("unroll") for (int _i = 0; _i < 2; ++_i) \
        __builtin_amdgcn_global_load_lds((const unsigned*)((const char*)(gbase) + (voff)[_i]), (PG8_LAS unsigned*)(lds + (bufoff) + ldsw + _i * 8192), 16, 0, 0); } while (0)
#define PG8_LDA(dst, b, h) do { _Pragma("unroll") for (int m = 0; m < 4; ++m) _Pragma("unroll") for (int k = 0; k < 2; ++k) dst[m][k] = *(const PG8_LAS bf16x8*)(lds + PG8_SA(b, h) + aoff + m * 2048 + k * 1024); } while (0)
#define PG8_LDB(dst, b, h) do { _Pragma("unroll") for (int n = 0; n < 2; ++n) _Pragma("unroll") for (int k = 0; k < 2; ++k) dst[n][k] = *(const PG8_LAS bf16x8*)(lds + PG8_SB(b, h) + boff + n * 2048 + k * 1024); } while (0)
#define PG8_MMA(ai, bj, At, Bt) do { __builtin_amdgcn_s_setprio(1); _Pragma("unroll") for (int m = 0; m < 4; ++m) _Pragma("unroll") for (int n = 0; n < 2; ++n) _Pragma("unroll") for (int k = 0; k < 2; ++k) \
        acc[ai][bj][m][n] = Epi::SWAP ? __builtin_amdgcn_mfma_f32_16x16x32_bf16(At[m][k], Bt[n][k], acc[ai][bj][m][n], 0, 0, 0) : __builtin_amdgcn_mfma_f32_16x16x32_bf16(Bt[n][k], At[m][k], acc[ai][bj][m][n], 0, 0, 0); __builtin_amdgcn_s_setprio(0); } while (0)
#define PG8_WAIT_V(n) asm volatile("s_waitcnt vmcnt(" #n ")" ::: "memory")
#define PG8_WAIT_L(n) asm volatile("s_waitcnt lgkmcnt(" #n ")" ::: "memory")
#define PG8_BAR __builtin_amdgcn_s_barrier()
#define PG8_SCHED __builtin_amdgcn_sched_barrier(0)
    Unit cur, nxt; int ui = 0;
    if (!S.next(0, cur)) return;
    f32x4 acc[2][2][4][2];
#pragma unroll
    for (int a = 0; a < 2; ++a)
#pragma unroll
        for (int b = 0; b < 2; ++b)
#pragma unroll
            for (int m = 0; m < 4; ++m)
#pragma unroll
                for (int n = 0; n < 2; ++n) acc[a][b][m][n] = (f32x4){0.f, 0.f, 0.f, 0.f};
    bf16x8 At[4][2], B0[2][2], B1[2][2];
    const char* cA = (const char*)g.A + (size_t)cur.pm * tstep; const char* cB = (const char*)g.Bt + (size_t)cur.pn * tstep;
    S.a_ready(cur);
    if constexpr (SP2) {
        PG8_STAGE(PG8_SB(0, 0), cB, voffB); PG8_STAGE(PG8_SB(0, 1), cB + hstep, voffB); PG8_STAGE(PG8_SA(0, 0), cA, voffA); PG8_STAGE(PG8_SA(0, 1), cA + hstep, voffA);
        if (wr == 1) PG8_BAR;
        PG8_WAIT_V(2); PG8_BAR;
        PG8_STAGE(PG8_SB(1, 0), cB + kstep, voffB); PG8_STAGE(PG8_SA(1, 0), cA + kstep, voffA); PG8_STAGE(PG8_SB(1, 1), cB + hstep + kstep, voffB);
        PG8_WAIT_V(6); PG8_BAR;
    } else {
        PG8_STAGE(PG8_SB(0, 0), cB, voffB); PG8_STAGE(PG8_SA(0, 0), cA, voffA); PG8_STAGE(PG8_SB(0, 1), cB + hstep, voffB); PG8_STAGE(PG8_SA(0, 1), cA + hstep, voffA);
        if (wr == 1) PG8_BAR;
        PG8_WAIT_V(4); PG8_BAR;
        PG8_STAGE(PG8_SB(1, 0), cB + kstep, voffB); PG8_STAGE(PG8_SA(1, 0), cA + kstep, voffA); PG8_STAGE(PG8_SB(1, 1), cB + hstep + kstep, voffB);
        PG8_WAIT_V(6); PG8_BAR;
    }
    for (;;) {
        const bool has_next = S.next(ui + 1, nxt);
        const char* nA = has_next ? (const char*)g.A + (size_t)nxt.pm * tstep : cA; const char* nB = has_next ? (const char*)g.Bt + (size_t)nxt.pn * tstep : cB;
        for (int t = 0; t < nt; t += 2) {
            const bool last = (t == nt - 2);
            const char* a1 = cA + (size_t)(t + 1) * kstep;
            const char* a2 = last ? nA : cA + (size_t)(t + 2) * kstep; const char* b2 = last ? nB : cB + (size_t)(t + 2) * kstep;
            const char* a3 = a2 + kstep; const char* b3 = b2 + kstep;
            if (last && has_next) S.a_ready(nxt);
            if constexpr (SP2) {
            PG8_LDB(B0, 0, 0); PG8_LDB(B1, 0, 1); PG8_SCHED; PG8_LDA(At, 0, 0); PG8_STAGE(PG8_SA(1, 1), a1 + hstep, voffA);
            PG8_WAIT_V(8); PG8_WAIT_L(0); PG8_BAR; PG8_MMA(0, 0, At, B0); PG8_MMA(0, 1, At, B1); PG8_BAR; PG8_SCHED;
            PG8_LDA(At, 0, 1); PG8_STAGE(PG8_SB(0, 0), b2, voffB); PG8_STAGE(PG8_SB(0, 1), b2 + hstep, voffB); PG8_STAGE(PG8_SA(0, 0), a2, voffA);
            PG8_WAIT_V(8); PG8_WAIT_L(0); PG8_BAR; PG8_MMA(1, 0, At, B0); PG8_MMA(1, 1, At, B1); PG8_BAR; PG8_SCHED;
            PG8_LDB(B0, 1, 0); PG8_LDB(B1, 1, 1); PG8_SCHED; PG8_LDA(At, 1, 0); PG8_STAGE(PG8_SA(0, 1), a2 + hstep, voffA);
            PG8_WAIT_V(8); PG8_WAIT_L(0); PG8_BAR; PG8_MMA(0, 0, At, B0); PG8_MMA(0, 1, At, B1); PG8_BAR; PG8_SCHED;
            PG8_LDA(At, 1, 1); PG8_STAGE(PG8_SB(1, 0), b3, voffB); PG8_STAGE(PG8_SB(1, 1), b3 + hstep, voffB); PG8_STAGE(PG8_SA(1, 0), a3, voffA);
            PG8_WAIT_V(8); PG8_WAIT_L(0); PG8_BAR; PG8_MMA(1, 0, At, B0); PG8_MMA(1, 1, At, B1); PG8_BAR; PG8_SCHED;
            } else {
            PG8_LDB(B0, 0, 0); PG8_SCHED; PG8_LDA(At, 0, 0); PG8_STAGE(PG8_SA(1, 1), a1 + hstep, voffA);
            PG8_WAIT_L(8); PG8_BAR; PG8_WAIT_L(0); PG8_MMA(0, 0, At, B0); PG8_BAR; PG8_SCHED;
            PG8_LDB(B1, 0, 1); PG8_STAGE(PG8_SB(0, 0), b2, voffB);
            PG8_BAR; PG8_WAIT_L(0); PG8_MMA(0, 1, At, B1); PG8_BAR;
            PG8_LDA(At, 0, 1); PG8_STAGE(PG8_SA(0, 0), a2, voffA);
            PG8_BAR; PG8_WAIT_L(0); PG8_MMA(1, 0, At, B0); PG8_BAR; PG8_SCHED;
            PG8_STAGE(PG8_SB(0, 1), b2 + hstep, voffB);
            PG8_WAIT_V(6); PG8_BAR; PG8_MMA(1, 1, At, B1); PG8_BAR;
            PG8_LDB(B0, 1, 0); PG8_SCHED; PG8_LDA(At, 1, 0); PG8_STAGE(PG8_SA(0, 1), a2 + hstep, voffA);
            PG8_WAIT_L(8); PG8_BAR; PG8_WAIT_L(0); PG8_MMA(0, 0, At, B0); PG8_BAR; PG8_SCHED;
            PG8_LDB(B1, 1, 1); PG8_STAGE(PG8_SB(1, 0), b3, voffB);
            PG8_BAR; PG8_WAIT_L(0); PG8_MMA(0, 1, At, B1); PG8_BAR;
            PG8_LDA(At, 1, 1); PG8_STAGE(PG8_SA(1, 0), a3, voffA);
            PG8_BAR; PG8_WAIT_L(0); PG8_MMA(1, 0, At, B0); PG8_BAR; PG8_SCHED;
            PG8_STAGE(PG8_SB(1, 1), b3 + hstep, voffB);
            PG8_WAIT_V(6); PG8_BAR; PG8_MMA(1, 1, At, B1); PG8_BAR;
            }
        }
        if constexpr (ALIGN_EPI) { if (wr == 0) PG8_BAR; }
        if constexpr (!Epi::AFTER_DRAIN) { E(acc, cur, wr, wc, fr, fq); S.done(cur); }
        if (!has_next) break;
#pragma unroll
        for (int a = 0; a < 2; ++a)
#pragma unroll
            for (int b = 0; b < 2; ++b)
#pragma unroll
                for (int m = 0; m < 4; ++m)
#pragma unroll
                    for (int n = 0; n < 2; ++n) acc[a][b][m][n] = (f32x4){0.f, 0.f, 0.f, 0.f};
        cur = nxt; cA = nA; cB = nB; ++ui;
        if constexpr (ALIGN_EPI) { if (wr == 1) PG8_BAR; }
    }
    PG8_WAIT_V(0);
    if constexpr (!ALIGN_EPI) { if (wr == 0) PG8_BAR; }
    PG8_BAR;
    if constexpr (Epi::AFTER_DRAIN) { E.fused(acc, cur, wr, wc, fr, fq, lds, wid, lane); S.done(cur); }
#undef PG8_SA
#undef PG8_SB
#undef PG8_STAGE
#undef PG8_LDA
#undef PG8_LDB
#undef PG8_MMA
#undef PG8_WAIT_V
#undef PG8_WAIT_L
#undef PG8_BAR
#undef PG8_SCHED
}
}
namespace epi {
using pg8::Unit;
struct Proj {
    static constexpr bool PERM = true, AFTER_DRAIN = false, SWAP = false;
    bf16_t *DQ, *DK, *SQ, *SK, *IQ, *IK; float* IW;
    __device__ __forceinline__ void operator()(const f32x4 (&acc)[2][2][4][2], const Unit& u, int wr, int wc, int fr, int fq) const {
        const int row0 = u.pm * 256 + wr * 64 + fr;
#pragma unroll
        for (int bj = 0; bj < 2; ++bj) {
            const int cbase = u.pn * 256 + bj * 128 + wc * 32;
            if (cbase >= 2400) continue;
            const int c8 = cbase + 8 * fq;
            if (cbase >= 2368) {
                if (fq == 0) {
#pragma unroll
                    for (int ai = 0; ai < 2; ++ai)
#pragma unroll
                        for (int m = 0; m < 4; ++m) { const int row = row0 + ai * 128 + m * 16; *(f32x4*)(IW + (size_t)row * 4) = acc[ai][bj][m][0] * 0.5f; }
                }
                continue;
            }
            bf16_t* dst; int nh, hh; float sc = 1.0f;
            if (cbase < 512) { dst = DQ; nh = 8; hh = cbase >> 6; sc = 0.125f * LOG2E; }
            else if (cbase < 1024) { dst = DK; nh = 8; hh = (cbase - 512) >> 6; }
            else if (cbase < 1536) { dst = SQ; nh = 8; hh = (cbase - 1024) >> 6; sc = 0.125f * LOG2E; }
            else if (cbase < 2048) { dst = SK; nh = 8; hh = (cbase - 1536) >> 6; }
            else if (cbase < 2304) { dst = IQ; nh = 4; hh = (cbase - 2048) >> 6; sc = 0.125f; }
            else { dst = IK; nh = 1; hh = 0; }
            const int d = c8 & 63;
#pragma unroll
            for (int ai = 0; ai < 2; ++ai)
#pragma unroll
                for (int m = 0; m < 4; ++m) {
                    const int row = row0 + ai * 128 + m * 16, b = row >> 12, s = row & 4095;
                    const f32x4 v0 = acc[ai][bj][m][0] * sc, v1 = acc[ai][bj][m][1] * sc;
                    u32x4 w; w.x = cvt_pk_bf16(v0[0], v0[1]); w.y = cvt_pk_bf16(v0[2], v0[3]); w.z = cvt_pk_bf16(v1[0], v1[1]); w.w = cvt_pk_bf16(v1[2], v1[3]);
                    *(u32x4*)(dst + ((size_t)((b * nh + hh) * 4096 + s)) * 64 + d) = w;
                }
        }
    }
};
struct ProjV {
    static constexpr bool PERM = false, AFTER_DRAIN = false, SWAP = true;
    bf16_t *DVT, *SVT;
    __device__ __forceinline__ void operator()(const f32x4 (&acc)[2][2][4][2], const Unit& u, int wr, int wc, int fr, int fq) const {
#pragma unroll
        for (int ai = 0; ai < 2; ++ai)
#pragma unroll
            for (int m = 0; m < 4; ++m) {
                const int tok0 = u.pm * 256 + ai * 128 + wr * 64 + m * 16 + 4 * fq, b = tok0 >> 12, s0 = tok0 & 4095;
                const int pos = (s0 & ~63) + 16 * m + 8 * (fq & 1) + 4 * (fq >> 1);
#pragma unroll
                for (int bj = 0; bj < 2; ++bj)
#pragma unroll
                    for (int n = 0; n < 2; ++n) {
                        const int col = u.pn * 256 + bj * 128 + wc * 32 + n * 16 + fr;
                        bf16_t* dst;
                        if (col < 512) dst = DVT + ((size_t)((b * 4 + (col >> 7)) * 128 + (col & 127))) * 4096 + pos;
                        else { const int c2 = col - 512; dst = SVT + ((size_t)((b * 8 + (c2 >> 6)) * 64 + (c2 & 63))) * 4096 + pos; }
                        const f32x4 v = acc[ai][bj][m][n];
                        u32x2 w; w.x = cvt_pk_bf16(v[0], v[1]); w.y = cvt_pk_bf16(v[2], v[3]);
                        *(u32x2*)dst = w;
                    }
            }
    }
};
struct PlainBf16 {
    static constexpr bool PERM = true, AFTER_DRAIN = false, SWAP = false;
    bf16_t* O; int ldc; int psh, pmask; unsigned pstride;
    __device__ __forceinline__ void operator()(const f32x4 (&acc)[2][2][4][2], const Unit& u, int wr, int wc, int fr, int fq) const {
        const int row0 = u.pm * 256 + wr * 64 + fr, col0 = (u.pn & pmask) * 256 + wc * 32 + 8 * fq;
        bf16_t* Op = O + (size_t)((unsigned)(u.pn >> psh) * pstride);
#pragma unroll
        for (int ai = 0; ai < 2; ++ai)
#pragma unroll
            for (int m = 0; m < 4; ++m) { bf16_t* rowp = Op + (size_t)(row0 + ai * 128 + m * 16) * ldc + col0;
#pragma unroll
                for (int bj = 0; bj < 2; ++bj) { const f32x4 v0 = acc[ai][bj][m][0], v1 = acc[ai][bj][m][1];
                    u32x4 w; w.x = cvt_pk_bf16(v0[0], v0[1]); w.y = cvt_pk_bf16(v0[2], v0[3]); w.z = cvt_pk_bf16(v1[0], v1[1]); w.w = cvt_pk_bf16(v1[2], v1[3]);
                    *(u32x4*)(rowp + bj * 128) = w; } }
    }
};
struct OutRes {
    static constexpr bool PERM = true, AFTER_DRAIN = false, SWAP = false;
    const bf16_t* H; bf16_t* RF;
    __device__ __forceinline__ void operator()(const f32x4 (&acc)[2][2][4][2], const Unit& u, int wr, int wc, int fr, int fq) const {
        const int row0 = u.pm * 256 + wr * 64 + fr, col0 = u.pn * 256 + wc * 32 + 8 * fq;
#pragma unroll
        for (int ai = 0; ai < 2; ++ai)
#pragma unroll
            for (int m = 0; m < 4; ++m) { const size_t off = (size_t)(row0 + ai * 128 + m * 16) * D + col0;
#pragma unroll
                for (int bj = 0; bj < 2; ++bj) { const u32x4 h = *(const u32x4*)(H + off + bj * 128);
                    f32x4 o0, o1;
                    o0[0] = ALPHA * bf_lo(h.x) + acc[ai][bj][m][0][0]; o0[1] = ALPHA * bf_hi(h.x) + acc[ai][bj][m][0][1]; o0[2] = ALPHA * bf_lo(h.y) + acc[ai][bj][m][0][2]; o0[3] = ALPHA * bf_hi(h.y) + acc[ai][bj][m][0][3];
                    o1[0] = ALPHA * bf_lo(h.z) + acc[ai][bj][m][1][0]; o1[1] = ALPHA * bf_hi(h.z) + acc[ai][bj][m][1][1]; o1[2] = ALPHA * bf_lo(h.w) + acc[ai][bj][m][1][2]; o1[3] = ALPHA * bf_hi(h.w) + acc[ai][bj][m][1][3];
                    u32x4 w; w.x = cvt_pk_bf16(o0[0], o0[1]); w.y = cvt_pk_bf16(o0[2], o0[3]); w.z = cvt_pk_bf16(o1[0], o1[1]); w.w = cvt_pk_bf16(o1[2], o1[3]);
                    *(u32x4*)(RF + off + bj * 128) = w; }
                asm volatile("" ::: "memory"); }
    }
};
struct Gate {
    static constexpr bool PERM = true, AFTER_DRAIN = false, SWAP = false;
    const bf16_t* R2; const bf16_t* PP; const float* bg; bf16_t* RF;
    __device__ __forceinline__ float sg(float x) const { return __builtin_amdgcn_rcpf(1.0f + __builtin_amdgcn_exp2f(-LOG2E * x)); }
    __device__ __forceinline__ void operator()(const f32x4 (&acc)[2][2][4][2], const Unit& u, int wr, int wc, int fr, int fq) const {
        const int row0 = u.pm * 256 + wr * 64 + fr, col0 = u.pn * 256 + wc * 32 + 8 * fq;
        f32x4 bv[2][2];
#pragma unroll
        for (int bj = 0; bj < 2; ++bj) { bv[bj][0] = *(const f32x4*)(bg + col0 + bj * 128); bv[bj][1] = *(const f32x4*)(bg + col0 + bj * 128 + 4); }
#pragma unroll
        for (int ai = 0; ai < 2; ++ai)
#pragma unroll
            for (int m = 0; m < 4; ++m) { const size_t off = (size_t)(row0 + ai * 128 + m * 16) * D + col0;
#pragma unroll
                for (int bj = 0; bj < 2; ++bj) { const u32x4 r = *(const u32x4*)(R2 + off + bj * 128), p = *(const u32x4*)(PP + off + bj * 128);
                    const f32x4 a0 = acc[ai][bj][m][0] + bv[bj][0], a1 = acc[ai][bj][m][1] + bv[bj][1];
                    f32x4 o0, o1;
                    o0[0] = bf_lo(r.x) + sg(a0[0]) * bf_lo(p.x); o0[1] = bf_hi(r.x) + sg(a0[1]) * bf_hi(p.x); o0[2] = bf_lo(r.y) + sg(a0[2]) * bf_lo(p.y); o0[3] = bf_hi(r.y) + sg(a0[3]) * bf_hi(p.y);
                    o1[0] = bf_lo(r.z) + sg(a1[0]) * bf_lo(p.z); o1[1] = bf_hi(r.z) + sg(a1[1]) * bf_hi(p.z); o1[2] = bf_lo(r.w) + sg(a1[2]) * bf_lo(p.w); o1[3] = bf_hi(r.w) + sg(a1[3]) * bf_hi(p.w);
                    u32x4 w; w.x = cvt_pk_bf16(o0[0], o0[1]); w.y = cvt_pk_bf16(o0[2], o0[3]); w.z = cvt_pk_bf16(o1[0], o1[1]); w.w = cvt_pk_bf16(o1[2], o1[3]);
                    *(u32x4*)(RF + off + bj * 128) = w; }
                asm volatile("" ::: "memory"); }
    }
};
}
#define XB_TMO      128
#define XB_XCNT(j)  (256  + 64 * (j))
#define XB_XSUB(j)  (1280 + 64 * (j))
#define XB_XGEN(j)  (2304 + 64 * (j))
#define XB_TOP      3328
#define XB_TOPGEN   3392
#define XCD_BAR_WORDS 3456
#define XB_SPIN_CAP (1u << 22)

__device__ __forceinline__ unsigned xb_ld(unsigned* p)              { return __hip_atomic_load(p, __ATOMIC_RELAXED, __HIP_MEMORY_SCOPE_AGENT); }
__device__ __forceinline__ unsigned xb_add(unsigned* p, unsigned v) { return __hip_atomic_fetch_add(p, v, __ATOMIC_RELAXED, __HIP_MEMORY_SCOPE_AGENT); }
__device__ __forceinline__ unsigned xb_xcc_id() { return (unsigned)__builtin_amdgcn_s_getreg((3 << 11) | 20) & 0xFu; }
#define XB_SPIN(cond, bar) do { unsigned _sp = 0; while (cond) { __builtin_amdgcn_s_sleep(1); \
    if ((++_sp & 255u) == 0u) { if (xb_ld(&(bar)[XB_TMO])) break; if (_sp > XB_SPIN_CAP) { atomicAdd(&(bar)[XB_TMO], 1u); break; } } } } while (0)

struct XcdBarrier {
    unsigned* bar; unsigned x;
    volatile LAS unsigned* st;
};

__device__ __forceinline__ XcdBarrier xcd_barrier_post(unsigned* bar, volatile LAS unsigned* st) {
    XcdBarrier b; b.bar = bar; b.x = xb_xcc_id(); b.st = st;
    if (threadIdx.x == 0) (void)xb_add(&bar[XB_XCNT(b.x)], 1u);
    return b;
}
__device__ __forceinline__ void xcd_barrier_complete(unsigned* bar, unsigned x, unsigned& nloc, unsigned& nx) {
    const unsigned G = gridDim.x * gridDim.y * gridDim.z;
    unsigned sum, cnt, mine, sp = 0u;
    for (;;) {
        sum = 0u; cnt = 0u; mine = 0u;
#pragma unroll
        for (unsigned j = 0; j < 16; ++j) { const unsigned c = xb_ld(&bar[XB_XCNT(j)]); sum += c; cnt += (c > 0u) ? 1u : 0u; mine = (j == x) ? c : mine; }
        if (sum == G) break;
        __builtin_amdgcn_s_sleep(1);
        if ((++sp & 255u) == 0u) { if (xb_ld(&bar[XB_TMO])) break; if (sp > XB_SPIN_CAP) { atomicAdd(&bar[XB_TMO], 1u); break; } }
    }
    nloc = mine > 0u ? mine : 1u; nx = cnt > 0u ? cnt : 1u;
}

__device__ __forceinline__ void xcd_barrier(const XcdBarrier& b) {
    asm volatile("s_waitcnt vmcnt(0)" ::: "memory");
    __syncthreads();
    if (threadIdx.x == 0) {
        unsigned* bar = b.bar;
        __builtin_amdgcn_s_waitcnt(0);
        unsigned nloc = b.st[0], nx = b.st[1];
        if (nloc == 0u) { xcd_barrier_complete(bar, b.x, nloc, nx); b.st[0] = nloc; b.st[1] = nx; }
        const unsigned old = xb_add(&bar[XB_XSUB(b.x)], 1u);
        const unsigned gen = old / nloc;
        if (old + 1u == (gen + 1u) * nloc) {
            __builtin_amdgcn_fence(__ATOMIC_RELEASE, "agent");
            asm volatile("s_waitcnt vmcnt(0)" ::: "memory");
            const unsigned og = xb_add(&bar[XB_TOP], 1u);
            const unsigned tg = og / nx;
            if (og + 1u == (tg + 1u) * nx) xb_add(&bar[XB_TOPGEN], 1u);
            else XB_SPIN(xb_ld(&bar[XB_TOPGEN]) == tg, bar);
            __builtin_amdgcn_fence(__ATOMIC_ACQUIRE, "agent");
            xb_add(&bar[XB_XGEN(b.x)], 1u);
            asm volatile("s_waitcnt vmcnt(0)" ::: "memory");
        } else {
            XB_SPIN(xb_ld(&bar[XB_XGEN(b.x)]) == gen, bar);
            __builtin_amdgcn_fence(__ATOMIC_ACQUIRE, "agent");
            asm volatile("s_waitcnt vmcnt(0)" ::: "memory");
        }
    }
    __syncthreads();
}

#define XB_GRP(j) (3520 + 64 * (j))
#define XB_GMASK(j) (3520 + 64 * (j) + 32)
#define XB_PAIR(j) (8192 + 64 * (j))
__device__ __forceinline__ void group_barrier(const XcdBarrier& b, unsigned cword, unsigned gsize, int gslot = 2) {
    asm volatile("s_waitcnt vmcnt(0)" ::: "memory");
    __syncthreads();
    if (threadIdx.x == 0) {
        unsigned* bar = b.bar;
        __builtin_amdgcn_s_waitcnt(0);
        if (b.st[3] == 0u) {
            __builtin_amdgcn_fence(__ATOMIC_RELEASE, "agent");
            asm volatile("s_waitcnt vmcnt(0)" ::: "memory");
        }
        const unsigned gen = b.st[gslot];
        (void)xb_add(&bar[cword], 1u);
        const unsigned target = (gen + 1u) * gsize;
        XB_SPIN(xb_ld(&bar[cword]) < target, bar);
        __builtin_amdgcn_fence(__ATOMIC_ACQUIRE, "agent");
        asm volatile("s_waitcnt vmcnt(0)" ::: "memory");
        b.st[gslot] = gen + 1u;
    }
    __syncthreads();
}

__device__ __forceinline__ void group_post(const XcdBarrier& b, unsigned grp) { if (threadIdx.x == 0) (void)__hip_atomic_fetch_or(&b.bar[XB_GMASK(grp)], 1u << b.x, __ATOMIC_RELAXED, __HIP_MEMORY_SCOPE_AGENT); }
__device__ __forceinline__ void group_resolve(const XcdBarrier& b, unsigned grp) {
    if (threadIdx.x == 0) { const unsigned m = xb_ld(&b.bar[XB_GMASK(grp)]); b.st[3] = (m != 0u && (m & (m - 1u)) == 0u) ? 1u : 0u; }
    __syncthreads();
}
struct Frame {
    LAS unsigned char* lds;
    int tid, lane, wave, G, wg;
    unsigned char* ws;
};

__device__ __forceinline__ void transpose_item(const float* __restrict__ W, int K, int ldn, int src_c0, int nvalid, bf16_t* __restrict__ WT, LAS float* scr, int kb, int nb, int lane) {
    const int k0 = 64 * kb, n0 = 32 * nb, nn = n0 + (lane & 31);
    const bool ok = nn < nvalid;
#pragma unroll 8
    for (int i = 0; i < 32; ++i) { const int kk = 2 * i + (lane >> 5); scr[kk * 33 + (lane & 31)] = ok ? W[(size_t)(k0 + kk) * ldn + src_c0 + nn] : 0.0f; }
    LDS_WAIT();
    const int c = lane & 7;
#pragma unroll
    for (int j = 0; j < 4; ++j) { const int n = (lane >> 3) + 8 * j; const LAS float* s = scr + (8 * c) * 33 + n;
        u32x4 o; o.x = cvt_pk_bf16(s[0 * 33], s[1 * 33]); o.y = cvt_pk_bf16(s[2 * 33], s[3 * 33]); o.z = cvt_pk_bf16(s[4 * 33], s[5 * 33]); o.w = cvt_pk_bf16(s[6 * 33], s[7 * 33]);
        *(u32x4*)(WT + (size_t)(n0 + n) * K + k0 + 8 * c) = o; }
    LDS_WAIT();
}
__device__ __forceinline__ void ln_row(const float* __restrict__ xrow, const float* __restrict__ g, const float* __restrict__ bta, bf16_t* obf, float* of32, int lane) {
    const f32x4* xr = (const f32x4*)xrow + lane;
    f32x4 v[4]; float s = 0.f;
#pragma unroll
    for (int j = 0; j < 4; ++j) { v[j] = xr[64 * j]; s += (v[j][0] + v[j][1]) + (v[j][2] + v[j][3]); }
    const float mean = wave_sum(s) * (1.f / D); float s2 = 0.f;
#pragma unroll
    for (int j = 0; j < 4; ++j) { v[j] = v[j] - mean; s2 += (v[j][0] * v[j][0] + v[j][1] * v[j][1]) + (v[j][2] * v[j][2] + v[j][3] * v[j][3]); }
    const float rstd = 1.f / sqrtf(wave_sum(s2) * (1.f / D) + LN_EPS);
#pragma unroll
    for (int j = 0; j < 4; ++j) {
        const f32x4 gg = ((const f32x4*)g)[lane + 64 * j], bb = ((const f32x4*)bta)[lane + 64 * j];
        const f32x4 y = v[j] * rstd * gg + bb;
        if (obf) { u32x2 w; w.x = cvt_pk_bf16(y[0], y[1]); w.y = cvt_pk_bf16(y[2], y[3]); ((u32x2*)obf)[lane + 64 * j] = w; }
        if (of32) ((f32x4*)of32)[lane + 64 * j] = y;
    }
}
__device__ __forceinline__ void ln_row_bf(const bf16_t* __restrict__ xrow, const float* __restrict__ g, const float* __restrict__ bta, bf16_t* obf, float* of32, int lane) {
    const u32x4 a0 = *(const u32x4*)(xrow + 16 * lane), a1 = *(const u32x4*)(xrow + 16 * lane + 8);
    float v[16] = {bf_lo(a0.x), bf_hi(a0.x), bf_lo(a0.y), bf_hi(a0.y), bf_lo(a0.z), bf_hi(a0.z), bf_lo(a0.w), bf_hi(a0.w), bf_lo(a1.x), bf_hi(a1.x), bf_lo(a1.y), bf_hi(a1.y), bf_lo(a1.z), bf_hi(a1.z), bf_lo(a1.w), bf_hi(a1.w)};
    float s = 0.f;
#pragma unroll
    for (int i = 0; i < 16; ++i) s += v[i];
    const float mean = wave_sum(s) * (1.f / D); float s2 = 0.f;
#pragma unroll
    for (int i = 0; i < 16; ++i) { v[i] -= mean; s2 += v[i] * v[i]; }
    const float rstd = 1.f / sqrtf(wave_sum(s2) * (1.f / D) + LN_EPS);
    float y[16];
#pragma unroll
    for (int j = 0; j < 4; ++j) { const f32x4 gg = ((const f32x4*)g)[4 * lane + j], bb = ((const f32x4*)bta)[4 * lane + j];
#pragma unroll
        for (int i = 0; i < 4; ++i) y[4 * j + i] = v[4 * j + i] * rstd * gg[i] + bb[i]; }
    if (obf) { u32x4 w0, w1; w0.x = cvt_pk_bf16(y[0], y[1]); w0.y = cvt_pk_bf16(y[2], y[3]); w0.z = cvt_pk_bf16(y[4], y[5]); w0.w = cvt_pk_bf16(y[6], y[7]);
        w1.x = cvt_pk_bf16(y[8], y[9]); w1.y = cvt_pk_bf16(y[10], y[11]); w1.z = cvt_pk_bf16(y[12], y[13]); w1.w = cvt_pk_bf16(y[14], y[15]);
        *(u32x4*)(obf + 16 * lane) = w0; *(u32x4*)(obf + 16 * lane + 8) = w1; }
    if (of32) {
#pragma unroll
        for (int j = 0; j < 4; ++j) ((f32x4*)of32)[4 * lane + j] = (f32x4){y[4 * j], y[4 * j + 1], y[4 * j + 2], y[4 * j + 3]}; }
}
__device__ __forceinline__ void ln_rows_bf(const bf16_t* __restrict__ X, const float* __restrict__ g, const float* __restrict__ bta, bf16_t* obf, float* of32, int gw, int ngw, int mend, int lane) {
    f32x4 gg[4], bb[4];
#pragma unroll
    for (int j = 0; j < 4; ++j) { gg[j] = ((const f32x4*)g)[4 * lane + j]; bb[j] = ((const f32x4*)bta)[4 * lane + j]; }
    int m = gw;
    u32x4 n0 = (u32x4){0u, 0u, 0u, 0u}, n1 = n0;
    if (m < mend) { n0 = *(const u32x4*)(X + (size_t)m * D + 16 * lane); n1 = *(const u32x4*)(X + (size_t)m * D + 16 * lane + 8); }
#pragma unroll 1
    for (; m < mend; m += ngw) {
        const u32x4 a0 = n0, a1 = n1;
        if (m + ngw < mend) { n0 = *(const u32x4*)(X + (size_t)(m + ngw) * D + 16 * lane); n1 = *(const u32x4*)(X + (size_t)(m + ngw) * D + 16 * lane + 8); }
        float v[16] = {bf_lo(a0.x), bf_hi(a0.x), bf_lo(a0.y), bf_hi(a0.y), bf_lo(a0.z), bf_hi(a0.z), bf_lo(a0.w), bf_hi(a0.w), bf_lo(a1.x), bf_hi(a1.x), bf_lo(a1.y), bf_hi(a1.y), bf_lo(a1.z), bf_hi(a1.z), bf_lo(a1.w), bf_hi(a1.w)};
        float s = 0.f;
#pragma unroll
        for (int i = 0; i < 16; ++i) s += v[i];
        const float mean = wave_sum(s) * (1.f / D); float s2 = 0.f;
#pragma unroll
        for (int i = 0; i < 16; ++i) { v[i] -= mean; s2 += v[i] * v[i]; }
        const float rstd = 1.f / sqrtf(wave_sum(s2) * (1.f / D) + LN_EPS);
        float y[16];
#pragma unroll
        for (int j = 0; j < 4; ++j)
#pragma unroll
            for (int i = 0; i < 4; ++i) y[4 * j + i] = v[4 * j + i] * rstd * gg[j][i] + bb[j][i];
        if (obf) { u32x4 w0, w1; w0.x = cvt_pk_bf16(y[0], y[1]); w0.y = cvt_pk_bf16(y[2], y[3]); w0.z = cvt_pk_bf16(y[4], y[5]); w0.w = cvt_pk_bf16(y[6], y[7]);
            w1.x = cvt_pk_bf16(y[8], y[9]); w1.y = cvt_pk_bf16(y[10], y[11]); w1.z = cvt_pk_bf16(y[12], y[13]); w1.w = cvt_pk_bf16(y[14], y[15]);
            *(u32x4*)(obf + (size_t)m * D + 16 * lane) = w0; *(u32x4*)(obf + (size_t)m * D + 16 * lane + 8) = w1; }
        if (of32) {
#pragma unroll
            for (int j = 0; j < 4; ++j) ((f32x4*)(of32 + (size_t)m * D))[4 * lane + j] = (f32x4){y[4 * j], y[4 * j + 1], y[4 * j + 2], y[4 * j + 3]}; }
    }
}
__device__ __forceinline__ void convert_f32_bf16(const float* __restrict__ src, bf16_t* __restrict__ dst, size_t n, size_t gtid, size_t gthreads) {
    const size_t n8 = n >> 3;
    for (size_t i = gtid; i < n8; i += gthreads) {
        const f32x4 a = ((const f32x4*)src)[2 * i], b = ((const f32x4*)src)[2 * i + 1];
        u32x4 o; o.x = cvt_pk_bf16(a[0], a[1]); o.y = cvt_pk_bf16(a[2], a[3]); o.z = cvt_pk_bf16(b[0], b[1]); o.w = cvt_pk_bf16(b[2], b[3]);
        ((u32x4*)dst)[i] = o;
    }
}

__device__ __forceinline__ float fp8_row_scale(float amax, float* inv) {
    const int ex = (int)((__float_as_uint(amax) >> 23) & 0xffu);
    if (ex < 16 || ex > 240) { *inv = 1.0f; return 1.0f; }
    *inv = __uint_as_float((unsigned)(ex - 7) << 23);
    return __uint_as_float((unsigned)(261 - ex) << 23);
}
__device__ __forceinline__ unsigned pack4_fp8(float a, float b, float c, float d) {
    int w = __builtin_amdgcn_cvt_pk_fp8_f32(a, b, 0, false);
    w = __builtin_amdgcn_cvt_pk_fp8_f32(c, d, w, true);
    return (unsigned)w;
}
__device__ __forceinline__ void convert_rows_fp8(const float* __restrict__ src, unsigned char* __restrict__ dst, float* __restrict__ inv_scale, int nrows, int gw, int ngw, int lane) {
    for (int row = gw; row < nrows; row += ngw) {
        const f32x4* xr = (const f32x4*)(src + (size_t)row * D) + lane;
        f32x4 v[4]; float am = 0.f;
#pragma unroll
        for (int j = 0; j < 4; ++j) { v[j] = xr[64 * j]; am = fmaxf(am, fmaxf(fmaxf(fabsf(v[j][0]), fabsf(v[j][1])), fmaxf(fabsf(v[j][2]), fabsf(v[j][3])))); }
#pragma unroll
        for (int o = 1; o < 64; o <<= 1) am = fmaxf(am, __shfl_xor(am, o));
        float inv; const float sc = fp8_row_scale(am, &inv);
#pragma unroll
        for (int j = 0; j < 4; ++j) ((unsigned*)(dst + (size_t)row * D))[lane + 64 * j] = pack4_fp8(v[j][0] * sc, v[j][1] * sc, v[j][2] * sc, v[j][3] * sc);
        if (lane == 0) inv_scale[row] = inv;
    }
}

__device__ __forceinline__ void convert_rows_i4(const float* __restrict__ src, unsigned char* __restrict__ dst, float* __restrict__ step_out, int nrows, int gw, int ngw, int lane) {
    f32x4 nv[4];
#pragma unroll
    for (int j = 0; j < 4; ++j) nv[j] = (f32x4){0.f, 0.f, 0.f, 0.f};
    if (gw < nrows) {
#pragma unroll
        for (int j = 0; j < 4; ++j) nv[j] = ((const f32x4*)(src + (size_t)gw * D + 16 * lane))[j]; }
#pragma unroll 1
    for (int row = gw; row < nrows; row += ngw) {
        f32x4 v[4]; float am = 0.f;
#pragma unroll
        for (int j = 0; j < 4; ++j) v[j] = nv[j];
        if (row + ngw < nrows) {
#pragma unroll
            for (int j = 0; j < 4; ++j) nv[j] = ((const f32x4*)(src + (size_t)(row + ngw) * D + 16 * lane))[j]; }
#pragma unroll
        for (int j = 0; j < 4; ++j) { am = fmaxf(am, fmaxf(fmaxf(fabsf(v[j][0]), fabsf(v[j][1])), fmaxf(fabsf(v[j][2]), fabsf(v[j][3])))); }
#pragma unroll
        for (int o = 1; o < 64; o <<= 1) am = fmaxf(am, __shfl_xor(am, o));
        float ss = 0.f;
#pragma unroll
        for (int j = 0; j < 4; ++j) ss += (v[j][0] * v[j][0] + v[j][1] * v[j][1]) + (v[j][2] * v[j][2] + v[j][3] * v[j][3]);
        ss = wave_sum(ss);
        const float s_rms = 0.335f * sqrtf(ss * (1.0f / D)), s_lo = am * (1.0f / 15.0f), s_hi = am * (1.0f / 7.5f);
        const float step = am > 0.f ? fminf(fmaxf(s_rms, s_lo), s_hi) : 1.0f, rs = 1.0f / step;
        unsigned n[16];
#pragma unroll
        for (int j = 0; j < 4; ++j)
#pragma unroll
            for (int i = 0; i < 4; ++i) { const int q = (int)(v[j][i] * rs + 8.0f); n[4 * j + i] = (unsigned)(q < 0 ? 0 : (q > 15 ? 15 : q)); }
        u32x2 w; w.x = 0u; w.y = 0u;
#pragma unroll
        for (int k = 0; k < 4; ++k) { w.x |= (n[k] | (n[k + 8] << 4)) << (8 * k); w.y |= (n[4 + k] | (n[12 + k] << 4)) << (8 * k); }
        *(u32x2*)(dst + (size_t)row * 512 + 8 * lane) = w;
        if (lane == 0) step_out[row] = step;
    }
}

__device__ __forceinline__ void convert_rows_fp4(const float* __restrict__ src, unsigned char* __restrict__ dst, float* __restrict__ step_out, int nrows, int gw, int ngw, int lane) {
    f32x4 nv[4];
#pragma unroll
    for (int j = 0; j < 4; ++j) nv[j] = (f32x4){0.f, 0.f, 0.f, 0.f};
    if (gw < nrows) {
#pragma unroll
        for (int j = 0; j < 4; ++j) nv[j] = ((const f32x4*)(src + (size_t)gw * D + 16 * lane))[j]; }
#pragma unroll 1
    for (int row = gw; row < nrows; row += ngw) {
        f32x4 v[4]; float am = 0.f;
#pragma unroll
        for (int j = 0; j < 4; ++j) v[j] = nv[j];
        if (row + ngw < nrows) {
#pragma unroll
            for (int j = 0; j < 4; ++j) nv[j] = ((const f32x4*)(src + (size_t)(row + ngw) * D + 16 * lane))[j]; }
#pragma unroll
        for (int j = 0; j < 4; ++j) { am = fmaxf(am, fmaxf(fmaxf(fabsf(v[j][0]), fabsf(v[j][1])), fmaxf(fabsf(v[j][2]), fabsf(v[j][3])))); }
#pragma unroll
        for (int o = 1; o < 64; o <<= 1) am = fmaxf(am, __shfl_xor(am, o));
        float ss = 0.f;
#pragma unroll
        for (int j = 0; j < 4; ++j) ss += (v[j][0] * v[j][0] + v[j][1] * v[j][1]) + (v[j][2] * v[j][2] + v[j][3] * v[j][3]);
        ss = wave_sum(ss);
        const float s_rms = 0.48f * sqrtf(ss * (1.0f / D)), s_lo = am * (1.0f / 12.0f), s_hi = am * (1.0f / 6.0f);
        const float step = am > 0.f ? fminf(fmaxf(s_rms, s_lo), s_hi) : 1.0f, rs = 1.0f / step;
        unsigned n[16];
#pragma unroll
        for (int j = 0; j < 4; ++j)
#pragma unroll
            for (int i = 0; i < 4; ++i) { const float y = v[j][i] * rs, ay = fabsf(y);
                const unsigned mag = (ay >= 0.25f ? 1u : 0u) + (ay >= 0.75f ? 1u : 0u) + (ay >= 1.25f ? 1u : 0u) + (ay >= 1.75f ? 1u : 0u) + (ay >= 2.5f ? 1u : 0u) + (ay >= 3.5f ? 1u : 0u) + (ay >= 5.0f ? 1u : 0u);
                n[4 * j + i] = mag | ((y < 0.f && mag != 0u) ? 8u : 0u); }
        u32x2 w; w.x = 0u; w.y = 0u;
#pragma unroll
        for (int k = 0; k < 4; ++k) { w.x |= (n[2 * k] | (n[2 * k + 1] << 4)) << (8 * k); w.y |= (n[8 + 2 * k] | (n[9 + 2 * k] << 4)) << (8 * k); }
        *(u32x2*)(dst + (size_t)row * 512 + 8 * lane) = w;
        if (lane == 0) step_out[row] = step;
    }
}

__device__ __forceinline__ float relu1(float d) { float r; asm("v_max_f32 %0, 0, %1" : "=v"(r) : "v"(d)); return r; }
__device__ __forceinline__ bool scan_hist_row(const LAS unsigned* row, int lane, unsigned target, unsigned& dsel, unsigned& ca, unsigned& csel, unsigned& tot_all) {
    unsigned wd[8];
#pragma unroll
    for (int i = 0; i < 8; ++i) wd[i] = row[8 * lane + i];
    unsigned tot = 0;
#pragma unroll
    for (int i = 0; i < 8; ++i) tot += (wd[i] & 0xffffu) + (wd[i] >> 16);
    unsigned incl = tot;
#pragma unroll
    for (int off = 1; off < 64; off <<= 1) { const unsigned t = __shfl_down(incl, off); if (lane + off < 64) incl += t; }
    tot_all = __shfl(incl, 0);
    const unsigned above = incl - tot;
    dsel = 0; ca = above; csel = 0;
    if (!(above < target && target <= incl)) return false;
    bool found = false;
#pragma unroll
    for (int i = 15; i >= 0; --i) { const unsigned c = (i & 1) ? (wd[i >> 1] >> 16) : (wd[i >> 1] & 0xffffu);
        if (!found) { if (ca + c >= target) { found = true; dsel = (unsigned)(16 * lane + i); csel = c; } else ca += c; } }
    return true;
}
__device__ __forceinline__ void select_exact_wave(const LAS float* S, int ng, LAS unsigned* wh, u64* __restrict__ mq, int lane) {
    unsigned prefix = 0u, need = 256u;
#pragma unroll 1
    for (int pass = 0; pass < 4; ++pass) {
        const int shift = 24 - 8 * pass;
        *(LAS u32x4*)(wh + 4 * lane) = (u32x4){0u, 0u, 0u, 0u};
        asm volatile("s_waitcnt lgkmcnt(0)" ::: "memory");
#pragma unroll 4
        for (int g = 0; g < ng; ++g) { const unsigned u = f2sort(S[g * 64 + lane]);
            if (((u >> shift) >> 8) == prefix) __hip_atomic_fetch_add(wh + ((u >> shift) & 255u), 1u, __ATOMIC_RELAXED, __HIP_MEMORY_SCOPE_WORKGROUP); }
        asm volatile("s_waitcnt lgkmcnt(0)" ::: "memory");
        unsigned cc[4];
#pragma unroll
        for (int i = 0; i < 4; ++i) cc[i] = wh[4 * lane + i];
        const unsigned tot = cc[0] + cc[1] + cc[2] + cc[3];
        unsigned incl = tot;
#pragma unroll
        for (int off = 1; off < 64; off <<= 1) { const unsigned t = __shfl_down(incl, off); if (lane + off < 64) incl += t; }
        const unsigned above = incl - tot;
        const bool hit = above < need && need <= incl;
        unsigned ca = above, dsel = 0u; bool found = false;
#pragma unroll
        for (int i = 3; i >= 0; --i) if (!found) { if (ca + cc[i] >= need) { found = true; dsel = (unsigned)(4 * lane + i); } else ca += cc[i]; }
        const u64 hm = __ballot(hit); const int hl = hm ? (int)__builtin_ctzll(hm) : 0;
        const unsigned bsel = (unsigned)__shfl((int)dsel, hl), bca = (unsigned)__shfl((int)ca, hl);
        prefix = (prefix << 8) | bsel; need -= bca;
        asm volatile("" ::: "memory");
    }
    unsigned rem = need;
#pragma unroll 2
    for (int g = 0; g < ng; ++g) { const unsigned u = f2sort(S[g * 64 + lane]);
        const u64 gt = __ballot(u > prefix), eq = __ballot(u == prefix);
        const unsigned below = __builtin_amdgcn_mbcnt_hi((unsigned)(eq >> 32), __builtin_amdgcn_mbcnt_lo((unsigned)eq, 0u));
        const u64 pick = __ballot(u == prefix && below < rem);
        const unsigned np = (unsigned)__builtin_popcountll(pick);
        rem -= np;
        if (lane == 0) mq[(size_t)g * 4096] = gt | pick; }
}
template <int MODE>
__device__ __forceinline__ void select_sweep(const bf16_t* __restrict__ ikb, const bf16x8 (&bq)[4][2], const f32x4 wq, int kh, int ng, int fr, int fq, bool active, unsigned P0, unsigned P1,
                                             LAS unsigned* hrow, u64* __restrict__ mrow, float flo = 0.f, float finv = 0.f, float* amax = nullptr, LAS unsigned* lcnt = nullptr, LAS u64* lrow = nullptr, unsigned cap = 0u, unsigned zg = 0u, unsigned zk = 0u, unsigned fs = 0u, bool dmp = false, LAS float* scb = nullptr) {
    const float tin = (P0 == 0u) ? -INFINITY : (float)P0;
    const float tsel = (P1 & 1u) ? tin : ((P0 >= 1023u) ? INFINITY : (float)(P0 + 1u));
    bf16x8 ka[8];
#define SEL_LOAD1(G, KT) do { const bf16_t* kp = ikb + (size_t)((G) * 64 + (KT) * 16 + fr) * 64 + 8 * fq; ka[2 * (KT)] = *(const bf16x8*)kp; ka[2 * (KT) + 1] = *(const bf16x8*)(kp + 32); } while (0)
    int g = kh;
    if (g < ng) {
#pragma unroll
        for (int kt = 0; kt < 4; ++kt) SEL_LOAD1(g, kt);
    }
#pragma unroll 1
    for (; g < ng; g += 2) {
        unsigned lo_ = 0u, hi_ = 0u, zlo_ = 0u, zhi_ = 0u;
        const bool more = (g + 2 < ng);
#pragma unroll
        for (int kt = 0; kt < 4; ++kt) {
            f32x4 dd[4];
#pragma unroll
            for (int j = 0; j < 4; ++j) {
                dd[j] = __builtin_amdgcn_mfma_f32_16x16x32_bf16(ka[2 * kt], bq[j][0], (f32x4){0.f, 0.f, 0.f, 0.f}, 0, 0, 0);
                dd[j] = __builtin_amdgcn_mfma_f32_16x16x32_bf16(ka[2 * kt + 1], bq[j][1], dd[j], 0, 0, 0);
            }
            if (more) SEL_LOAD1(g + 2, kt);
            f32x4 sc = (f32x4){0.f, 0.f, 0.f, 0.f};
#pragma unroll
            for (int j = 0; j < 4; ++j)
#pragma unroll
                for (int r = 0; r < 4; ++r) sc[r] += wq[j] * relu1(dd[j][r]);
            unsigned nib = 0u, znib = 0u;
#pragma unroll
            for (int r = 0; r < 4; ++r) {
                const unsigned u = f2sort(sc[r] + 0.0f), inv = (unsigned)(4095 - (g * 64 + kt * 16 + 4 * fq + r));
                if (MODE == 5) { nib |= ((u > P0) || (u == P0 && inv >= P1)) ? (1u << r) : 0u; }
                else if (MODE == 6) { *amax = fmaxf(*amax, fabsf(sc[r])); }
                else if (MODE == 7) { const unsigned bi = (unsigned)(int)fminf(fmaxf(__builtin_fmaf(sc[r], finv, 512.0f), 0.f), 1023.f);
                    if (bi >= P0) __hip_atomic_fetch_add(hrow + (bi >> 1), (bi & 1u) ? 65536u : 1u, __ATOMIC_RELAXED, __HIP_MEMORY_SCOPE_WORKGROUP);
                    if (lcnt != nullptr && sc[r] == 0.0f) znib += 1u; }
                else if (MODE == 8) { const float tb = __builtin_fmaf(sc[r], finv, 512.0f);
                    const bool s1 = fs == 0u && tb >= tsel;
                    nib |= s1 ? (1u << r) : 0u;
                    if (fs == 0u && !s1 && tb >= tin) {
                        if ((P1 & 2u) != 0u && sc[r] == 0.0f) znib |= (1u << r);
                        else { const unsigned pos = __hip_atomic_fetch_add(lcnt, 1u, __ATOMIC_RELAXED, __HIP_MEMORY_SCOPE_WORKGROUP); if (pos < cap) lrow[pos] = ((u64)u << 12) | (u64)inv; } } }
                else if (MODE == 9) { }
                else { bool match; unsigned dg;
                    if (MODE == 0) { match = active; dg = u >> 22; }
                    else if (MODE == 1) { match = active && (u >> 22) == P0; dg = (u >> 12) & 1023u; }
                    else if (MODE == 2) { match = active && (u >> 12) == P0; dg = (u >> 2) & 1023u; }
                    else if (MODE == 3) { match = active && (u >> 2) == P0; dg = ((u & 3u) << 8) | (inv >> 4); }
                    else { match = active && u == P0 && (inv >> 4) == P1; dg = inv & 15u; }
                    if (match) __hip_atomic_fetch_add(hrow + (dg >> 1), (dg & 1u) ? 65536u : 1u, __ATOMIC_RELAXED, __HIP_MEMORY_SCOPE_WORKGROUP); }
            }
            if (MODE == 8 || MODE == 9) { if (dmp) *(LAS f32x4*)(scb + g * 64 + kt * 16 + 4 * fq) = sc + 0.0f; }
            if (MODE == 5 || MODE == 8) { const unsigned sh = (unsigned)((kt & 1) * 16 + 4 * fq); if (kt < 2) lo_ |= nib << sh; else hi_ |= nib << sh; }
            if (MODE == 8) { const unsigned sh = (unsigned)((kt & 1) * 16 + 4 * fq); if (kt < 2) zlo_ |= znib << sh; else zhi_ |= znib << sh; }
            if (MODE == 7) { if (znib != 0u) __hip_atomic_fetch_add(lcnt + (g >> 1), znib << (16 * (g & 1)), __ATOMIC_RELAXED, __HIP_MEMORY_SCOPE_WORKGROUP); }
        }
        if (MODE == 5 || MODE == 8) { lo_ |= __shfl_xor(lo_, 16); lo_ |= __shfl_xor(lo_, 32); hi_ |= __shfl_xor(hi_, 16); hi_ |= __shfl_xor(hi_, 32);
            u64 word = ((u64)hi_ << 32) | (u64)lo_;
            if (MODE == 8 && (P1 & 2u) != 0u) {
                zlo_ |= __shfl_xor(zlo_, 16); zlo_ |= __shfl_xor(zlo_, 32); zhi_ |= __shfl_xor(zhi_, 16); zhi_ |= __shfl_xor(zhi_, 32);
                u64 zm = ((u64)zhi_ << 32) | (u64)zlo_;
                if (g > (int)zg) zm = 0ull; else if (g == (int)zg) { u64 pick = 0ull; for (unsigned i = 0; i < zk; ++i) { const u64 bb = zm & (0ull - zm); pick |= bb; zm ^= bb; } zm = pick; }
                word |= zm; }
            if (fq == 0 && (MODE != 8 || fs == 0u)) mrow[(size_t)g * 4096] = word; }
    }
#undef SEL_LOAD1
}
__device__ __forceinline__ void select_item(const Frame& F, int b, int qb, const bf16_t* __restrict__ IQ, const bf16_t* __restrict__ IK, const float* __restrict__ IW, u64* __restrict__ MASK) {
    constexpr int HS = 513;
    LAS unsigned* hist = (LAS unsigned*)(F.lds + LDS_A);
    LAS u64* Pq = (LAS u64*)(F.lds + LDS_B + 2048);
    LAS u64* Thr = (LAS u64*)(F.lds + LDS_B + 2048 + 512);
    LAS unsigned* Need = (LAS unsigned*)(F.lds + LDS_B + 2048 + 1024);
    LAS unsigned* Done = (LAS unsigned*)(F.lds + LDS_B + 2048 + 1280);
    LAS unsigned* NDone = (LAS unsigned*)(F.lds + LDS_B + 2048 + 1536);
    const int lane = lane_id_fresh(), w = WAVE_FRESH(), qg = w & 3, kh = w >> 2, fr = lane & 15, fq = lane >> 4;
    const int q0 = qb * 64, ql = 16 * qg + fr, ng = qb + 1, tid = w * 64 + lane;
    u64* mrow = MASK + (size_t)b * 64 * 4096 + (q0 + ql);
    if (qb < 4) {
        for (int g = kh; g < ng; g += 2) if (fq == 0) mrow[(size_t)g * 4096] = ~0ull;
        return;
    }
    bf16x8 bq[4][2]; f32x4 wq;
#pragma unroll
    for (int j = 0; j < 4; ++j)
#pragma unroll
        for (int ks = 0; ks < 2; ++ks) bq[j][ks] = *(const bf16x8*)(IQ + ((size_t)((b * 4 + j) * 4096 + q0 + ql)) * 64 + 32 * ks + 8 * fq);
    wq = *(const f32x4*)(IW + (size_t)(b * 4096 + q0 + ql) * 4);
    const bf16_t* ikb = IK + (size_t)b * 4096 * 64;
    {
        constexpr unsigned CAP = 128u, NSLOT = 4u;
        LAS unsigned* AMX = (LAS unsigned*)(F.lds + LDS_B + 2048 + 1792);
        LAS unsigned* LCN = (LAS unsigned*)(F.lds + LDS_B + 2048 + 2048);
        LAS unsigned* ALQ = (LAS unsigned*)(F.lds + LDS_B + 2048 + 2304);
        LAS u64* LST = (LAS u64*)(F.lds + LDS_A);
        LAS unsigned* ZH = (LAS unsigned*)(F.lds + LDS_B + 8192);
        LAS unsigned* ZGK = (LAS unsigned*)(F.lds + LDS_B + 2048 + 3072);
        LAS unsigned* OVF = (LAS unsigned*)(F.lds + LDS_B + 2048 + 2560);
        LAS unsigned* FSL = (LAS unsigned*)(F.lds + LDS_B + 2048 + 3328);
        LAS unsigned* FQS = (LAS unsigned*)(F.lds + LDS_B + 2048 + 3840);
        LAS unsigned* NFL = (LAS unsigned*)(F.lds + LDS_B + 2048 + 3584);
        LAS float* SCB = (LAS float*)(F.lds + LDS_A + 65536);
        if (tid < 64) { AMX[tid] = 0u; LCN[tid] = 0u; ALQ[tid] = 0u; Need[tid] = 256u; Pq[tid] = 0ull; ZGK[tid] = 0u; FSL[tid] = 0u; }
        if (tid == 0) { OVF[0] = 0u; NFL[0] = 0u; }
#define SEL_RESCUE(Q) do { const unsigned s_ = __hip_atomic_fetch_add(NFL, 1u, __ATOMIC_RELAXED, __HIP_MEMORY_SCOPE_WORKGROUP); if (s_ < 64u) { FSL[Q] = s_ + 1u; FQS[s_] = (unsigned)(Q); } else OVF[0] = 1u; } while (0)
        for (int i = tid; i < 64 * 32; i += NTHREADS) ZH[i] = 0u;
        for (int i = tid; i < (64 * HS + 3) / 4; i += NTHREADS) ((LAS u32x4*)hist)[i] = (u32x4){0u, 0u, 0u, 0u};
        __syncthreads();
        { float am = 0.f;
          select_sweep<6>(ikb, bq, wq, kh, 2, fr, fq, true, 0u, 0u, hist, mrow, 0.f, 0.f, &am);
          am = fmaxf(am, __shfl_xor(am, 16)); am = fmaxf(am, __shfl_xor(am, 32));
          if (fq == 0) __hip_atomic_fetch_max(AMX + ql, __float_as_uint(am), __ATOMIC_RELAXED, __HIP_MEMORY_SCOPE_WORKGROUP); }
        __syncthreads();
        const float fhi = __uint_as_float(((AMX[ql] >> 23) + 2u) << 23), flo = -fhi, finv = 512.0f / fhi;
        LAS unsigned* LBN = (LAS unsigned*)(F.lds + LDS_B + 2048 + 2816);
        select_sweep<7>(ikb, bq, wq, kh, 2, fr, fq, true, 0u, 0u, hist + ql * HS, mrow, flo, finv);
        __syncthreads();
        { const unsigned nvis = 64u * (unsigned)ng; unsigned msel = (128u * 256u * 3u + nvis - 1u) / nvis + 8u;
          for (int qi = 0; qi < 8; ++qi) { const int q = 8 * w + qi; unsigned dsel, ca, csel, tall;
              const bool hit = scan_hist_row(hist + q * HS, lane, msel, dsel, ca, csel, tall);
              if (msel >= 128u) { if (lane == 0) LBN[q] = 0u; } else if (hit) LBN[q] = dsel; } }
        __syncthreads();
        for (int i = tid; i < (64 * HS + 3) / 4; i += NTHREADS) ((LAS u32x4*)hist)[i] = (u32x4){0u, 0u, 0u, 0u};
        __syncthreads();
        select_sweep<7>(ikb, bq, wq, kh, ng, fr, fq, true, LBN[ql], 0u, hist + ql * HS, mrow, flo, finv, nullptr, ZH + ql * 32);
        __syncthreads();
        for (int qi = 0; qi < 8; ++qi) {
            const int q = 8 * w + qi; unsigned dsel, ca, csel, tall;
            const bool hit = scan_hist_row(hist + q * HS, lane, 256u, dsel, ca, csel, tall);
            if (lane == 0 && tall < 256u) SEL_RESCUE(q);
            const u64 hm = __ballot(hit); const int hl = hm ? (int)__builtin_ctzll(hm) : 0;
            const unsigned bsel = (unsigned)__shfl((int)dsel, hl), bca = (unsigned)__shfl((int)ca, hl), bcs = (unsigned)__shfl((int)csel, hl);
            if (hm != 0ull) {
                const unsigned nneed = 256u - bca;
                if (lane == 0) { Pq[q] = (u64)bsel; Need[q] = nneed; }
                if (bcs == nneed) { if (lane == 0) ALQ[q] = 1u; }
                else { const float qhi = __uint_as_float(((AMX[q] >> 23) + 2u) << 23); const unsigned bz = (unsigned)(int)fminf(fmaxf((0.0f + qhi) * (512.0f / qhi), 0.f), 1023.f);
                    unsigned cl = bcs;
                    if (bsel == bz) {
                        const unsigned zz = ZH[q * 32 + (lane >> 1)], zc = (lane & 1) ? (zz >> 16) : (zz & 0xffffu);
                        unsigned incl = zc;
#pragma unroll
                        for (int off = 1; off < 64; off <<= 1) { const unsigned t = (unsigned)__shfl_up((int)incl, off); if (lane >= off) incl += t; }
                        const unsigned Z = (unsigned)__shfl((int)incl, 63);
                        const unsigned p = bcs - Z;
                        const unsigned zsel = nneed > p ? (nneed - p < Z ? nneed - p : Z) : 0u;
                        const u64 gm = __ballot(incl >= zsel && zsel != 0u); const int gl = gm ? (int)__builtin_ctzll(gm) : 0;
                        const unsigned gex = (unsigned)__shfl((int)(incl - zc), gl);
                        const unsigned G = zsel ? (unsigned)gl : 0u, kin = zsel ? zsel - gex : 0u;
                        if (lane == 0) ZGK[q] = ((G << 8) | kin) + 1u;
                        cl = p; }
                    if (cl > CAP && lane == 0) SEL_RESCUE(q); } }
        }
        __syncthreads();
        if (OVF[0] == 0u) {
            LAS u64* lrow = LST + ql * CAP;
            const unsigned zgk = ZGK[ql], fs = FSL[ql];
            select_sweep<8>(ikb, bq, wq, kh, ng, fr, fq, true, (unsigned)Pq[ql], ALQ[ql] | (zgk != 0u ? 2u : 0u), hist, mrow, flo, finv, nullptr, LCN + ql, lrow, CAP, (zgk - 1u) >> 8, (zgk - 1u) & 255u, fs, fs != 0u && fs <= NSLOT, SCB + ((fs - 1u) & (NSLOT - 1u)) * 4096u);
            asm volatile("s_waitcnt vmcnt(0)" ::: "memory");
            __syncthreads();
            for (int qi = 0; qi < 8; ++qi) {
                const int q = 8 * w + qi;
                if (ALQ[q] != 0u || FSL[q] != 0u) continue;
                const unsigned c = LCN[q], need = Need[q];
                const LAS u64* lq = LST + q * CAP;
                u64 ci[2]; unsigned rank[2];
#pragma unroll
                for (int m = 0; m < 2; ++m) { ci[m] = ((unsigned)(lane + 64 * m) < c) ? lq[lane + 64 * m] : ~0ull; rank[m] = 0u; }
                for (unsigned j = 0; j < c; ++j) { const u64 cj = lq[j];
#pragma unroll
                    for (int m = 0; m < 2; ++m) rank[m] += (cj > ci[m]) ? 1u : 0u; }
                u64* mq = MASK + (size_t)b * 64 * 4096 + (q0 + q);
#pragma unroll
                for (int m = 0; m < 2; ++m) if ((unsigned)(lane + 64 * m) < c && rank[m] < need) { const unsigned key = 4095u - (unsigned)(ci[m] & 4095ull);
                    __hip_atomic_fetch_or(mq + (size_t)(key >> 6) * 4096, 1ull << (key & 63u), __ATOMIC_RELAXED, __HIP_MEMORY_SCOPE_AGENT); }
            }
            const unsigned nfl = NFL[0];
            if ((unsigned)w < (nfl < NSLOT ? nfl : NSLOT)) { const unsigned q = FQS[w];
                select_exact_wave(SCB + w * 4096, ng, ZH + w * 256, MASK + (size_t)b * 64 * 4096 + (q0 + (int)q), lane); }
            if (__builtin_expect(nfl > NSLOT, 0))
_Pragma("unroll 1")
            for (unsigned base = NSLOT; base < nfl; base += 8u) {
                __syncthreads();
                const bool dm = fs > base && fs <= base + 8u;
                select_sweep<9>(ikb, bq, wq, kh, ng, fr, fq, true, 0u, 0u, hist, mrow, 0.f, 0.f, nullptr, nullptr, nullptr, 0u, 0u, 0u, fs, dm, (LAS float*)(F.lds + LDS_A) + ((fs - base - 1u) & 7u) * 4096u);
                __syncthreads();
                if (base + (unsigned)w < nfl) { const unsigned q = FQS[base + w];
                    select_exact_wave((LAS float*)(F.lds + LDS_A) + w * 4096, ng, ZH + w * 256, MASK + (size_t)b * 64 * 4096 + (q0 + (int)q), lane); }
            }
            __syncthreads();
            return;
        }
#undef SEL_RESCUE
    }
    if (tid < 64) { Pq[tid] = 0ull; Need[tid] = 256u; Done[tid] = 0u; Thr[tid] = 0ull; }
    if (tid == 0) NDone[0] = 0u;
    __syncthreads();
    for (int pass = 0; pass < 5; ++pass) {
        const int sh_hi = 44 - 10 * pass, wbits = sh_hi < 10 ? sh_hi : 10, sh_lo = sh_hi - wbits;
        for (int i = tid; i < (64 * HS + 3) / 4; i += NTHREADS) ((LAS u32x4*)hist)[i] = (u32x4){0u, 0u, 0u, 0u};
        __syncthreads();
        const u64 myP = Pq[ql]; const bool active = Done[ql] == 0u;
        LAS unsigned* hrow = hist + ql * HS;
        if (pass == 0) select_sweep<0>(ikb, bq, wq, kh, ng, fr, fq, active, 0u, 0u, hrow, mrow);
        else if (pass == 1) select_sweep<1>(ikb, bq, wq, kh, ng, fr, fq, active, (unsigned)myP, 0u, hrow, mrow);
        else if (pass == 2) select_sweep<2>(ikb, bq, wq, kh, ng, fr, fq, active, (unsigned)myP, 0u, hrow, mrow);
        else if (pass == 3) select_sweep<3>(ikb, bq, wq, kh, ng, fr, fq, active, (unsigned)myP, 0u, hrow, mrow);
        else select_sweep<4>(ikb, bq, wq, kh, ng, fr, fq, active, (unsigned)(myP >> 8), (unsigned)myP & 255u, hrow, mrow);
        __syncthreads();
        for (int qi = 0; qi < 8; ++qi) {
            const int q = 8 * w + qi;
            if (Done[q] != 0u) continue;
            unsigned wd[8];
#pragma unroll
            for (int i = 0; i < 8; ++i) wd[i] = hist[q * HS + 8 * lane + i];
            unsigned tot = 0;
#pragma unroll
            for (int i = 0; i < 8; ++i) tot += (wd[i] & 0xffffu) + (wd[i] >> 16);
            unsigned incl = tot;
#pragma unroll
            for (int off = 1; off < 64; off <<= 1) { const unsigned t = __shfl_down(incl, off); if (lane + off < 64) incl += t; }
            const unsigned above = incl - tot, need = Need[q];
            if (above < need && need <= incl) {
                unsigned ca = above, dsel = 0, csel = 0; bool found = false;
#pragma unroll
                for (int i = 15; i >= 0; --i) { const unsigned c = (i & 1) ? (wd[i >> 1] >> 16) : (wd[i >> 1] & 0xffffu);
                    if (!found) { if (ca + c >= need) { found = true; dsel = (unsigned)(16 * lane + i); csel = c; } else ca += c; } }
                const unsigned nneed = need - ca;
                const u64 np = (Pq[q] << wbits) | (u64)dsel;
                Pq[q] = np; Need[q] = nneed;
                if (csel == nneed || sh_lo == 0) { Done[q] = 1u; Thr[q] = np << sh_lo; __hip_atomic_fetch_add(NDone, 1u, __ATOMIC_RELAXED, __HIP_MEMORY_SCOPE_WORKGROUP); }
            }
        }
        __syncthreads();
        if (NDone[0] >= 64u) break;
    }
    const u64 thr = Thr[ql];
    select_sweep<5>(ikb, bq, wq, kh, ng, fr, fq, true, (unsigned)(thr >> 12), (unsigned)thr & 4095u, hist, mrow);
    __syncthreads();
}

__device__ __forceinline__ void knorm_item(const Frame& F, const bf16_t* __restrict__ Kt, float* __restrict__ out) {
    const int lane = lane_id_fresh(), tid = F.wave * 64 + lane;
    float mx = 0.f;
    for (int r = tid; r < 2048; r += NTHREADS) {
        const u32x4* p = (const u32x4*)(Kt + (size_t)r * 64); float s = 0.f;
#pragma unroll
        for (int c = 0; c < 8; ++c) { const u32x4 v = p[c];
            s += bf_lo(v.x) * bf_lo(v.x) + bf_hi(v.x) * bf_hi(v.x) + bf_lo(v.y) * bf_lo(v.y) + bf_hi(v.y) * bf_hi(v.y) + bf_lo(v.z) * bf_lo(v.z) + bf_hi(v.z) * bf_hi(v.z) + bf_lo(v.w) * bf_lo(v.w) + bf_hi(v.w) * bf_hi(v.w); }
        mx = fmaxf(mx, s);
    }
#pragma unroll
    for (int o = 1; o < 64; o <<= 1) mx = fmaxf(mx, __shfl_xor(mx, o));
    LAS float* red = (LAS float*)(F.lds + LDS_B + 6144);
    if (lane == 0) red[F.wave] = mx;
    __syncthreads();
    if (tid == 0) { float m = red[0];
#pragma unroll
        for (int i = 1; i < NWAVES; ++i) m = fmaxf(m, red[i]);
        *out = m; }
    __syncthreads();
}
typedef float f32x16 __attribute__((ext_vector_type(16)));
__device__ __forceinline__ float fadd_s(float a, float b) { float r; asm("v_add_f32 %0, %1, %2" : "=v"(r) : "v"(a), "v"(b)); return r; }
template <bool DSA>
__device__ __forceinline__ void attn_item(const Frame& F, int b, int hsel, int QB, const bf16_t* __restrict__ Qg, const bf16_t* __restrict__ Kg, const bf16_t* __restrict__ VTg,
                                          const u64* __restrict__ MASK, bf16_t* __restrict__ MIX, float lam, float lam_init, const float* __restrict__ subln_g, const float* __restrict__ KN) {
    constexpr int NDB = DSA ? 2 : 4;
    constexpr float THR = 6.0f;
    const int lane = lane_id_fresh(), w = WAVE_FRESH(), tid = w * 64 + lane, st = w >> 2, wq = w & 3, r32 = lane & 31, hh = lane >> 5;
    const int q0 = QB * 128, tq = q0 + 32 * wq + r32, nt = 2 * QB + 2, mychunk = 2 * QB + (wq >> 1);
    const int head = 2 * hsel + st;
    const float slope = DSA ? exp2f(-(float)(head + 1)) : exp2f(-2.0f * (float)(hsel + 1));
    const float SL = slope * LOG2E;
    bf16x8 qf[4];
    { const bf16_t* qp = Qg + ((size_t)((b * 8 + head) * 4096 + tq)) * 64 + 8 * hh;
#pragma unroll
      for (int ks = 0; ks < 4; ++ks) qf[ks] = *(const bf16x8*)(qp + 16 * ks); }
    float BQK;
    { float q2 = 0.f;
#pragma unroll
      for (int ks = 0; ks < 4; ++ks) { const u32x4 qw = __builtin_bit_cast(u32x4, qf[ks]);
          q2 += bf_lo(qw.x) * bf_lo(qw.x) + bf_hi(qw.x) * bf_hi(qw.x) + bf_lo(qw.y) * bf_lo(qw.y) + bf_hi(qw.y) * bf_hi(qw.y) + bf_lo(qw.z) * bf_lo(qw.z) + bf_hi(qw.z) * bf_hi(qw.z) + bf_lo(qw.w) * bf_lo(qw.w) + bf_hi(qw.w) * bf_hi(qw.w); }
      q2 += __shfl_xor(q2, 32);
#pragma unroll
      for (int o = 1; o < 32; o <<= 1) q2 = fmaxf(q2, __shfl_xor(q2, o));
      const float* knp = KN + ((b * 16 + (DSA ? 8 : 0) + head) * 2);
      BQK = sqrtf(q2) * sqrtf(fmaxf(knp[0], knp[1])) * 1.0001f + 0.01f; }
    asm volatile("" : "+v"(BQK));
    LAS int* DN = (LAS int*)(F.lds + LDS_B + 4096);
    if (lane == 0) DN[w] = -1;
    int mydn = -1;
    const int lrow = 8 * w + (lane >> 3), lc = (lane & 7) ^ ((lrow >> 1) & 7);
    const unsigned koff = (unsigned)(lrow * 64 + lc * 8) * 2u, voff = (unsigned)(lrow * 4096 + lc * 8) * 2u;
    const unsigned char* gb[4];
    gb[0] = (const unsigned char*)(Kg + ((size_t)((b * 8 + 2 * hsel + 0) * 4096)) * 64);
    gb[1] = (const unsigned char*)(Kg + ((size_t)((b * 8 + 2 * hsel + 1) * 4096)) * 64);
    if (DSA) { gb[2] = (const unsigned char*)(VTg + ((size_t)((b * 8 + 2 * hsel + 0) * 64)) * 4096); gb[3] = (const unsigned char*)(VTg + ((size_t)((b * 8 + 2 * hsel + 1) * 64)) * 4096); }
    else     { gb[2] = (const unsigned char*)(VTg + ((size_t)((b * 4 + hsel) * 128)) * 4096);         gb[3] = (const unsigned char*)(VTg + ((size_t)((b * 4 + hsel) * 128 + 64)) * 4096); }
    const u64* mgsrc = DSA ? (MASK + ((size_t)b * 64 * 4096 + q0) + 2 * lane) : nullptr;
    LAS unsigned char* const ring = F.lds + LDS_A + w * 1024;
    LAS unsigned char* const mring = F.lds + LDS_B + 12288;
#ifdef PROBE_DMA2
#define ATT_REP_ 2
#else
#define ATT_REP_ 1
#endif
#define ATT_ISSUE(TT, STG) do { const int tt_ = (TT) < 0 ? 0 : (TT); \
        _Pragma("unroll") for (int rr_ = 0; rr_ < ATT_REP_; ++rr_) _Pragma("unroll") for (int i_ = 0; i_ < 4; ++i_) __builtin_amdgcn_global_load_lds((const unsigned*)(gb[i_] + (i_ < 2 ? (size_t)tt_ * 8192 : (size_t)tt_ * 128) + (i_ < 2 ? koff : voff)), (LAS unsigned*)(ring + (STG) * 32768 + i_ * 8192), 16, 0, 0); \
        if (DSA && w == 0) __builtin_amdgcn_global_load_lds((const unsigned*)(mgsrc + (size_t)tt_ * 4096), (LAS unsigned*)(mring + (STG) * 1024), 16, 0, 0); } while (0)
    const int swz = (r32 >> 1) & 7;
    const int kbase = st * 8192 + r32 * 128, vbase = 16384 + ((DSA ? st * 64 : 0) + r32) * 128;
    f32x16 o[NDB];
#pragma unroll
    for (int i = 0; i < NDB; ++i)
#pragma unroll
        for (int r = 0; r < 16; ++r) o[i][r] = 0.f;
    float mref = -INFINITY, lsum = 0.f;
    ATT_ISSUE(nt - 1, 0); ATT_ISSUE(nt - 2, 1);
    for (int ip = 0; ip < nt / 2; ++ip) {
        asm volatile("s_waitcnt vmcnt(0)" ::: "memory");
        __builtin_amdgcn_s_barrier();
        asm volatile("" ::: "memory");
        if (ip > 0) {
            const u32x4 d0 = *(const LAS u32x4*)DN, d1 = *(const LAS u32x4*)(DN + 4);
            const int dm = min(min(min((int)d0.x, (int)d0.y), min((int)d0.z, (int)d0.w)), min(min((int)d1.x, (int)d1.y), min((int)d1.z, (int)d1.w)));
            if (dm >= nt - 1 - 2 * ip) break;
        }
        if (ip + 1 < nt / 2) { ATT_ISSUE(nt - 3 - 2 * ip, 2 * ((ip + 1) & 1)); ATT_ISSUE(nt - 4 - 2 * ip, 2 * ((ip + 1) & 1) + 1); }
#pragma unroll 1
        for (int sub = 0; sub < 2; ++sub) {
        const int t = nt - 1 - 2 * ip - sub, stg = 2 * (ip & 1) + sub;
        LAS unsigned char* sb = F.lds + LDS_A + stg * 32768;
        if (t <= mychunk && t > mydn) {
            bf16x8 pb[4];
            bf16x8 kf[8];
#pragma unroll
            for (int kb = 0; kb < 2; ++kb)
#pragma unroll
                for (int ks = 0; ks < 4; ++ks) kf[kb * 4 + ks] = *(const LAS bf16x8*)(sb + kbase + kb * 4096 + (((2 * ks + hh) ^ swz) << 4));
            const bool unset = (mref == -INFINITY);
            const float mr = unset ? 0.f : mref;
            const float relq = (float)(tq - 64 * t - 4 * hh);
            unsigned mlo = 0u, mhi = 0u;
            if (DSA) { const u64 mw = *(const LAS u64*)(mring + stg * 1024 + (32 * wq + r32) * 8) >> (4 * hh); mlo = (unsigned)mw; mhi = (unsigned)(mw >> 32); }
            f32x16 s[2];
            if (t == mychunk) {
#pragma unroll
                for (int kb = 0; kb < 2; ++kb)
#pragma unroll
                    for (int r = 0; r < 16; ++r) { const float c = (float)(32 * kb + (r & 3) + 8 * (r >> 2)); s[kb][r] = -SL * fabsf(relq - c) - mr; }
            } else {
                const float B0 = -SL * relq - mr, SL8 = 8.0f * SL;
                float gb_ = B0;
#pragma unroll
                for (int kb = 0; kb < 2; ++kb)
#pragma unroll
                    for (int g4 = 0; g4 < 4; ++g4) {
                        float e_ = gb_; s[kb][4 * g4] = e_;
#pragma unroll
                        for (int j = 1; j < 4; ++j) { e_ = fadd_s(e_, SL); s[kb][4 * g4 + j] = e_; }
                        gb_ = fadd_s(gb_, SL8);
                    }
            }
            if (DSA) {
#pragma unroll
                for (int kb = 0; kb < 2; ++kb)
#pragma unroll
                    for (int r = 0; r < 16; ++r) { const int tm = __builtin_amdgcn_sbfe((int)(kb ? mhi : mlo), (r & 3) + 8 * (r >> 2), 1);
                        const float sv = s[kb][r]; s[kb][r] = __int_as_float((__float_as_int(sv) & tm) | (~tm & (int)0xff800000)); }
            }
#pragma unroll
            for (int kb = 0; kb < 2; ++kb)
#pragma unroll
                for (int ks = 0; ks < 4; ++ks) s[kb] = __builtin_amdgcn_mfma_f32_32x32x16_bf16(kf[kb * 4 + ks], qf[ks], s[kb], 0, 0, 0);
            __builtin_amdgcn_sched_group_barrier(0x100, 4, 0);
#pragma unroll
            for (int i = 0; i < 4; ++i) { __builtin_amdgcn_sched_group_barrier(0x008, 1, 0); __builtin_amdgcn_sched_group_barrier(0x100, 1, 0); }
            __builtin_amdgcn_sched_group_barrier(0x008, 4, 0);
            float mx = -INFINITY;
#pragma unroll
            for (int kb = 0; kb < 2; ++kb)
#pragma unroll
                for (int r = 0; r < 16; ++r) mx = fmaxf(mx, s[kb][r]);
            mx = fmaxf(mx, __shfl_xor(mx, 32));
            const bool need = unset ? (mx != -INFINITY) : (mx > THR);
            if (__any(need)) {
                const float delta = need ? mx : 0.f;
                const float scl = (unset || !need) ? 1.f : __builtin_amdgcn_exp2f(-delta);
#pragma unroll
                for (int kb = 0; kb < 2; ++kb)
#pragma unroll
                    for (int r = 0; r < 16; ++r) s[kb][r] -= delta;
#pragma unroll
                for (int i = 0; i < NDB; ++i)
#pragma unroll
                    for (int r = 0; r < 16; ++r) o[i][r] *= scl;
                lsum *= scl;
                mref = need ? (mr + delta) : mref;
            }
#pragma unroll
            for (int r = 0; r < 16; ++r) { s[0][r] = __builtin_amdgcn_exp2f(s[0][r]); s[1][r] = __builtin_amdgcn_exp2f(s[1][r]); }
            __builtin_amdgcn_sched_barrier(0);
            float ps0 = s[0][0], ps1 = s[1][0];
#pragma unroll
            for (int r = 1; r < 16; ++r) { ps0 = fadd_s(ps0, s[0][r]); ps1 = fadd_s(ps1, s[1][r]); }
            lsum += ps0 + ps1;
#pragma unroll
            for (int kb = 0; kb < 2; ++kb)
#pragma unroll
                for (int s2 = 0; s2 < 2; ++s2) {
                    u32x4 pk; pk.x = cvt_pk_bf16(s[kb][8 * s2 + 0], s[kb][8 * s2 + 1]); pk.y = cvt_pk_bf16(s[kb][8 * s2 + 2], s[kb][8 * s2 + 3]);
                    pk.z = cvt_pk_bf16(s[kb][8 * s2 + 4], s[kb][8 * s2 + 5]); pk.w = cvt_pk_bf16(s[kb][8 * s2 + 6], s[kb][8 * s2 + 7]);
                    pb[2 * kb + s2] = __builtin_bit_cast(bf16x8, pk);
                }
#pragma unroll
            for (int db = 0; db < NDB; ++db)
#pragma unroll
                for (int sg = 0; sg < 4; ++sg) {
                    const bf16x8 a = *(const LAS bf16x8*)(sb + vbase + db * 4096 + (((2 * sg + hh) ^ swz) << 4));
                    o[db] = __builtin_amdgcn_mfma_f32_32x32x16_bf16(a, pb[sg], o[db], 0, 0, 0);
                }
            __builtin_amdgcn_sched_group_barrier(0x100, 4, 1);
#pragma unroll
            for (int i = 0; i < 4 * NDB - 4; ++i) { __builtin_amdgcn_sched_group_barrier(0x008, 1, 1); __builtin_amdgcn_sched_group_barrier(0x100, 1, 1); }
            __builtin_amdgcn_sched_group_barrier(0x008, 4, 1);
            if (t > 0) {
                const float dmin = (float)(q0 + 32 * wq - 64 * t + 1);
                const bool okk = (mref != -INFINITY) && (BQK - SL * dmin - mref < -150.0f);
                if (__all(okk)) { mydn = t - 1; if (lane == 0) DN[w] = t - 1; }
            }
        }
        }
    }
    asm volatile("s_waitcnt vmcnt(0)" ::: "memory");
#undef ATT_ISSUE
    __syncthreads();
    lsum += __shfl_xor(lsum, 32);
    const float inv = 1.0f / lsum;
    const size_t tok = (size_t)b * 4096 + tq;
    if (DSA) {
#pragma unroll
        for (int db = 0; db < NDB; ++db)
#pragma unroll
            for (int g4 = 0; g4 < 4; g4 += 2) {
                const float z = inv;
                u32x2 pa, pb2;
                pa.x = cvt_pk_bf16(o[db][4 * g4 + 0] * z, o[db][4 * g4 + 1] * z); pa.y = cvt_pk_bf16(o[db][4 * g4 + 2] * z, o[db][4 * g4 + 3] * z);
                pb2.x = cvt_pk_bf16(o[db][4 * g4 + 4] * z, o[db][4 * g4 + 5] * z); pb2.y = cvt_pk_bf16(o[db][4 * g4 + 6] * z, o[db][4 * g4 + 7] * z);
                { auto r_ = __builtin_amdgcn_permlane32_swap(pa.x, pb2.x, false, false); pa.x = r_[0]; pb2.x = r_[1]; }
                { auto r_ = __builtin_amdgcn_permlane32_swap(pa.y, pb2.y, false, false); pa.y = r_[0]; pb2.y = r_[1]; }
                *(u32x4*)(MIX + tok * D + 512 + head * 64 + 32 * db + 8 * g4 + 8 * hh) = (u32x4){pa.x, pa.y, pb2.x, pb2.y}; }
    } else {
        LAS float* XB = (LAS float*)(F.lds + LDS_A);
        const int xq = (32 * wq + r32) * 132 + 4 * hh;
        if (st == 1) {
#pragma unroll
            for (int db = 0; db < NDB; ++db)
#pragma unroll
                for (int g4 = 0; g4 < 4; ++g4) *(LAS f32x4*)(XB + xq + 32 * db + 8 * g4) = (f32x4){o[db][4 * g4] * inv, o[db][4 * g4 + 1] * inv, o[db][4 * g4 + 2] * inv, o[db][4 * g4 + 3] * inv};
        }
        __syncthreads();
        if (st == 0) {
            float ss = 0.f;
#pragma unroll
            for (int db = 0; db < NDB; ++db)
#pragma unroll
                for (int g4 = 0; g4 < 4; ++g4) { const f32x4 o1 = *(const LAS f32x4*)(XB + xq + 32 * db + 8 * g4);
#pragma unroll
                    for (int j = 0; j < 4; ++j) { const float a = o[db][4 * g4 + j] * inv - o1[j] * lam; o[db][4 * g4 + j] = a; ss += a * a; } }
            ss += __shfl_xor(ss, 32);
            const float rn = (1.0f / sqrtf(ss * (1.0f / 128.0f) + LN_EPS)) * (1.0f - lam_init);
#pragma unroll
            for (int db = 0; db < NDB; ++db)
#pragma unroll
                for (int g4 = 0; g4 < 4; g4 += 2) { const f32x4 ga = *(const f32x4*)(subln_g + 32 * db + 8 * g4 + 4 * hh), gb = *(const f32x4*)(subln_g + 32 * db + 8 * g4 + 8 + 4 * hh);
                    u32x2 pa, pb2;
                    pa.x = cvt_pk_bf16(o[db][4 * g4 + 0] * rn * ga[0], o[db][4 * g4 + 1] * rn * ga[1]); pa.y = cvt_pk_bf16(o[db][4 * g4 + 2] * rn * ga[2], o[db][4 * g4 + 3] * rn * ga[3]);
                    pb2.x = cvt_pk_bf16(o[db][4 * g4 + 4] * rn * gb[0], o[db][4 * g4 + 5] * rn * gb[1]); pb2.y = cvt_pk_bf16(o[db][4 * g4 + 6] * rn * gb[2], o[db][4 * g4 + 7] * rn * gb[3]);
                    { auto r_ = __builtin_amdgcn_permlane32_swap(pa.x, pb2.x, false, false); pa.x = r_[0]; pb2.x = r_[1]; }
                    { auto r_ = __builtin_amdgcn_permlane32_swap(pa.y, pb2.y, false, false); pa.y = r_[0]; pb2.y = r_[1]; }
                    *(u32x4*)(MIX + tok * D + hsel * 128 + 32 * db + 8 * g4 + 8 * hh) = (u32x4){pa.x, pa.y, pb2.x, pb2.y}; }
        }
        __syncthreads();
    }
}
struct CandTab { unsigned char a[52], b[52]; };
__host__ __device__ constexpr CandTab make_cand_tab() {
    CandTab t{}; int n = 0;
    for (int a = 0; a < 16; ++a) for (int b = 0; b < 16; ++b) if ((a + 1) * (b + 1) <= 16) { t.a[n] = (unsigned char)a; t.b[n] = (unsigned char)b; ++n; }
    for (; n < 52; ++n) { t.a[n] = 0; t.b[n] = 0; }
    return t;
}
constexpr CandTab CAND = make_cand_tab();
constexpr int NCAND = 50;

#define PK_CEX(A, B) do { const unsigned hi_ = (A) > (B) ? (A) : (B), lo_ = (A) > (B) ? (B) : (A); (A) = hi_; (B) = lo_; } while (0)
__device__ __forceinline__ void pk_bitonic_merge16(unsigned (&x)[16]) {
#pragma unroll
    for (int j = 8; j >= 1; j >>= 1)
#pragma unroll
        for (int i = 0; i < 16; ++i) { const int l = i ^ j; if (l > i) PK_CEX(x[i], x[l]); }
}
__device__ __forceinline__ void pk_sort16(unsigned (&x)[16]) {
#pragma unroll
    for (int k = 2; k <= 16; k <<= 1)
#pragma unroll
        for (int j = k >> 1; j >= 1; j >>= 1)
#pragma unroll
            for (int i = 0; i < 16; ++i) { const int l = i ^ j; if (l > i) { if ((i & k) == 0) PK_CEX(x[i], x[l]); else PK_CEX(x[l], x[i]); } }
}
template <int XM>
__device__ __forceinline__ void pk_merge_lanes16(unsigned (&x)[16]) {
    unsigned y[16];
#pragma unroll
    for (int i = 0; i < 16; ++i) y[i] = (unsigned)__shfl_xor((int)x[15 - i], XM);
#pragma unroll
    for (int i = 0; i < 16; ++i) x[i] = x[i] > y[i] ? x[i] : y[i];
    pk_bitonic_merge16(x);
}
__device__ __forceinline__ void peer_topk_phase(const Frame& F, const bf16_t* __restrict__ PQ, const bf16_t* __restrict__ SUBK_l, int* __restrict__ EG) {
    const int lane = lane_id_fresh(), w = WAVE_FRESH(), tid = w * 64 + lane, fr = lane & 15, fq = lane >> 4;
    const int pm = 16 * (F.wg & 7) + (F.wg >> 4), par = (F.wg >> 3) & 1;
    LAS unsigned char* sk = F.lds + LDS_A;
    LAS unsigned* LST = (LAS unsigned*)(F.lds + LDS_A + 65536) + w * 512;
#pragma unroll 1
    for (int hi = 0; hi < 4; ++hi) {
    const int h = par + 2 * hi;
    __syncthreads();
#pragma unroll
    for (int i = 0; i < 8; ++i) { const int id = tid + 512 * i, cs = id >> 11, row = (id >> 4) & 127, c16 = id & 15;
        const u32x4 v = *(const u32x4*)(SUBK_l + ((size_t)((h * 2 + cs) * 128 + row)) * 128 + c16 * 8);
        *(LAS u32x4*)(sk + cs * 32768 + row * 256 + ((c16 ^ (row & 15)) << 4)) = v; }
    __syncthreads();
    for (int it = 0; it < 2; ++it) {
        const int tt = 16 * pm + 2 * w + it, token = tt * 16 + fr;
#pragma unroll 1
        for (int cs = 0; cs < 2; ++cs) {
            bf16x8 qf[4];
#pragma unroll
            for (int ks = 0; ks < 4; ++ks) qf[ks] = *(const bf16x8*)(PQ + (size_t)(h >> 1) * PQ_PLANE + (size_t)token * 512 + (h & 1) * 256 + cs * 128 + 32 * ks + 8 * fq);
            unsigned x0[16], x1[16];
#pragma unroll
            for (int kt = 0; kt < 8; ++kt) {
                f32x4 sc = (f32x4){0.f, 0.f, 0.f, 0.f};
#pragma unroll
                for (int ks = 0; ks < 4; ++ks) { const int row = 16 * kt + fr, c16 = ks * 4 + fq;
                    const bf16x8 a = *(const LAS bf16x8*)(sk + cs * 32768 + row * 256 + ((c16 ^ (row & 15)) << 4));
                    sc = __builtin_amdgcn_mfma_f32_16x16x32_bf16(a, qf[ks], sc, 0, 0, 0); }
#pragma unroll
                for (int r = 0; r < 4; ++r) { const unsigned key = (f2sort(sc[r]) & ~127u) | (unsigned)(127 - (16 * kt + 4 * fq + r));
                    if (kt < 4) x0[kt * 4 + r] = key; else x1[(kt - 4) * 4 + r] = key; }
            }
            pk_sort16(x0); pk_sort16(x1);
#pragma unroll
            for (int i = 0; i < 16; ++i) x0[i] = x0[i] > x1[15 - i] ? x0[i] : x1[15 - i];
            pk_bitonic_merge16(x0);
            pk_merge_lanes16<16>(x0);
            pk_merge_lanes16<32>(x0);
            if (fq == 0) {
#pragma unroll
                for (int i = 0; i < 4; ++i) *(LAS u32x4*)(LST + cs * 256 + fr * 16 + 4 * i) = (u32x4){x0[4 * i], x0[4 * i + 1], x0[4 * i + 2], x0[4 * i + 3]};
            }
        }
        LDS_WAIT();
        unsigned win[16];
#pragma unroll
        for (int t = 0; t < 16; ++t) win[t] = 0u;
#pragma unroll
        for (int t = 0; t < 13; ++t) {
            const int a = fq == 0 ? CAND.a[t] : fq == 1 ? CAND.a[13 + t] : fq == 2 ? CAND.a[26 + t] : CAND.a[39 + t];
            const int bb = fq == 0 ? CAND.b[t] : fq == 1 ? CAND.b[13 + t] : fq == 2 ? CAND.b[26 + t] : CAND.b[39 + t];
            const unsigned k1 = LST[fr * 16 + a], k2 = LST[256 + fr * 16 + bb];
            const float cv = sort2f(k1 & ~127u) + sort2f(k2 & ~127u);
            const unsigned key = (f2sort(cv) & ~255u) | (unsigned)(255 - (a * 16 + bb));
            win[t] = (fq * 13 + t < NCAND) ? key : 0u;
        }
        pk_sort16(win);
        pk_merge_lanes16<16>(win);
        pk_merge_lanes16<32>(win);
        const float v0 = sort2f(win[0] & ~255u);
        float ev[16], es = 0.f;
#pragma unroll
        for (int k = 0; k < 16; ++k) { ev[k] = __expf(sort2f(win[k] & ~255u) - v0); es += ev[k]; }
        const float rs = 1.0f / es;
        int* egp = EG + ((size_t)token * 128 + h * 16) * 2;
#pragma unroll
        for (int k = 0; k < 16; ++k) {
            if ((k >> 2) == fq) {
                const unsigned flat = 255u - (win[k] & 255u), a = flat >> 4, bb = flat & 15u;
                const unsigned i1 = 127u - (LST[fr * 16 + a] & 127u), i2 = 127u - (LST[256 + fr * 16 + bb] & 127u);
                u32x2 e; e.x = i1 * 128u + i2; e.y = __float_as_uint(ev[k] * rs);
                *(u32x2*)(egp + 2 * k) = e;
            }
        }
        LDS_WAIT();
    }
    }
    __syncthreads();
}

__device__ __forceinline__ float cvt_ubyte(unsigned x, int k) {
    float r;
    if (k == 0) asm("v_cvt_f32_ubyte0 %0, %1" : "=v"(r) : "v"(x));
    else if (k == 1) asm("v_cvt_f32_ubyte1 %0, %1" : "=v"(r) : "v"(x));
    else if (k == 2) asm("v_cvt_f32_ubyte2 %0, %1" : "=v"(r) : "v"(x));
    else asm("v_cvt_f32_ubyte3 %0, %1" : "=v"(r) : "v"(x));
    return r;
}
__device__ __forceinline__ void peer_gather_phase(const Frame& F, const bf16_t* __restrict__ H1, const int* __restrict__ EG, const unsigned char* __restrict__ U8, const unsigned char* __restrict__ V8,
                                                  const float* __restrict__ USC, const float* __restrict__ VSC, bf16_t* __restrict__ R2) {
    const int lane = lane_id_fresh(), w = WAVE_FRESH(), fr = lane & 15, fq = lane >> 4;
    LAS unsigned char* wl = F.lds + LDS_A + w * 12288;
    LAS float* WL16 = (LAS float*)(wl + 4096);
    LAS unsigned char* XS = wl; LAS float* WL = (LAS float*)(wl + 1024); LAS int* EL = (LAS int*)(wl + 1536); LAS float* USL = (LAS float*)(wl + 2048); LAS float* VSL = (LAS float*)(wl + 2560);
    for (int gwi = (F.G == 256 ? 256 * (F.wg & 7) + 8 * (F.wg >> 3) + w : F.wg * NWAVES + w); gwi < T / 16; gwi += (F.G == 256 ? T / 16 : F.G * NWAVES)) {
    for (int it = 0; it < 16; ++it) {
        const int token = gwi * 16 + it;
        const int* eg = EG + (size_t)token * 256;
        unsigned uoff[8];
#pragma unroll
        for (int hh = 0; hh < 8; ++hh) uoff[hh] = (unsigned)eg[(hh * 16 + fr) * 2] * 512u + 16u * fq;
        const int e0 = eg[lane * 2], e1 = eg[(64 + lane) * 2];
        const float us0 = USC[e0], us1 = USC[e1], vs0 = VSC[e0], vs1 = VSC[e1], g0 = __int_as_float(eg[lane * 2 + 1]), g1 = __int_as_float(eg[(64 + lane) * 2 + 1]);
        const u32x4 x0 = *(const u32x4*)(H1 + (size_t)token * D + 16 * lane), x1 = *(const u32x4*)(H1 + (size_t)token * D + 16 * lane + 8);
        float xf[16] = {bf_lo(x0.x), bf_hi(x0.x), bf_lo(x0.y), bf_hi(x0.y), bf_lo(x0.z), bf_hi(x0.z), bf_lo(x0.w), bf_hi(x0.w), bf_lo(x1.x), bf_hi(x1.x), bf_lo(x1.y), bf_hi(x1.y), bf_lo(x1.z), bf_hi(x1.z), bf_lo(x1.w), bf_hi(x1.w)};
        float am = 0.f;
#pragma unroll
        for (int i = 0; i < 16; ++i) am = fmaxf(am, fabsf(xf[i]));
#pragma unroll
        for (int o = 1; o < 64; o <<= 1) am = fmaxf(am, __shfl_xor(am, o));
        const float xinv = am > 0.f ? am * (1.0f / 127.0f) : 1.0f, xsc = 1.0f / xinv;
        int xsum = 0;
        { unsigned xp[4] = {0u, 0u, 0u, 0u};
#pragma unroll
          for (int i = 0; i < 16; ++i) { int q = (int)rintf(xf[i] * xsc); q = q < -127 ? -127 : (q > 127 ? 127 : q); xsum += q; xp[i >> 2] |= ((unsigned)q & 0xffu) << (8 * (i & 3)); }
          *(LAS u32x4*)(XS + 16 * lane) = (u32x4){xp[0], xp[1], xp[2], xp[3]}; }
#pragma unroll
        for (int o = 1; o < 64; o <<= 1) xsum += __shfl_xor(xsum, o);
        LDS_WAIT();
        typedef int i32x4 __attribute__((ext_vector_type(4)));
        i32x4 acc[8];
#pragma unroll
        for (int hh = 0; hh < 8; ++hh) acc[hh] = (i32x4){0, 0, 0, 0};
#define U_LOAD(SET, P) do { _Pragma("unroll") for (int hh = 0; hh < 8; ++hh) SET[hh] = *(const u32x4*)(U8 + uoff[hh] + 64 * (P)); } while (0)
#define U_MMA(SET, P) do { const i32x4 xb0 = *(const LAS i32x4*)(XS + 128 * (P) + 32 * fq), xb1 = *(const LAS i32x4*)(XS + 128 * (P) + 32 * fq + 16); \
            _Pragma("unroll") for (int hh = 0; hh < 8; ++hh) { \
                const i32x4 a0 = (i32x4){(int)(SET[hh].x & 0x0f0f0f0fu), (int)(SET[hh].y & 0x0f0f0f0fu), (int)((SET[hh].x >> 4) & 0x0f0f0f0fu), (int)((SET[hh].y >> 4) & 0x0f0f0f0fu)}; \
                const i32x4 a1 = (i32x4){(int)(SET[hh].z & 0x0f0f0f0fu), (int)(SET[hh].w & 0x0f0f0f0fu), (int)((SET[hh].z >> 4) & 0x0f0f0f0fu), (int)((SET[hh].w >> 4) & 0x0f0f0f0fu)}; \
                acc[hh] = __builtin_amdgcn_mfma_i32_16x16x64_i8(a0, xb0, acc[hh], 0, 0, 0); \
                acc[hh] = __builtin_amdgcn_mfma_i32_16x16x64_i8(a1, xb1, acc[hh], 0, 0, 0); } } while (0)
        u32x4 ua[8], ub[8];
        U_LOAD(ua, 0); U_LOAD(ub, 1);
#pragma unroll 1
        for (int p = 0; p < 6; p += 2) {
            U_MMA(ua, p); U_LOAD(ua, p + 2);
            U_MMA(ub, p + 1); U_LOAD(ub, p + 3);
        }
        U_MMA(ua, 6); U_MMA(ub, 7);
#undef U_LOAD
#undef U_MMA
        LAS int* AL = (LAS int*)(wl + 1536);
        if (fr == 0) {
#pragma unroll
            for (int hh = 0; hh < 8; ++hh) *(LAS i32x4*)(AL + hh * 16 + 4 * fq) = acc[hh];
        }
        LDS_WAIT();
        { const float d0 = ((float)AL[lane] - 7.5f * (float)xsum) * us0 * xinv, d1 = ((float)AL[64 + lane] - 7.5f * (float)xsum) * us1 * xinv;
          WL16[it * 128 + lane] = g0 * (0.5f * d0 * (1.0f + erff(d0 * 0.70710678118654752f))) * vs0;
          WL16[it * 128 + 64 + lane] = g1 * (0.5f * d1 * (1.0f + erff(d1 * 0.70710678118654752f))) * vs1; }
        LDS_WAIT();
    }
    for (int it = 0; it < 16; ++it) {
        const int token = gwi * 16 + it;
        const int* eg = EG + (size_t)token * 256;
        const int e0 = eg[lane * 2], e1 = eg[(64 + lane) * 2];
        const u32x4 x0 = *(const u32x4*)(H1 + (size_t)token * D + 16 * lane), x1 = *(const u32x4*)(H1 + (size_t)token * D + 16 * lane + 8);
        const float xf[16] = {bf_lo(x0.x), bf_hi(x0.x), bf_lo(x0.y), bf_hi(x0.y), bf_lo(x0.z), bf_hi(x0.z), bf_lo(x0.w), bf_hi(x0.w), bf_lo(x1.x), bf_hi(x1.x), bf_lo(x1.y), bf_hi(x1.y), bf_lo(x1.z), bf_hi(x1.z), bf_lo(x1.w), bf_hi(x1.w)};
        LAS float* WL = WL16 + it * 128;
        f32x2 o2[8];
#pragma unroll
        for (int i = 0; i < 8; ++i) o2[i] = (f32x2){0.f, 0.f};
        const float wr0 = WL[lane], wr1 = WL[64 + lane];
        const unsigned vlane = 8u * (unsigned)lane;

#define V_LOAD(SET, EREG, S0) do { _Pragma("unroll") for (int i = 0; i < 16; ++i) { const unsigned e = (unsigned)__builtin_amdgcn_readlane(EREG, (S0) + i); \
            SET[i] = *(const u32x2*)(V8 + (size_t)e * 512u + vlane); } } while (0)
#define V_FMA(SET, WREG, S0) do { _Pragma("unroll") for (int i = 0; i < 16; ++i) { const float ws = __builtin_bit_cast(float, __builtin_amdgcn_readlane(__builtin_bit_cast(int, WREG), (S0) + i)); \
            asm volatile("" : "+v"(SET[i].x), "+v"(SET[i].y), "+v"(o2[0]), "+v"(o2[1]), "+v"(o2[2]), "+v"(o2[3]), "+v"(o2[4]), "+v"(o2[5]), "+v"(o2[6]), "+v"(o2[7])); \
            const f32x2 w2_ = (f32x2){ws, ws}; \
            o2[0] = w2_ * __builtin_amdgcn_cvt_scalef32_pk_f32_fp4(SET[i].x, 1.0f, 0) + o2[0]; o2[1] = w2_ * __builtin_amdgcn_cvt_scalef32_pk_f32_fp4(SET[i].x, 1.0f, 1) + o2[1]; \
            o2[2] = w2_ * __builtin_amdgcn_cvt_scalef32_pk_f32_fp4(SET[i].x, 1.0f, 2) + o2[2]; o2[3] = w2_ * __builtin_amdgcn_cvt_scalef32_pk_f32_fp4(SET[i].x, 1.0f, 3) + o2[3]; \
            o2[4] = w2_ * __builtin_amdgcn_cvt_scalef32_pk_f32_fp4(SET[i].y, 1.0f, 0) + o2[4]; o2[5] = w2_ * __builtin_amdgcn_cvt_scalef32_pk_f32_fp4(SET[i].y, 1.0f, 1) + o2[5]; \
            o2[6] = w2_ * __builtin_amdgcn_cvt_scalef32_pk_f32_fp4(SET[i].y, 1.0f, 2) + o2[6]; o2[7] = w2_ * __builtin_amdgcn_cvt_scalef32_pk_f32_fp4(SET[i].y, 1.0f, 3) + o2[7]; } } while (0)
        u32x2 va[16], vb2[16];
        V_LOAD(va, e0, 0); V_LOAD(vb2, e0, 16);
        V_FMA(va, wr0, 0); V_LOAD(va, e0, 32); V_FMA(vb2, wr0, 16); V_LOAD(vb2, e0, 48);
        V_FMA(va, wr0, 32); V_LOAD(va, e1, 0); V_FMA(vb2, wr0, 48); V_LOAD(vb2, e1, 16);
        V_FMA(va, wr1, 0); V_LOAD(va, e1, 32); V_FMA(vb2, wr1, 16); V_LOAD(vb2, e1, 48);
        V_FMA(va, wr1, 32); V_FMA(vb2, wr1, 48);
#undef V_LOAD
#undef V_FMA
        float out[16];
#pragma unroll
        for (int i = 0; i < 16; ++i) out[i] = o2[i >> 1][i & 1];
#ifdef PROBE_ZERO_PEER
#pragma unroll
        for (int i = 0; i < 16; ++i) out[i] = 0.f;
#endif
        u32x4 r0, r1;
        r0.x = cvt_pk_bf16(ALPHA * xf[0] + out[0], ALPHA * xf[1] + out[1]); r0.y = cvt_pk_bf16(ALPHA * xf[2] + out[2], ALPHA * xf[3] + out[3]);
        r0.z = cvt_pk_bf16(ALPHA * xf[4] + out[4], ALPHA * xf[5] + out[5]); r0.w = cvt_pk_bf16(ALPHA * xf[6] + out[6], ALPHA * xf[7] + out[7]);
        r1.x = cvt_pk_bf16(ALPHA * xf[8] + out[8], ALPHA * xf[9] + out[9]); r1.y = cvt_pk_bf16(ALPHA * xf[10] + out[10], ALPHA * xf[11] + out[11]);
        r1.z = cvt_pk_bf16(ALPHA * xf[12] + out[12], ALPHA * xf[13] + out[13]); r1.w = cvt_pk_bf16(ALPHA * xf[14] + out[14], ALPHA * xf[15] + out[15]);
        *(u32x4*)(R2 + (size_t)token * D + 16 * lane) = r0; *(u32x4*)(R2 + (size_t)token * D + 16 * lane + 8) = r1;
    }
    LDS_WAIT();
    }
}
struct AttnItems { unsigned short v[1024]; };
__host__ __device__ constexpr AttnItems make_attn_items() {
    AttnItems t{}; int n = 0;
    const int lim[4] = {11, 37, 64, 64};
    for (int c = 66; c >= 0; --c)
        for (int b = 0; b < 8; ++b) for (int h = 0; h < 4; ++h) for (int q = 0; q < 32; ++q) {
            int tiles = 2 * q + 2; if (tiles > lim[h]) tiles = lim[h];
            if (tiles + 2 == c) t.v[n++] = (unsigned short)((b << 7) | (h << 5) | q);
        }
    return t;
}
__device__ const AttnItems ATTN_ITEMS = make_attn_items();
struct AttnItems1 { unsigned char v[128]; };
__host__ __device__ constexpr AttnItems1 make_attn_items1() {
    AttnItems1 t{}; int n = 0;
    const int lim[4] = {11, 37, 64, 64};
    for (int c = 66; c >= 0; --c)
        for (int h = 0; h < 4; ++h) for (int q = 0; q < 32; ++q) {
            int tiles = 2 * q + 2; if (tiles > lim[h]) tiles = lim[h];
            if (tiles + 2 == c) t.v[n++] = (unsigned char)((h << 5) | q);
        }
    return t;
}
__device__ const AttnItems1 ATTN_ITEMS1 = make_attn_items1();
constexpr int PH_PER_LAYER = 10, N_PHASES = 1 + DEPTH * PH_PER_LAYER;
struct Args {
    const float *x, *p, *ln_in_g, *ln_in_b, *w_in, *w_out, *diff_lambda, *diff_subln_g, *ln1_g, *ln1_b, *peer_wq, *peer_subkeys, *peer_u, *peer_v, *ple_wg, *ple_bg, *ple_wp, *ln2_g, *ln2_b;
    float* out; unsigned char* ws; int ph_lo, ph_hi;
};
__global__ void __launch_bounds__(NTHREADS, 2) fwd_kernel(Args args) {
    extern __shared__ __attribute__((aligned(16))) unsigned char lds_raw[];
    Frame F;
    F.lds = (LAS unsigned char*)lds_raw;
    F.tid = threadIdx.x; F.lane = F.tid & 63; F.wave = __builtin_amdgcn_readfirstlane(F.tid >> 6);
    F.G = gridDim.x; F.wg = blockIdx.x; F.ws = args.ws;
    unsigned char* ws = args.ws;
    if (F.tid < 64) ((LAS unsigned*)(F.lds + LDS_CTL))[F.tid] = 0u;
    __syncthreads();
    const int lo = args.ph_lo, hi = args.ph_hi; (void)lo; (void)hi;
#ifndef PHASE_MASK
#define PHASE_MASK 0x7ff
#endif
#ifndef REPEAT_MASK
#define REPEAT_MASK 0
#endif
#define REP(k) (1 + ((REPEAT_MASK >> (k)) & 1))
#define IN(k) (lo <= (k) && (k) < hi)
#define BOTH(k) (IN(k) && IN((k) + 1))
#if MK_PER_PHASE
#define GRID_BAR(k) do { } while (0)
#define GRP_BAR(k) do { } while (0)
#define PAIR_BAR(k) do { } while (0)
#else
    XcdBarrier bar = xcd_barrier_post((unsigned*)(ws + WS_CTL) + 4096, (volatile LAS unsigned*)(F.lds + LDS_CTL));
    if (F.G == 256) group_post(bar, (unsigned)(F.wg & 7));
#define GRID_BAR(k) do { if (BOTH(k)) { unsigned z_ = 0u; asm volatile("" : "+s"(z_)); XcdBarrier b2_ = bar; b2_.bar = bar.bar + z_; asm volatile("" : "+s"(b2_.x)); xcd_barrier(b2_); } } while (0)
#define GRP_BAR(k) do { if (BOTH(k)) { unsigned z_ = 0u; asm volatile("" : "+s"(z_)); XcdBarrier b2_ = bar; b2_.bar = bar.bar + z_; asm volatile("" : "+s"(b2_.x)); \
        group_barrier(b2_, XB_GRP(F.G == 256 ? (unsigned)(F.wg & 7) : 0u), F.G == 256 ? 32u : (unsigned)F.G); } } while (0)
#define TILE_PM (16 * (F.wg & 7) + (F.wg >> 4))
#define TILE_PAR ((F.wg >> 3) & 1)
#define PAIR_BAR(k) do { if (BOTH(k)) { unsigned z_ = 0u; asm volatile("" : "+s"(z_)); XcdBarrier b2_ = bar; b2_.bar = bar.bar + z_; asm volatile("" : "+s"(b2_.x)); \
        if (F.G == 256) group_barrier(b2_, XB_PAIR((unsigned)(TILE_PM)), 2u, 4); else group_barrier(b2_, XB_GRP(0u), (unsigned)F.G); } } while (0)
#endif
    const int gw = F.wg * NWAVES + F.wave, NGW = F.G * NWAVES;
#define ROW_BASE (F.G == 256 ? 4096 * (F.wg & 7) + 8 * (F.wg >> 3) + F.wave : gw)
#define ROW_STRIDE (F.G == 256 ? 256 : NGW)
#define ROW_END (F.G == 256 ? 4096 * ((F.wg & 7) + 1) : T)
#define TROW_BASE (F.G == 256 ? 256 * (16 * (F.wg & 7) + (F.wg >> 4)) + 128 * ((F.wg >> 3) & 1) + F.wave : gw)
#define TROW_STRIDE (F.G == 256 ? 8 : NGW)
#define TROW_END (F.G == 256 ? 256 * (16 * (F.wg & 7) + (F.wg >> 4)) + 128 * ((F.wg >> 3) & 1) + 128 : T)
    typedef const __attribute__((address_space(4))) Args* kargs_t;
    const kargs_t kp0 = (kargs_t)__builtin_amdgcn_kernarg_segment_ptr();
#define PHASE_ARGS() kargs_t ap = kp0; asm volatile("" : "+s"(ap)); unsigned char* const wsl = ap->ws; (void)wsl
#define H ((bf16_t*)(wsl + WS_H))
#define H1 ((bf16_t*)(wsl + WS_H1))
#define MIX ((bf16_t*)(wsl + WS_MIX))
#define R2 ((bf16_t*)(wsl + WS_R2))
#define RF ((bf16_t*)(wsl + WS_RF))
#define DQ ((bf16_t*)(wsl + WS_DQ))
#define DK ((bf16_t*)(wsl + WS_DK))
#define DVT ((bf16_t*)(wsl + WS_DVT))
#define SQ ((bf16_t*)(wsl + WS_SQ))
#define SK ((bf16_t*)(wsl + WS_SK))
#define SVT ((bf16_t*)(wsl + WS_SVT))
#define IQ ((bf16_t*)(wsl + WS_IQ))
#define IK ((bf16_t*)(wsl + WS_IK))
#define IW ((float*)(wsl + WS_IW))
#define PQ ((bf16_t*)(wsl + WS_PQ))
#define EG ((int*)(wsl + WS_EG))
#define MASK ((u64*)(wsl + WS_MASK))
#define PP MIX

    if (((PHASE_MASK >> 0) & 1) && IN(0)) for (int rep_ = 0; rep_ < REP(0); ++rep_) {
        PHASE_ARGS();
        LAS float* scr = (LAS float*)(F.lds + LDS_A + F.wave * 8448);
        for (int l = 0; l < DEPTH; ++l) {
            const float* win = ap->w_in + (size_t)l * D * IN_COLS;
            bf16_t* WIN = (bf16_t*)(wsl + WS_WIN) + (size_t)l * NMAIN * D; bf16_t* WINV = (bf16_t*)(wsl + WS_WINV) + (size_t)l * NVV * D;
#define DO_SEG(sgi, W_, WT_, K_, ldn_, c0_, nvalid_, ncols_) do { const int nblk = (ncols_) / 32, items = ((K_) / 64) * nblk, rot = (l * 9 + (sgi)) * 397; \
                for (int it = (gw + rot) % NGW; it < items; it += NGW) transpose_item((W_), (K_), (ldn_), (c0_), (nvalid_), (WT_), scr, it / nblk, it % nblk, F.lane); } while (0)
            DO_SEG(0, win, WIN, D, IN_COLS, 0, 1024, 1024);
            DO_SEG(1, win, WIN + (size_t)1024 * D, D, IN_COLS, 1536, 1024, 1024);
            DO_SEG(2, win, WIN + (size_t)2048 * D, D, IN_COLS, 3072, 324, 512);
            DO_SEG(3, win, WINV, D, IN_COLS, 1024, 512, 512);
            DO_SEG(4, win, WINV + (size_t)512 * D, D, IN_COLS, 2560, 512, 512);
            DO_SEG(5, ap->w_out + (size_t)l * D * D, (bf16_t*)(wsl + WS_WOUT) + (size_t)l * D * D, D, D, 0, D, D);
            DO_SEG(6, ap->peer_wq + (size_t)l * D * 2048, (bf16_t*)(wsl + WS_WPQ) + (size_t)l * 2048 * D, D, 2048, 0, 2048, 2048);
            DO_SEG(7, ap->ple_wg + (size_t)l * D * D, (bf16_t*)(wsl + WS_WG) + (size_t)l * D * D, D, D, 0, D, D);
            DO_SEG(8, ap->ple_wp + (size_t)l * 256 * D, (bf16_t*)(wsl + WS_WP) + (size_t)l * D * 256, 256, D, 0, D, D);
#undef DO_SEG
        }
        const size_t gtid = (size_t)F.wg * NTHREADS + F.tid, gthreads = (size_t)F.G * NTHREADS;
        convert_rows_i4(ap->peer_u, ws + WS_U8, (float*)(wsl + WS_USC), DEPTH * 16384, gw, NGW, F.lane);
        convert_rows_fp4(ap->peer_v, ws + WS_V8, (float*)(wsl + WS_VSC), DEPTH * 16384, gw, NGW, F.lane);
        convert_f32_bf16(ap->p, (bf16_t*)(wsl + WS_P16), (size_t)DEPTH * T * 256, gtid, gthreads);
        convert_f32_bf16(ap->peer_subkeys, (bf16_t*)(wsl + WS_SUBK), (size_t)DEPTH * 8 * 2 * 128 * 128, gtid, gthreads);
        for (int m = ROW_BASE; m < ROW_END; m += ROW_STRIDE) ln_row(ap->x + (size_t)m * D, ap->ln_in_g, ap->ln_in_b, H + (size_t)m * D, nullptr, F.lane);
        __syncthreads();
    }
    GRID_BAR(0);
#if !MK_PER_PHASE
    if (F.G == 256 && BOTH(0)) group_resolve(bar, (unsigned)(F.wg & 7));
#endif

    for (int l = 0; l < DEPTH; ++l) {
        const int pb = 1 + PH_PER_LAYER * l;
        const float lam_init = 0.8f - 0.6f * expf(-0.3f * (float)l);
        if (((PHASE_MASK >> 1) & 1) && IN(pb + 0)) for (int rep_ = 0; rep_ < REP(1); ++rep_) { PHASE_ARGS();
            { pg8::Gemm g{H, (const bf16_t*)(wsl + WS_WIN) + (size_t)l * NMAIN * D, T, NMAIN, D}; pg8::StaticOrder S; S.init(T, NMAIN, F.G, F.wg);
              epi::Proj E{DQ, DK, SQ, SK, IQ, IK, IW};
              pg8::gemm_phase<epi::Proj, pg8::StaticOrder, true, true>(F.lds + LDS_A, g, S, E, WAVE_FRESH()); }
            { pg8::Gemm g{H, (const bf16_t*)(wsl + WS_WINV) + (size_t)l * NVV * D, T, NVV, D}; pg8::StaticOrder S; S.init(T, NVV, F.G, F.wg);
              epi::ProjV E{DVT, SVT};
              pg8::gemm_phase<epi::ProjV, pg8::StaticOrder, true, true>(F.lds + LDS_A, g, S, E, WAVE_FRESH()); }
        }
        GRP_BAR(pb + 0);
        if (((PHASE_MASK >> 2) & 1) && IN(pb + 1)) for (int rep_ = 0; rep_ < REP(2); ++rep_) { PHASE_ARGS();
            for (int g = F.wg; g < 256; g += F.G) {
                const int kb_ = g & 7, pr = g >> 3, h16 = pr >> 1, hf = pr & 1;
                const bf16_t* Kt = (h16 < 8 ? DK : SK) + ((size_t)((kb_ * 8 + (h16 & 7)) * 4096 + hf * 2048)) * 64;
                knorm_item(F, Kt, (float*)(wsl + WS_KN) + ((kb_ * 16 + h16) * 2 + hf));
            }
            for (int g = F.wg; g < 256; g += F.G) {
                const int b = g & 7, j = g >> 3;
#pragma unroll 1
                for (int k = 0; k < 2; ++k) select_item(F, b, k ? j : 63 - j, IQ, IK, IW, MASK);
            }
        }
        GRP_BAR(pb + 1);
        if (((PHASE_MASK >> 3) & 1) && IN(pb + 2)) for (int rep_ = 0; rep_ < REP(3); ++rep_) { PHASE_ARGS();
            LAS float* lamw = (LAS float*)(F.lds + LDS_B + 8192);
            if (F.wave == 0) {
                const float* lv = ap->diff_lambda + (size_t)l * 256; const int ln = lane_id_fresh();
                const float s01 = wave_sum(lv[ln] * lv[64 + ln]), s23 = wave_sum(lv[128 + ln] * lv[192 + ln]);
                if (ln == 0) lamw[0] = expf(s01) - expf(s23) + lam_init;
            }
            __syncthreads();
            const float lam = lamw[0];
            const float* sg = ap->diff_subln_g + (size_t)l * 128;
#ifdef ATTN_GLOBAL_DEAL
            for (int r = 0; r < 4; ++r) {
                for (int g = F.wg; g < 256; g += F.G) {
                    const int itm = ATTN_ITEMS.v[256 * r + ((r & 1) ? 255 - g : g)];
                    attn_item<false>(F, itm >> 7, (itm >> 5) & 3, itm & 31, DQ, DK, DVT, nullptr, MIX, lam, lam_init, sg, (const float*)(wsl + WS_KN));
                }
            }
            for (int r = 0; r < 4; ++r) {
                for (int g = F.wg; g < 256; g += F.G) {
                    const int itm = ATTN_ITEMS.v[256 * r + ((r & 1) ? 255 - g : g)];
                    attn_item<true>(F, itm >> 7, (itm >> 5) & 3, itm & 31, SQ, SK, SVT, MASK, MIX, 0.f, 0.f, nullptr, (const float*)(wsl + WS_KN));
                }
            }
#else
            for (int r = 0; r < 4; ++r) {
                for (int g = F.wg; g < 256; g += F.G) {
                    const int xb = g & 7, c = g >> 3, itm = ATTN_ITEMS1.v[32 * r + ((r & 1) ? 31 - c : c)];
                    attn_item<false>(F, xb, itm >> 5, itm & 31, DQ, DK, DVT, nullptr, MIX, lam, lam_init, sg, (const float*)(wsl + WS_KN));
                }
            }
            for (int r = 0; r < 4; ++r) {
                for (int g = F.wg; g < 256; g += F.G) {
                    const int xb = g & 7, c = g >> 3, itm = ATTN_ITEMS1.v[32 * r + ((r & 1) ? 31 - c : c)];
                    attn_item<true>(F, xb, itm >> 5, itm & 31, SQ, SK, SVT, MASK, MIX, 0.f, 0.f, nullptr, (const float*)(wsl + WS_KN));
                }
            }
#endif
        }
        GRP_BAR(pb + 2);
        if (((PHASE_MASK >> 4) & 1) && IN(pb + 3)) for (int rep_ = 0; rep_ < REP(4); ++rep_) { PHASE_ARGS();
            pg8::Gemm g{MIX, (const bf16_t*)(wsl + WS_WOUT) + (size_t)l * D * D, T, D, D}; pg8::StaticOrder S; if (F.G == 256) S.init_tile(D, TILE_PM, TILE_PAR); else S.init(T, D, F.G, F.wg);
            epi::OutRes E{H, RF};
            pg8::gemm_phase<epi::OutRes, pg8::StaticOrder, true, true>(F.lds + LDS_A, g, S, E, WAVE_FRESH());
        }
        PAIR_BAR(pb + 3);
        if (((PHASE_MASK >> 5) & 1) && IN(pb + 4)) for (int rep_ = 0; rep_ < REP(5); ++rep_) { PHASE_ARGS();
            ln_rows_bf(RF, ap->ln1_g + (size_t)l * D, ap->ln1_b + (size_t)l * D, H1, nullptr, TROW_BASE, TROW_STRIDE, TROW_END, lane_id_fresh());
        }
        PAIR_BAR(pb + 4);
        if (((PHASE_MASK >> 6) & 1) && IN(pb + 5)) for (int rep_ = 0; rep_ < REP(6); ++rep_) { PHASE_ARGS();
            pg8::Gemm g{H1, (const bf16_t*)(wsl + WS_WPQ) + (size_t)l * 2048 * D, T, 2048, D}; pg8::StaticOrder S; if (F.G == 256) S.init_tile(2048, TILE_PM, TILE_PAR); else S.init(T, 2048, F.G, F.wg);
            epi::PlainBf16 E{PQ, 512, 1, 1, (unsigned)PQ_PLANE};
            pg8::gemm_phase<epi::PlainBf16, pg8::StaticOrder, true, true>(F.lds + LDS_A, g, S, E, WAVE_FRESH());
        }
        PAIR_BAR(pb + 5);
        if (((PHASE_MASK >> 7) & 1) && IN(pb + 6)) for (int rep_ = 0; rep_ < REP(7); ++rep_) { PHASE_ARGS(); peer_topk_phase(F, PQ, (const bf16_t*)(wsl + WS_SUBK) + (size_t)l * 8 * 2 * 128 * 128, EG); }
        PAIR_BAR(pb + 6);
        if (((PHASE_MASK >> 8) & 1) && IN(pb + 7)) for (int rep_ = 0; rep_ < REP(8); ++rep_) { PHASE_ARGS(); peer_gather_phase(F, H1, EG, ws + WS_U8 + (size_t)l * 16384 * 512, ws + WS_V8 + (size_t)l * 16384 * 512, (const float*)(wsl + WS_USC) + (size_t)l * 16384, (const float*)(wsl + WS_VSC) + (size_t)l * 16384, R2); }
        PAIR_BAR(pb + 7);
        if (((PHASE_MASK >> 9) & 1) && IN(pb + 8)) for (int rep_ = 0; rep_ < REP(9); ++rep_) { PHASE_ARGS();
            { pg8::Gemm g{(const bf16_t*)(wsl + WS_P16) + (size_t)l * T * 256, (const bf16_t*)(wsl + WS_WP) + (size_t)l * D * 256, T, D, 256}; pg8::StaticOrder S; if (F.G == 256) S.init_tile(D, TILE_PM, TILE_PAR); else S.init(T, D, F.G, F.wg);
              epi::PlainBf16 E{PP, D, 8, 255, 0u};
              pg8::gemm_phase<epi::PlainBf16, pg8::StaticOrder, true, true>(F.lds + LDS_A, g, S, E, WAVE_FRESH()); }
            VM_WAIT(); __syncthreads();
            { pg8::Gemm g{R2, (const bf16_t*)(wsl + WS_WG) + (size_t)l * D * D, T, D, D}; pg8::StaticOrder S; if (F.G == 256) S.init_tile(D, TILE_PM, TILE_PAR); else S.init(T, D, F.G, F.wg);
              epi::Gate E{R2, PP, ap->ple_bg + (size_t)l * D, RF};
              pg8::gemm_phase<epi::Gate, pg8::StaticOrder, true, true>(F.lds + LDS_A, g, S, E, WAVE_FRESH()); }
        }
        PAIR_BAR(pb + 8);
        if (((PHASE_MASK >> 10) & 1) && IN(pb + 9)) for (int rep_ = 0; rep_ < REP(10); ++rep_) { PHASE_ARGS();
            const bool last = (l == DEPTH - 1);
            ln_rows_bf(RF, ap->ln2_g + (size_t)l * D, ap->ln2_b + (size_t)l * D, last ? nullptr : H, last ? ap->out : nullptr, TROW_BASE, TROW_STRIDE, TROW_END, lane_id_fresh());
        }
        if (l + 1 < DEPTH) GRP_BAR(pb + 9);
    }
#undef IN
#undef BOTH
#undef H
#undef H1
#undef MIX
#undef R2
#undef RF
#undef DQ
#undef DK
#undef DVT
#undef SQ
#undef SK
#undef SVT
#undef IQ
#undef IK
#undef IW
#undef PQ
#undef EG
#undef MASK
#undef PP
}

extern "C" void kernel_launch(void* const* d_in, const int* in_sizes, int n_in, void* d_out, int out_size, void* d_ws, size_t ws_size, hipStream_t stream) {
    static int grid = 0;
    if (grid == 0) {
        if (n_in != 19 || in_sizes[0] != T * D || out_size != T * D || ws_size < WS_END) {
            fprintf(stderr, "kernel_launch: unexpected problem: n_in %d in0 %d out %d ws %zu (need %zu); nothing launched\n", n_in, n_in > 0 ? in_sizes[0] : -1, out_size, ws_size, (size_t)WS_END); grid = -1; return; }
        int dev = 0, cus = 0, per_cu = 0;
        if (hipGetDevice(&dev) != hipSuccess || hipDeviceGetAttribute(&cus, hipDeviceAttributeMultiprocessorCount, dev) != hipSuccess) { fprintf(stderr, "kernel_launch: device query failed\n"); grid = -1; return; }
        if (hipFuncSetAttribute((const void*)fwd_kernel, hipFuncAttributeMaxDynamicSharedMemorySize, LDS_BYTES) != hipSuccess) { fprintf(stderr, "kernel_launch: hipFuncSetAttribute failed\n"); grid = -1; return; }
        if (hipOccupancyMaxActiveBlocksPerMultiprocessor(&per_cu, (const void*)fwd_kernel, NTHREADS, LDS_BYTES) != hipSuccess || per_cu < 1) { fprintf(stderr, "kernel_launch: occupancy query says %d blocks per CU\n", per_cu); }
        (void)hipGetLastError();
        grid = cus < 256 ? cus : 256;
    }
    if (grid < 0) return;
    if (hipMemsetAsync((char*)d_ws + WS_CTL, 0, CTL_ZERO_BYTES, stream) != hipSuccess) { fprintf(stderr, "kernel_launch: memset failed\n"); return; }
    Args a{};
    a.x = (const float*)d_in[0]; a.p = (const float*)d_in[1]; a.ln_in_g = (const float*)d_in[2]; a.ln_in_b = (const float*)d_in[3]; a.w_in = (const float*)d_in[4]; a.w_out = (const float*)d_in[5];
    a.diff_lambda = (const float*)d_in[6]; a.diff_subln_g = (const float*)d_in[7]; a.ln1_g = (const float*)d_in[8]; a.ln1_b = (const float*)d_in[9]; a.peer_wq = (const float*)d_in[10];
    a.peer_subkeys = (const float*)d_in[11]; a.peer_u = (const float*)d_in[12]; a.peer_v = (const float*)d_in[13]; a.ple_wg = (const float*)d_in[14]; a.ple_bg = (const float*)d_in[15];
    a.ple_wp = (const float*)d_in[16]; a.ln2_g = (const float*)d_in[17]; a.ln2_b = (const float*)d_in[18];
    a.out = (float*)d_out; a.ws = (unsigned char*)d_ws;
#if MK_PER_PHASE
    for (int ph = 0; ph < N_PHASES; ++ph) { a.ph_lo = ph; a.ph_hi = ph + 1; hipLaunchKernelGGL(fwd_kernel, dim3(grid), dim3(NTHREADS), LDS_BYTES, stream, a); }
#else
    a.ph_lo = 0; a.ph_hi = N_PHASES;
    hipLaunchKernelGGL(fwd_kernel, dim3(grid), dim3(NTHREADS), LDS_BYTES, stream, a);
#endif
    const hipError_t le = hipPeekAtLastError();
    if (le != hipSuccess) fprintf(stderr, "kernel_launch: launch failed: %s\n", hipGetErrorName(le));
}
```

```cpp
#include <hip/hip_runtime.h>
#include <cstdio>
#include <cstdint>
#include <cmath>

#ifndef MK_PER_PHASE
#define MK_PER_PHASE 0
#endif

#define LAS __attribute__((address_space(3)))
typedef unsigned short bf16_t;
typedef short bf16x8 __attribute__((ext_vector_type(8)));
typedef float f32x4 __attribute__((ext_vector_type(4)));
typedef float f32x2 __attribute__((ext_vector_type(2)));
typedef unsigned u32x4 __attribute__((ext_vector_type(4)));
typedef unsigned u32x2 __attribute__((ext_vector_type(2)));
typedef unsigned long long u64;

constexpr int D = 1024, BATCH = 8, SEQ = 4096, DEPTH = 4, T = BATCH * SEQ;
constexpr int IN_COLS = 3396;
constexpr int NMAIN = 2560;
constexpr int NVV = 1024;
constexpr int NWAVES = 8, NTHREADS = 512;
constexpr float LN_EPS = 1e-5f;
constexpr float ALPHA = 1.6817928305074290f;
constexpr float LOG2E = 1.4426950408889634f;

constexpr size_t MiB = 1u << 20;
constexpr size_t WS_CTL = 0, CTL_ZERO_BYTES = 1 * MiB;
constexpr size_t WS_WIN = 1 * MiB;
constexpr size_t WS_WINV = 21 * MiB;
constexpr size_t WS_WOUT = 29 * MiB;
constexpr size_t WS_WPQ = 37 * MiB;
constexpr size_t WS_WG = 53 * MiB;
constexpr size_t WS_WP = 61 * MiB;
constexpr size_t WS_SUBK = 63 * MiB;
constexpr size_t WS_U8 = 65 * MiB;
constexpr size_t WS_V8 = 129 * MiB;
constexpr size_t WS_USC = 193 * MiB;
constexpr size_t WS_VSC = 194 * MiB;
constexpr size_t WS_KN = 195 * MiB;
constexpr size_t WS_P16 = 321 * MiB;
constexpr size_t WS_H = 385 * MiB;
constexpr size_t WS_H1 = 449 * MiB;
constexpr size_t WS_MIX = 513 * MiB;
constexpr size_t WS_R2 = 577 * MiB;
constexpr size_t WS_RF = 641 * MiB;
constexpr size_t WS_PROJ = 769 * MiB;
constexpr size_t WS_DQ = WS_PROJ + 0 * MiB, WS_DK = WS_PROJ + 32 * MiB, WS_DVT = WS_PROJ + 64 * MiB, WS_SQ = WS_PROJ + 96 * MiB, WS_SK = WS_PROJ + 128 * MiB,
                 WS_SVT = WS_PROJ + 160 * MiB, WS_IQ = WS_PROJ + 192 * MiB, WS_IK = WS_PROJ + 208 * MiB, WS_IW = WS_PROJ + 212 * MiB;
constexpr size_t WS_PQ = WS_PROJ;
constexpr size_t PQ_PLANE = 32 * MiB / 2;
constexpr size_t WS_EG = WS_PROJ + 128 * MiB;
constexpr size_t WS_MASK = 993 * MiB;
constexpr size_t WS_END = 1009 * MiB;

constexpr int LDS_A = 0;
constexpr int LDS_B = 131072;
constexpr int LDS_CTL = 153600;
constexpr int LDS_BYTES = 155648;

__device__ __forceinline__ unsigned cvt_pk_bf16(float lo, float hi) { unsigned r; asm volatile("v_cvt_pk_bf16_f32 %0, %1, %2" : "=v"(r) : "v"(lo), "v"(hi)); return r; }
__device__ __forceinline__ float bf_lo(unsigned w) { return __uint_as_float(w << 16); }
__device__ __forceinline__ float bf_hi(unsigned w) { return __uint_as_float(w & 0xffff0000u); }
__device__ __forceinline__ float wave_sum(float v) {
#pragma unroll
    for (int o = 1; o < 64; o <<= 1) v += __shfl_xor(v, o);
    return v;
}
__device__ __forceinline__ unsigned f2sort(float f) { const unsigned u = __float_as_uint(f); return (u & 0x80000000u) ? ~u : (u | 0x80000000u); }
__device__ __forceinline__ float sort2f(unsigned s) { const unsigned u = (s & 0x80000000u) ? (s & 0x7fffffffu) : ~s; return __uint_as_float(u); }
__device__ __forceinline__ int lane_id_fresh() { int l; asm volatile("v_mbcnt_lo_u32_b32 %0, -1, 0\n\tv_mbcnt_hi_u32_b32 %0, -1, %0" : "=v"(l)); return l; }
#define WAVE_FRESH() ({ int w_ = F.wave; asm volatile("" : "+s"(w_)); w_; })
#define LDS_WAIT() asm volatile("s_waitcnt lgkmcnt(0)" ::: "memory")
#define VM_WAIT() asm volatile("s_waitcnt vmcnt(0)" ::: "memory")
namespace pg8 {
#define PG8_LAS __attribute__((address_space(3)))
constexpr int BM = 256, BK = 64, HALF = 128, HTB = HALF * BK * 2  , STAGE_BYTES = 8 * HTB, NXCD = 8, WGM = 8;

__host__ __device__ __forceinline__ int lds_byte(int r, int c) { const int st = (r >> 4) * 2 + (c >> 5), rr = r & 15, cc = c & 31, ob = rr * 64 + cc * 2; return st * 1024 + (ob ^ (((ob >> 9) & 1) << 5)); }
__host__ __device__ __forceinline__ void stage_rc(int b, int& R, int& C) { const int st = b / 1024, sb = b % 1024, swz = sb ^ (((sb >> 9) & 1) << 5); R = (st >> 1) * 16 + swz / 64; C = (st & 1) * 32 + (swz % 64) / 2; }
__host__ __device__ __forceinline__ int perm32(int rho) { const int n = rho >> 4, i = rho & 15; return 8 * (i >> 2) + 4 * n + (i & 3); }

struct Unit { int pm, pn; };
struct Gemm { const bf16_t* A; const bf16_t* Bt; int M, N, K; };

struct StaticOrder {
    int nM, nN, nwg, G, c, tile;
    __host__ __device__ void init(int M, int N, int G_, int c_) { nM = M / BM; nN = N / BM; nwg = nM * nN; G = G_; c = c_; tile = -1; }
    __host__ __device__ void init_tile(int N, int tile_, int par) { nM = 0; nN = N / BM; nwg = 0; G = 0; c = par; tile = tile_; }
    __host__ __device__ bool next(int i, Unit& u) const {
        if (tile >= 0) { const int pn = c + 2 * i; if (pn >= nN) return false; u.pm = tile; u.pn = pn; return true; }
        const long L = (long)i * G + c; if (L >= nwg) return false;
        int wgid = (int)L; { const int q = nwg / NXCD, r = nwg % NXCD, xcd = wgid % NXCD, off = wgid / NXCD; wgid = (xcd < r ? xcd * (q + 1) : r * (q + 1) + (xcd - r) * q) + off; }
        const int nig = WGM * nN, gid = wgid / nig, fm = gid * WGM, gsz = (nM - fm) < WGM ? (nM - fm) : WGM;
        u.pm = fm + ((wgid % nig) % gsz); u.pn = (wgid % nig) / gsz; return true;
    }
    __device__ __forceinline__ void a_ready(const Unit&) const {}
    __device__ __forceinline__ void done(const Unit&) const {}
};

template <class Epi, class Sched, bool ALIGN_EPI = false, bool SP2 = false>
__device__ __forceinline__ void gemm_phase(PG8_LAS unsigned char* lds, const Gemm g, const Sched& S, const Epi& E, int wave_id) {
    const int lane = lane_id_fresh(), wid = wave_id, tid = wid * 64 + lane,
              wr = wid >> 2, wc = wid & 3, fr = lane & 15, fq = lane >> 4;
    const int K = g.K, nt = K / BK;
    unsigned voffA[2], voffB[2];
#pragma unroll
    for (int i = 0; i < 2; ++i) { int R, C; stage_rc(tid * 16 + i * 8192, R, C); const int Rb = Epi::PERM ? ((R & ~31) + perm32(R & 31)) : R;
        voffA[i] = (unsigned)(R * K + C) * 2u; voffB[i] = (unsigned)(Rb * K + C) * 2u; }
    const size_t kstep = (size_t)(BK * 2);
    const size_t hstep = (size_t)HALF * K * 2;
    const size_t tstep = 2 * hstep;
    const unsigned ldsw = (unsigned)wid * 1024u;
    const int aoff = lds_byte(wr * 64 + fr, fq * 8), boff = lds_byte(wc * 32 + fr, fq * 8);
#define PG8_SA(b, h) (((b) * 2 + (h)) * HTB)
#define PG8_SB(b, h) ((4 + (b) * 2 + (h)) * HTB)
#define PG8_STAGE(bufoff, gbase, voff) do { _Pragma("unroll") for (int _i = 0; _i < 2; ++_i) \
        __builtin_amdgcn_global_load_lds((const unsigned*)((const char*)(gbase) + (voff)[_i]), (PG8_LAS unsigned*)(lds + (bufoff) + ldsw + _i * 8192), 16, 0, 0); } while (0)
#define PG8_LDA(dst, b, h) do { _Pragma("unroll") for (int m = 0; m < 4; ++m) _Pragma("unroll") for (int k = 0; k < 2; ++k) dst[m][k] = *(const PG8_LAS bf16x8*)(lds + PG8_SA(b, h) + aoff + m * 2048 + k * 1024); } while (0)
#define PG8_LDB(dst, b, h) do { _Pragma("unroll") for (int n = 0; n < 2; ++n) _Pragma("unroll") for (int k = 0; k < 2; ++k) dst[n][k] = *(const PG8_LAS bf16x8*)(lds + PG8_SB(b, h) + boff + n * 2048 + k * 1024); } while (0)
#define PG8_MMA(ai, bj, At, Bt) do { __builtin_amdgcn_s_setprio(1); _Pragma("unroll") for (int m = 0; m < 4; ++m) _Pragma("unroll") for (int n = 0; n < 2; ++n) _Pragma("unroll") for (int k = 0; k < 2; ++k) \
        acc[ai][bj][m][n] = Epi::SWAP ? __builtin_amdgcn_mfma_f32_16x16x32_bf16(At[m][k], Bt[n][k], acc[ai][bj][m][n], 0, 0, 0) : __builtin_amdgcn_mfma_f32_16x16x32_bf16(Bt[n][k], At[m][k], acc[ai][bj][m][n], 0, 0, 0); __builtin_amdgcn_s_setprio(0); } while (0)
#define PG8_WAIT_V(n) asm volatile("s_waitcnt vmcnt(" #n ")" ::: "memory")
#define PG8_WAIT_L(n) asm volatile("s_waitcnt lgkmcnt(" #n ")" ::: "memory")
#define PG8_BAR __builtin_amdgcn_s_barrier()
#define PG8_SCHED __builtin_amdgcn_sched_barrier(0)
    Unit cur, nxt; int ui = 0;
    if (!S.next(0, cur)) return;
    f32x4 acc[2][2][4][2];
#pragma unroll
    for (int a = 0; a < 2; ++a)
#pragma unroll
        for (int b = 0; b < 2; ++b)
#pragma unroll
            for (int m = 0; m < 4; ++m)
#pragma unroll
                for (int n = 0; n < 2; ++n) acc[a][b][m][n] = (f32x4){0.f, 0.f, 0.f, 0.f};
    bf16x8 At[4][2], B0[2][2], B1[2][2];
    const char* cA = (const char*)g.A + (size_t)cur.pm * tstep; const char* cB = (const char*)g.Bt + (size_t)cur.pn * tstep;
    S.a_ready(cur);
    if constexpr (SP2) {
        PG8_STAGE(PG8_SB(0, 0), cB, voffB); PG8_STAGE(PG8_SB(0, 1), cB + hstep, voffB); PG8_STAGE(PG8_SA(0, 0), cA, voffA); PG8_STAGE(PG8_SA(0, 1), cA + hstep, voffA);
        if (wr == 1) PG8_BAR;
        PG8_WAIT_V(2); PG8_BAR;
        PG8_STAGE(PG8_SB(1, 0), cB + kstep, voffB); PG8_STAGE(PG8_SA(1, 0), cA + kstep, voffA); PG8_STAGE(PG8_SB(1, 1), cB + hstep + kstep, voffB);
        PG8_WAIT_V(6); PG8_BAR;
    } else {
        PG8_STAGE(PG8_SB(0, 0), cB, voffB); PG8_STAGE(PG8_SA(0, 0), cA, voffA); PG8_STAGE(PG8_SB(0, 1), cB + hstep, voffB); PG8_STAGE(PG8_SA(0, 1), cA + hstep, voffA);
        if (wr == 1) PG8_BAR;
        PG8_WAIT_V(4); PG8_BAR;
        PG8_STAGE(PG8_SB(1, 0), cB + kstep, voffB); PG8_STAGE(PG8_SA(1, 0), cA + kstep, voffA); PG8_STAGE(PG8_SB(1, 1), cB + hstep + kstep, voffB);
        PG8_WAIT_V(6); PG8_BAR;
    }
    for (;;) {
        const bool has_next = S.next(ui + 1, nxt);
        const char* nA = has_next ? (const char*)g.A + (size_t)nxt.pm * tstep : cA; const char* nB = has_next ? (const char*)g.Bt + (size_t)nxt.pn * tstep : cB;
        for (int t = 0; t < nt; t += 2) {
            const bool last = (t == nt - 2);
            const char* a1 = cA + (size_t)(t + 1) * kstep;
            const char* a2 = last ? nA : cA + (size_t)(t + 2) * kstep; const char* b2 = last ? nB : cB + (size_t)(t + 2) * kstep;
            const char* a3 = a2 + kstep; const char* b3 = b2 + kstep;
            if (last && has_next) S.a_ready(nxt);
            if constexpr (SP2) {
            PG8_LDB(B0, 0, 0); PG8_LDB(B1, 0, 1); PG8_SCHED; PG8_LDA(At, 0, 0); PG8_STAGE(PG8_SA(1, 1), a1 + hstep, voffA);
            PG8_WAIT_V(8); PG8_WAIT_L(0); PG8_BAR; PG8_MMA(0, 0, At, B0); PG8_MMA(0, 1, At, B1); PG8_BAR; PG8_SCHED;
            PG8_LDA(At, 0, 1); PG8_STAGE(PG8_SB(0, 0), b2, voffB); PG8_STAGE(PG8_SB(0, 1), b2 + hstep, voffB); PG8_STAGE(PG8_SA(0, 0), a2, voffA);
            PG8_WAIT_V(8); PG8_WAIT_L(0); PG8_BAR; PG8_MMA(1, 0, At, B0); PG8_MMA(1, 1, At, B1); PG8_BAR; PG8_SCHED;
            PG8_LDB(B0, 1, 0); PG8_LDB(B1, 1, 1); PG8_SCHED; PG8_LDA(At, 1, 0); PG8_STAGE(PG8_SA(0, 1), a2 + hstep, voffA);
            PG8_WAIT_V(8); PG8_WAIT_L(0); PG8_BAR; PG8_MMA(0, 0, At, B0); PG8_MMA(0, 1, At, B1); PG8_BAR; PG8_SCHED;
            PG8_LDA(At, 1, 1); PG8_STAGE(PG8_SB(1, 0), b3, voffB); PG8_STAGE(PG8_SB(1, 1), b3 + hstep, voffB); PG8_STAGE(PG8_SA(1, 0), a3, voffA);
            PG8_WAIT_V(8); PG8_WAIT_L(0); PG8_BAR; PG8_MMA(1, 0, At, B0); PG8_MMA(1, 1, At, B1); PG8_BAR; PG8_SCHED;
            } else {
            PG8_LDB(B0, 0, 0); PG8_SCHED; PG8_LDA(At, 0, 0); PG8_STAGE(PG8_SA(1, 1), a1 + hstep, voffA);
            PG8_WAIT_L(8); PG8_BAR; PG8_WAIT_L(0); PG8_MMA(0, 0, At, B0); PG8_BAR; PG8_SCHED;
            PG8_LDB(B1, 0, 1); PG8_STAGE(PG8_SB(0, 0), b2, voffB);
            PG8_BAR; PG8_WAIT_L(0); PG8_MMA(0, 1, At, B1); PG8_BAR;
            PG8_LDA(At, 0, 1); PG8_STAGE(PG8_SA(0, 0), a2, voffA);
            PG8_BAR; PG8_WAIT_L(0); PG8_MMA(1, 0, At, B0); PG8_BAR; PG8_SCHED;
            PG8_STAGE(PG8_SB(0, 1), b2 + hstep, voffB);
            PG8_WAIT_V(6); PG8_BAR; PG8_MMA(1, 1, At, B1); PG8_BAR;
            PG8_LDB(B0, 1, 0); PG8_SCHED; PG8_LDA(At, 1, 0); PG8_STAGE(PG8_SA(0, 1), a2 + hstep, voffA);
            PG8_WAIT_L(8); PG8_BAR; PG8_WAIT_L(0); PG8_MMA(0, 0, At, B0); PG8_BAR; PG8_SCHED;
            PG8_LDB(B1, 1, 1); PG8_STAGE(PG8_SB(1, 0), b3, voffB);
            PG8_BAR; PG8_WAIT_L(0); PG8_MMA(0, 1, At, B1); PG8_BAR;
            PG8_LDA(At, 1, 1); PG8_STAGE(PG8_SA(1, 0), a3, voffA);
            PG8_BAR; PG8_WAIT_L(0); PG8_MMA(1, 0, At, B0); PG8_BAR; PG8_SCHED;
            PG8_STAGE(PG8_SB(1, 1), b3 + hstep, voffB);
            PG8_WAIT_V(6); PG8_BAR; PG8_MMA(1, 1, At, B1); PG8_BAR;
            }
        }
        if constexpr (ALIGN_EPI) { if (wr == 0) PG8_BAR; }
        if constexpr (!Epi::AFTER_DRAIN) { E(acc, cur, wr, wc, fr, fq); S.done(cur); }
        if (!has_next) break;
#pragma unroll
        for (int a = 0; a < 2; ++a)
#pragma unroll
            for (int b = 0; b < 2; ++b)
#pragma unroll
                for (int m = 0; m < 4; ++m)
#pragma unroll
                    for (int n = 0; n < 2; ++n) acc[a][b][m][n] = (f32x4){0.f, 0.f, 0.f, 0.f};
        cur = nxt; cA = nA; cB = nB; ++ui;
        if constexpr (ALIGN_EPI) { if (wr == 1) PG8_BAR; }
    }
    PG8_WAIT_V(0);
    if constexpr (!ALIGN_EPI) { if (wr == 0) PG8_BAR; }
    PG8_BAR;
    if constexpr (Epi::AFTER_DRAIN) { E.fused(acc, cur, wr, wc, fr, fq, lds, wid, lane); S.done(cur); }
#undef PG8_SA
#undef PG8_SB
#undef PG8_STAGE
#undef PG8_LDA
#undef PG8_LDB
#undef PG8_MMA
#undef PG8_WAIT_V
#undef PG8_WAIT_L
#undef PG8_BAR
#undef PG8_SCHED
}
}
namespace epi {
using pg8::Unit;
struct Proj {
    static constexpr bool PERM = true, AFTER_DRAIN = false, SWAP = false;
    bf16_t *DQ, *DK, *SQ, *SK, *IQ, *IK; float* IW;
    __device__ __forceinline__ void operator()(const f32x4 (&acc)[2][2][4][2], const Unit& u, int wr, int wc, int fr, int fq) const {
        const int row0 = u.pm * 256 + wr * 64 + fr;
#pragma unroll
        for (int bj = 0; bj < 2; ++bj) {
            const int cbase = u.pn * 256 + bj * 128 + wc * 32;
            if (cbase >= 2400) continue;
            const int c8 = cbase + 8 * fq;
            if (cbase >= 2368) {
                if (fq == 0) {
#pragma unroll
                    for (int ai = 0; ai < 2; ++ai)
#pragma unroll
                        for (int m = 0; m < 4; ++m) { const int row = row0 + ai * 128 + m * 16; *(f32x4*)(IW + (size_t)row * 4) = acc[ai][bj][m][0] * 0.5f; }
                }
                continue;
            }
            bf16_t* dst; int nh, hh; float sc = 1.0f;
            if (cbase < 512) { dst = DQ; nh = 8; hh = cbase >> 6; sc = 0.125f * LOG2E; }
            else if (cbase < 1024) { dst = DK; nh = 8; hh = (cbase - 512) >> 6; }
            else if (cbase < 1536) { dst = SQ; nh = 8; hh = (cbase - 1024) >> 6; sc = 0.125f * LOG2E; }
            else if (cbase < 2048) { dst = SK; nh = 8; hh = (cbase - 1536) >> 6; }
            else if (cbase < 2304) { dst = IQ; nh = 4; hh = (cbase - 2048) >> 6; sc = 0.125f; }
            else { dst = IK; nh = 1; hh = 0; }
            const int d = c8 & 63;
#pragma unroll
            for (int ai = 0; ai < 2; ++ai)
#pragma unroll
                for (int m = 0; m < 4; ++m) {
                    const int row = row0 + ai * 128 + m * 16, b = row >> 12, s = row & 4095;
                    const f32x4 v0 = acc[ai][bj][m][0] * sc, v1 = acc[ai][bj][m][1] * sc;
                    u32x4 w; w.x = cvt_pk_bf16(v0[0], v0[1]); w.y = cvt_pk_bf16(v0[2], v0[3]); w.z = cvt_pk_bf16(v1[0], v1[1]); w.w = cvt_pk_bf16(v1[2], v1[3]);
                    *(u32x4*)(dst + ((size_t)((b * nh + hh) * 4096 + s)) * 64 + d) = w;
                }
        }
    }
};
struct ProjV {
    static constexpr bool PERM = false, AFTER_DRAIN = false, SWAP = true;
    bf16_t *DVT, *SVT;
    __device__ __forceinline__ void operator()(const f32x4 (&acc)[2][2][4][2], const Unit& u, int wr, int wc, int fr, int fq) const {
#pragma unroll
        for (int ai = 0; ai < 2; ++ai)
#pragma unroll
            for (int m = 0; m < 4; ++m) {
                const int tok0 = u.pm * 256 + ai * 128 + wr * 64 + m * 16 + 4 * fq, b = tok0 >> 12, s0 = tok0 & 4095;
                const int pos = (s0 & ~63) + 16 * m + 8 * (fq & 1) + 4 * (fq >> 1);
#pragma unroll
                for (int bj = 0; bj < 2; ++bj)
#pragma unroll
                    for (int n = 0; n < 2; ++n) {
                        const int col = u.pn * 256 + bj * 128 + wc * 32 + n * 16 + fr;
                        bf16_t* dst;
                        if (col < 512) dst = DVT + ((size_t)((b * 4 + (col >> 7)) * 128 + (col & 127))) * 4096 + pos;
                        else { const int c2 = col - 512; dst = SVT + ((size_t)((b * 8 + (c2 >> 6)) * 64 + (c2 & 63))) * 4096 + pos; }
                        const f32x4 v = acc[ai][bj][m][n];
                        u32x2 w; w.x = cvt_pk_bf16(v[0], v[1]); w.y = cvt_pk_bf16(v[2], v[3]);
                        *(u32x2*)dst = w;
                    }
            }
    }
};
struct PlainBf16 {
    static constexpr bool PERM = true, AFTER_DRAIN = false, SWAP = false;
    bf16_t* O; int ldc; int psh, pmask; unsigned pstride;
    __device__ __forceinline__ void operator()(const f32x4 (&acc)[2][2][4][2], const Unit& u, int wr, int wc, int fr, int fq) const {
        const int row0 = u.pm * 256 + wr * 64 + fr, col0 = (u.pn & pmask) * 256 + wc * 32 + 8 * fq;
        bf16_t* Op = O + (size_t)((unsigned)(u.pn >> psh) * pstride);
#pragma unroll
        for (int ai = 0; ai < 2; ++ai)
#pragma unroll
            for (int m = 0; m < 4; ++m) { bf16_t* rowp = Op + (size_t)(row0 + ai * 128 + m * 16) * ldc + col0;
#pragma unroll
                for (int bj = 0; bj < 2; ++bj) { const f32x4 v0 = acc[ai][bj][m][0], v1 = acc[ai][bj][m][1];
                    u32x4 w; w.x = cvt_pk_bf16(v0[0], v0[1]); w.y = cvt_pk_bf16(v0[2], v0[3]); w.z = cvt_pk_bf16(v1[0], v1[1]); w.w = cvt_pk_bf16(v1[2], v1[3]);
                    *(u32x4*)(rowp + bj * 128) = w; } }
    }
};
struct OutRes {
    static constexpr bool PERM = true, AFTER_DRAIN = false, SWAP = false;
    const bf16_t* H; bf16_t* RF;
    __device__ __forceinline__ void operator()(const f32x4 (&acc)[2][2][4][2], const Unit& u, int wr, int wc, int fr, int fq) const {
        const int row0 = u.pm * 256 + wr * 64 + fr, col0 = u.pn * 256 + wc * 32 + 8 * fq;
#pragma unroll
        for (int ai = 0; ai < 2; ++ai)
#pragma unroll
            for (int m = 0; m < 4; ++m) { const size_t off = (size_t)(row0 + ai * 128 + m * 16) * D + col0;
#pragma unroll
                for (int bj = 0; bj < 2; ++bj) { const u32x4 h = *(const u32x4*)(H + off + bj * 128);
                    f32x4 o0, o1;
                    o0[0] = ALPHA * bf_lo(h.x) + acc[ai][bj][m][0][0]; o0[1] = ALPHA * bf_hi(h.x) + acc[ai][bj][m][0][1]; o0[2] = ALPHA * bf_lo(h.y) + acc[ai][bj][m][0][2]; o0[3] = ALPHA * bf_hi(h.y) + acc[ai][bj][m][0][3];
                    o1[0] = ALPHA * bf_lo(h.z) + acc[ai][bj][m][1][0]; o1[1] = ALPHA * bf_hi(h.z) + acc[ai][bj][m][1][1]; o1[2] = ALPHA * bf_lo(h.w) + acc[ai][bj][m][1][2]; o1[3] = ALPHA * bf_hi(h.w) + acc[ai][bj][m][1][3];
                    u32x4 w; w.x = cvt_pk_bf16(o0[0], o0[1]); w.y = cvt_pk_bf16(o0[2], o0[3]); w.z = cvt_pk_bf16(o1[0], o1[1]); w.w = cvt_pk_bf16(o1[2], o1[3]);
                    *(u32x4*)(RF + off + bj * 128) = w; }
                asm volatile("" ::: "memory"); }
    }
};
struct Gate {
    static constexpr bool PERM = true, AFTER_DRAIN = false, SWAP = false;
    const bf16_t* R2; const bf16_t* PP; const float* bg; bf16_t* RF;
    __device__ __forceinline__ float sg(float x) const { return __builtin_amdgcn_rcpf(1.0f + __builtin_amdgcn_exp2f(-LOG2E * x)); }
    __device__ __forceinline__ void operator()(const f32x4 (&acc)[2][2][4][2], const Unit& u, int wr, int wc, int fr, int fq) const {
        const int row0 = u.pm * 256 + wr * 64 + fr, col0 = u.pn * 256 + wc * 32 + 8 * fq;
        f32x4 bv[2][2];
#pragma unroll
        for (int bj = 0; bj < 2; ++bj) { bv[bj][0] = *(const f32x4*)(bg + col0 + bj * 128); bv[bj][1] = *(const f32x4*)(bg + col0 + bj * 128 + 4); }
#pragma unroll
        for (int ai = 0; ai < 2; ++ai)
#pragma unroll
            for (int m = 0; m < 4; ++m) { const size_t off = (size_t)(row0 + ai * 128 + m * 16) * D + col0;
#pragma unroll
                for (int bj = 0; bj < 2; ++bj) { const u32x4 r = *(const u32x4*)(R2 + off + bj * 128), p = *(const u32x4*)(PP + off + bj * 128);
                    const f32x4 a0 = acc[ai][bj][m][0] + bv[bj][0], a1 = acc[ai][bj][m][1] + bv[bj][1];
                    f32x4 o0, o1;
                    o0[0] = bf_lo(r.x) + sg(a0[0]) * bf_lo(p.x); o0[1] = bf_hi(r.x) + sg(a0[1]) * bf_hi(p.x); o0[2] = bf_lo(r.y) + sg(a0[2]) * bf_lo(p.y); o0[3] = bf_hi(r.y) + sg(a0[3]) * bf_hi(p.y);
                    o1[0] = bf_lo(r.z) + sg(a1[0]) * bf_lo(p.z); o1[1] = bf_hi(r.z) + sg(a1[1]) * bf_hi(p.z); o1[2] = bf_lo(r.w) + sg(a1[2]) * bf_lo(p.w); o1[3] = bf_hi(r.w) + sg(a1[3]) * bf_hi(p.w);
                    u32x4 w; w.x = cvt_pk_bf16(o0[0], o0[1]); w.y = cvt_pk_bf16(o0[2], o0[3]); w.z = cvt_pk_bf16(o1[0], o1[1]); w.w = cvt_pk_bf16(o1[2], o1[3]);
                    *(u32x4*)(RF + off + bj * 128) = w; }
                asm volatile("" ::: "memory"); }
    }
};
}
#define XB_TMO      128
#define XB_XCNT(j)  (256  + 64 * (j))
#define XB_XSUB(j)  (1280 + 64 * (j))
#define XB_XGEN(j)  (2304 + 64 * (j))
#define XB_TOP      3328
#define XB_TOPGEN   3392
#define XCD_BAR_WORDS 3456
#define XB_SPIN_CAP (1u << 22)

__device__ __forceinline__ unsigned xb_ld(unsigned* p)              { return __hip_atomic_load(p, __ATOMIC_RELAXED, __HIP_MEMORY_SCOPE_AGENT); }
__device__ __forceinline__ unsigned xb_add(unsigned* p, unsigned v) { return __hip_atomic_fetch_add(p, v, __ATOMIC_RELAXED, __HIP_MEMORY_SCOPE_AGENT); }
__device__ __forceinline__ unsigned xb_xcc_id() { return (unsigned)__builtin_amdgcn_s_getreg((3 << 11) | 20) & 0xFu; }
#define XB_SPIN(cond, bar) do { unsigned _sp = 0; while (cond) { __builtin_amdgcn_s_sleep(1); \
    if ((++_sp & 255u) == 0u) { if (xb_ld(&(bar)[XB_TMO])) break; if (_sp > XB_SPIN_CAP) { atomicAdd(&(bar)[XB_TMO], 1u); break; } } } } while (0)

struct XcdBarrier {
    unsigned* bar; unsigned x;
    volatile LAS unsigned* st;
};

__device__ __forceinline__ XcdBarrier xcd_barrier_post(unsigned* bar, volatile LAS unsigned* st) {
    XcdBarrier b; b.bar = bar; b.x = xb_xcc_id(); b.st = st;
    if (threadIdx.x == 0) (void)xb_add(&bar[XB_XCNT(b.x)], 1u);
    return b;
}
__device__ __forceinline__ void xcd_barrier_complete(unsigned* bar, unsigned x, unsigned& nloc, unsigned& nx) {
    const unsigned G = gridDim.x * gridDim.y * gridDim.z;
    unsigned sum, cnt, mine, sp = 0u;
    for (;;) {
        sum = 0u; cnt = 0u; mine = 0u;
#pragma unroll
        for (unsigned j = 0; j < 16; ++j) { const unsigned c = xb_ld(&bar[XB_XCNT(j)]); sum += c; cnt += (c > 0u) ? 1u : 0u; mine = (j == x) ? c : mine; }
        if (sum == G) break;
        __builtin_amdgcn_s_sleep(1);
        if ((++sp & 255u) == 0u) { if (xb_ld(&bar[XB_TMO])) break; if (sp > XB_SPIN_CAP) { atomicAdd(&bar[XB_TMO], 1u); break; } }
    }
    nloc = mine > 0u ? mine : 1u; nx = cnt > 0u ? cnt : 1u;
}

__device__ __forceinline__ void xcd_barrier(const XcdBarrier& b) {
    asm volatile("s_waitcnt vmcnt(0)" ::: "memory");
    __syncthreads();
    if (threadIdx.x == 0) {
        unsigned* bar = b.bar;
        __builtin_amdgcn_s_waitcnt(0);
        unsigned nloc = b.st[0], nx = b.st[1];
        if (nloc == 0u) { xcd_barrier_complete(bar, b.x, nloc, nx); b.st[0] = nloc; b.st[1] = nx; }
        const unsigned old = xb_add(&bar[XB_XSUB(b.x)], 1u);
        const unsigned gen = old / nloc;
        if (old + 1u == (gen + 1u) * nloc) {
            __builtin_amdgcn_fence(__ATOMIC_RELEASE, "agent");
            asm volatile("s_waitcnt vmcnt(0)" ::: "memory");
            const unsigned og = xb_add(&bar[XB_TOP], 1u);
            const unsigned tg = og / nx;
            if (og + 1u == (tg + 1u) * nx) xb_add(&bar[XB_TOPGEN], 1u);
            else XB_SPIN(xb_ld(&bar[XB_TOPGEN]) == tg, bar);
            __builtin_amdgcn_fence(__ATOMIC_ACQUIRE, "agent");
            xb_add(&bar[XB_XGEN(b.x)], 1u);
            asm volatile("s_waitcnt vmcnt(0)" ::: "memory");
        } else {
            XB_SPIN(xb_ld(&bar[XB_XGEN(b.x)]) == gen, bar);
            __builtin_amdgcn_fence(__ATOMIC_ACQUIRE, "agent");
            asm volatile("s_waitcnt vmcnt(0)" ::: "memory");
        }
    }
    __syncthreads();
}

#define XB_GRP(j) (3520 + 64 * (j))
#define XB_GMASK(j) (3520 + 64 * (j) + 32)
#define XB_PAIR(j) (8192 + 64 * (j))
__device__ __forceinline__ void group_barrier(const XcdBarrier& b, unsigned cword, unsigned gsize, int gslot = 2) {
    asm volatile("s_waitcnt vmcnt(0)" ::: "memory");
    __syncthreads();
    if (threadIdx.x == 0) {
        unsigned* bar = b.bar;
        __builtin_amdgcn_s_waitcnt(0);
        if (b.st[3] == 0u) {
            __builtin_amdgcn_fence(__ATOMIC_RELEASE, "agent");
            asm volatile("s_waitcnt vmcnt(0)" ::: "memory");
        }
        const unsigned gen = b.st[gslot];
        (void)xb_add(&bar[cword], 1u);
        const unsigned target = (gen + 1u) * gsize;
        XB_SPIN(xb_ld(&bar[cword]) < target, bar);
        __builtin_amdgcn_fence(__ATOMIC_ACQUIRE, "agent");
        asm volatile("s_waitcnt vmcnt(0)" ::: "memory");
        b.st[gslot] = gen + 1u;
    }
    __syncthreads();
}

__device__ __forceinline__ void group_post(const XcdBarrier& b, unsigned grp) { if (threadIdx.x == 0) (void)__hip_atomic_fetch_or(&b.bar[XB_GMASK(grp)], 1u << b.x, __ATOMIC_RELAXED, __HIP_MEMORY_SCOPE_AGENT); }
__device__ __forceinline__ void group_resolve(const XcdBarrier& b, unsigned grp) {
    if (threadIdx.x == 0) { const unsigned m = xb_ld(&b.bar[XB_GMASK(grp)]); b.st[3] = (m != 0u && (m & (m - 1u)) == 0u) ? 1u : 0u; }
    __syncthreads();
}
struct Frame {
    LAS unsigned char* lds;
    int tid, lane, wave, G, wg;
    unsigned char* ws;
};

__device__ __forceinline__ void transpose_item(const float* __restrict__ W, int K, int ldn, int src_c0, int nvalid, bf16_t* __restrict__ WT, LAS float* scr, int kb, int nb, int lane) {
    const int k0 = 64 * kb, n0 = 32 * nb, nn = n0 + (lane & 31);
    const bool ok = nn < nvalid;
#pragma unroll 8
    for (int i = 0; i < 32; ++i) { const int kk = 2 * i + (lane >> 5); scr[kk * 33 + (lane & 31)] = ok ? W[(size_t)(k0 + kk) * ldn + src_c0 + nn] : 0.0f; }
    LDS_WAIT();
    const int c = lane & 7;
#pragma unroll
    for (int j = 0; j < 4; ++j) { const int n = (lane >> 3) + 8 * j; const LAS float* s = scr + (8 * c) * 33 + n;
        u32x4 o; o.x = cvt_pk_bf16(s[0 * 33], s[1 * 33]); o.y = cvt_pk_bf16(s[2 * 33], s[3 * 33]); o.z = cvt_pk_bf16(s[4 * 33], s[5 * 33]); o.w = cvt_pk_bf16(s[6 * 33], s[7 * 33]);
        *(u32x4*)(WT + (size_t)(n0 + n) * K + k0 + 8 * c) = o; }
    LDS_WAIT();
}
__device__ __forceinline__ void ln_row(const float* __restrict__ xrow, const float* __restrict__ g, const float* __restrict__ bta, bf16_t* obf, float* of32, int lane) {
    const f32x4* xr = (const f32x4*)xrow + lane;
    f32x4 v[4]; float s = 0.f;
#pragma unroll
    for (int j = 0; j < 4; ++j) { v[j] = xr[64 * j]; s += (v[j][0] + v[j][1]) + (v[j][2] + v[j][3]); }
    const float mean = wave_sum(s) * (1.f / D); float s2 = 0.f;
#pragma unroll
    for (int j = 0; j < 4; ++j) { v[j] = v[j] - mean; s2 += (v[j][0] * v[j][0] + v[j][1] * v[j][1]) + (v[j][2] * v[j][2] + v[j][3] * v[j][3]); }
    const float rstd = 1.f / sqrtf(wave_sum(s2) * (1.f / D) + LN_EPS);
#pragma unroll
    for (int j = 0; j < 4; ++j) {
        const f32x4 gg = ((const f32x4*)g)[lane + 64 * j], bb = ((const f32x4*)bta)[lane + 64 * j];
        const f32x4 y = v[j] * rstd * gg + bb;
        if (obf) { u32x2 w; w.x = cvt_pk_bf16(y[0], y[1]); w.y = cvt_pk_bf16(y[2], y[3]); ((u32x2*)obf)[lane + 64 * j] = w; }
        if (of32) ((f32x4*)of32)[lane + 64 * j] = y;
    }
}
__device__ __forceinline__ void ln_row_bf(const bf16_t* __restrict__ xrow, const float* __restrict__ g, const float* __restrict__ bta, bf16_t* obf, float* of32, int lane) {
    const u32x4 a0 = *(const u32x4*)(xrow + 16 * lane), a1 = *(const u32x4*)(xrow + 16 * lane + 8);
    float v[16] = {bf_lo(a0.x), bf_hi(a0.x), bf_lo(a0.y), bf_hi(a0.y), bf_lo(a0.z), bf_hi(a0.z), bf_lo(a0.w), bf_hi(a0.w), bf_lo(a1.x), bf_hi(a1.x), bf_lo(a1.y), bf_hi(a1.y), bf_lo(a1.z), bf_hi(a1.z), bf_lo(a1.w), bf_hi(a1.w)};
    float s = 0.f;
#pragma unroll
    for (int i = 0; i < 16; ++i) s += v[i];
    const float mean = wave_sum(s) * (1.f / D); float s2 = 0.f;
#pragma unroll
    for (int i = 0; i < 16; ++i) { v[i] -= mean; s2 += v[i] * v[i]; }
    const float rstd = 1.f / sqrtf(wave_sum(s2) * (1.f / D) + LN_EPS);
    float y[16];
#pragma unroll
    for (int j = 0; j < 4; ++j) { const f32x4 gg = ((const f32x4*)g)[4 * lane + j], bb = ((const f32x4*)bta)[4 * lane + j];
#pragma unroll
        for (int i = 0; i < 4; ++i) y[4 * j + i] = v[4 * j + i] * rstd * gg[i] + bb[i]; }
    if (obf) { u32x4 w0, w1; w0.x = cvt_pk_bf16(y[0], y[1]); w0.y = cvt_pk_bf16(y[2], y[3]); w0.z = cvt_pk_bf16(y[4], y[5]); w0.w = cvt_pk_bf16(y[6], y[7]);
        w1.x = cvt_pk_bf16(y[8], y[9]); w1.y = cvt_pk_bf16(y[10], y[11]); w1.z = cvt_pk_bf16(y[12], y[13]); w1.w = cvt_pk_bf16(y[14], y[15]);
        *(u32x4*)(obf + 16 * lane) = w0; *(u32x4*)(obf + 16 * lane + 8) = w1; }
    if (of32) {
#pragma unroll
        for (int j = 0; j < 4; ++j) ((f32x4*)of32)[4 * lane + j] = (f32x4){y[4 * j], y[4 * j + 1], y[4 * j + 2], y[4 * j + 3]}; }
}
__device__ __forceinline__ void ln_rows_bf(const bf16_t* __restrict__ X, const float* __restrict__ g, const float* __restrict__ bta, bf16_t* obf, float* of32, int gw, int ngw, int mend, int lane) {
    f32x4 gg[4], bb[4];
#pragma unroll
    for (int j = 0; j < 4; ++j) { gg[j] = ((const f32x4*)g)[4 * lane + j]; bb[j] = ((const f32x4*)bta)[4 * lane + j]; }
    int m = gw;
    u32x4 n0 = (u32x4){0u, 0u, 0u, 0u}, n1 = n0;
    if (m < mend) { n0 = *(const u32x4*)(X + (size_t)m * D + 16 * lane); n1 = *(const u32x4*)(X + (size_t)m * D + 16 * lane + 8); }
#pragma unroll 1
    for (; m < mend; m += ngw) {
        const u32x4 a0 = n0, a1 = n1;
        if (m + ngw < mend) { n0 = *(const u32x4*)(X + (size_t)(m + ngw) * D + 16 * lane); n1 = *(const u32x4*)(X + (size_t)(m + ngw) * D + 16 * lane + 8); }
        float v[16] = {bf_lo(a0.x), bf_hi(a0.x), bf_lo(a0.y), bf_hi(a0.y), bf_lo(a0.z), bf_hi(a0.z), bf_lo(a0.w), bf_hi(a0.w), bf_lo(a1.x), bf_hi(a1.x), bf_lo(a1.y), bf_hi(a1.y), bf_lo(a1.z), bf_hi(a1.z), bf_lo(a1.w), bf_hi(a1.w)};
        float s = 0.f;
#pragma unroll
        for (int i = 0; i < 16; ++i) s += v[i];
        const float mean = wave_sum(s) * (1.f / D); float s2 = 0.f;
#pragma unroll
        for (int i = 0; i < 16; ++i) { v[i] -= mean; s2 += v[i] * v[i]; }
        const float rstd = 1.f / sqrtf(wave_sum(s2) * (1.f / D) + LN_EPS);
        float y[16];
#pragma unroll
        for (int j = 0; j < 4; ++j)
#pragma unroll
            for (int i = 0; i < 4; ++i) y[4 * j + i] = v[4 * j + i] * rstd * gg[j][i] + bb[j][i];
        if (obf) { u32x4 w0, w1; w0.x = cvt_pk_bf16(y[0], y[1]); w0.y = cvt_pk_bf16(y[2], y[3]); w0.z = cvt_pk_bf16(y[4], y[5]); w0.w = cvt_pk_bf16(y[6], y[7]);
            w1.x = cvt_pk_bf16(y[8], y[9]); w1.y = cvt_pk_bf16(y[10], y[11]); w1.z = cvt_pk_bf16(y[12], y[13]); w1.w = cvt_pk_bf16(y[14], y[15]);
            *(u32x4*)(obf + (size_t)m * D + 16 * lane) = w0; *(u32x4*)(obf + (size_t)m * D + 16 * lane + 8) = w1; }
        if (of32) {
#pragma unroll
            for (int j = 0; j < 4; ++j) ((f32x4*)(of32 + (size_t)m * D))[4 * lane + j] = (f32x4){y[4 * j], y[4 * j + 1], y[4 * j + 2], y[4 * j + 3]}; }
    }
}
__device__ __forceinline__ void convert_f32_bf16(const float* __restrict__ src, bf16_t* __restrict__ dst, size_t n, size_t gtid, size_t gthreads) {
    const size_t n8 = n >> 3;
    for (size_t i = gtid; i < n8; i += gthreads) {
        const f32x4 a = ((const f32x4*)src)[2 * i], b = ((const f32x4*)src)[2 * i + 1];
        u32x4 o; o.x = cvt_pk_bf16(a[0], a[1]); o.y = cvt_pk_bf16(a[2], a[3]); o.z = cvt_pk_bf16(b[0], b[1]); o.w = cvt_pk_bf16(b[2], b[3]);
        ((u32x4*)dst)[i] = o;
    }
}

__device__ __forceinline__ float fp8_row_scale(float amax, float* inv) {
    const int ex = (int)((__float_as_uint(amax) >> 23) & 0xffu);
    if (ex < 16 || ex > 240) { *inv = 1.0f; return 1.0f; }
    *inv = __uint_as_float((unsigned)(ex - 7) << 23);
    return __uint_as_float((unsigned)(261 - ex) << 23);
}
__device__ __forceinline__ unsigned pack4_fp8(float a, float b, float c, float d) {
    int w = __builtin_amdgcn_cvt_pk_fp8_f32(a, b, 0, false);
    w = __builtin_amdgcn_cvt_pk_fp8_f32(c, d, w, true);
    return (unsigned)w;
}
__device__ __forceinline__ void convert_rows_fp8(const float* __restrict__ src, unsigned char* __restrict__ dst, float* __restrict__ inv_scale, int nrows, int gw, int ngw, int lane) {
    for (int row = gw; row < nrows; row += ngw) {
        const f32x4* xr = (const f32x4*)(src + (size_t)row * D) + lane;
        f32x4 v[4]; float am = 0.f;
#pragma unroll
        for (int j = 0; j < 4; ++j) { v[j] = xr[64 * j]; am = fmaxf(am, fmaxf(fmaxf(fabsf(v[j][0]), fabsf(v[j][1])), fmaxf(fabsf(v[j][2]), fabsf(v[j][3])))); }
#pragma unroll
        for (int o = 1; o < 64; o <<= 1) am = fmaxf(am, __shfl_xor(am, o));
        float inv; const float sc = fp8_row_scale(am, &inv);
#pragma unroll
        for (int j = 0; j < 4; ++j) ((unsigned*)(dst + (size_t)row * D))[lane + 64 * j] = pack4_fp8(v[j][0] * sc, v[j][1] * sc, v[j][2] * sc, v[j][3] * sc);
        if (lane == 0) inv_scale[row] = inv;
    }
}

__device__ __forceinline__ void convert_rows_i4(const float* __restrict__ src, unsigned char* __restrict__ dst, float* __restrict__ step_out, int nrows, int gw, int ngw, int lane) {
    f32x4 nv[4];
#pragma unroll
    for (int j = 0; j < 4; ++j) nv[j] = (f32x4){0.f, 0.f, 0.f, 0.f};
    if (gw < nrows) {
#pragma unroll
        for (int j = 0; j < 4; ++j) nv[j] = ((const f32x4*)(src + (size_t)gw * D + 16 * lane))[j]; }
#pragma unroll 1
    for (int row = gw; row < nrows; row += ngw) {
        f32x4 v[4]; float am = 0.f;
#pragma unroll
        for (int j = 0; j < 4; ++j) v[j] = nv[j];
        if (row + ngw < nrows) {
#pragma unroll
            for (int j = 0; j < 4; ++j) nv[j] = ((const f32x4*)(src + (size_t)(row + ngw) * D + 16 * lane))[j]; }
#pragma unroll
        for (int j = 0; j < 4; ++j) { am = fmaxf(am, fmaxf(fmaxf(fabsf(v[j][0]), fabsf(v[j][1])), fmaxf(fabsf(v[j][2]), fabsf(v[j][3])))); }
#pragma unroll
        for (int o = 1; o < 64; o <<= 1) am = fmaxf(am, __shfl_xor(am, o));
        float ss = 0.f;
#pragma unroll
        for (int j = 0; j < 4; ++j) ss += (v[j][0] * v[j][0] + v[j][1] * v[j][1]) + (v[j][2] * v[j][2] + v[j][3] * v[j][3]);
        ss = wave_sum(ss);
        const float s_rms = 0.335f * sqrtf(ss * (1.0f / D)), s_lo = am * (1.0f / 15.0f), s_hi = am * (1.0f / 7.5f);
        const float step = am > 0.f ? fminf(fmaxf(s_rms, s_lo), s_hi) : 1.0f, rs = 1.0f / step;
        unsigned n[16];
#pragma unroll
        for (int j = 0; j < 4; ++j)
#pragma unroll
            for (int i = 0; i < 4; ++i) { const int q = (int)(v[j][i] * rs + 8.0f); n[4 * j + i] = (unsigned)(q < 0 ? 0 : (q > 15 ? 15 : q)); }
        u32x2 w; w.x = 0u; w.y = 0u;
#pragma unroll
        for (int k = 0; k < 4; ++k) { w.x |= (n[k] | (n[k + 8] << 4)) << (8 * k); w.y |= (n[4 + k] | (n[12 + k] << 4)) << (8 * k); }
        *(u32x2*)(dst + (size_t)row * 512 + 8 * lane) = w;
        if (lane == 0) step_out[row] = step;
    }
}

__device__ __forceinline__ void convert_rows_fp4(const float* __restrict__ src, unsigned char* __restrict__ dst, float* __restrict__ step_out, int nrows, int gw, int ngw, int lane) {
    f32x4 nv[4];
#pragma unroll
    for (int j = 0; j < 4; ++j) nv[j] = (f32x4){0.f, 0.f, 0.f, 0.f};
    if (gw < nrows) {
#pragma unroll
        for (int j = 0; j < 4; ++j) nv[j] = ((const f32x4*)(src + (size_t)gw * D + 16 * lane))[j]; }
#pragma unroll 1
    for (int row = gw; row < nrows; row += ngw) {
        f32x4 v[4]; float am = 0.f;
#pragma unroll
        for (int j = 0; j < 4; ++j) v[j] = nv[j];
        if (row + ngw < nrows) {
#pragma unroll
            for (int j = 0; j < 4; ++j) nv[j] = ((const f32x4*)(src + (size_t)(row + ngw) * D + 16 * lane))[j]; }
#pragma unroll
        for (int j = 0; j < 4; ++j) { am = fmaxf(am, fmaxf(fmaxf(fabsf(v[j][0]), fabsf(v[j][1])), fmaxf(fabsf(v[j][2]), fabsf(v[j][3])))); }
#pragma unroll
        for (int o = 1; o < 64; o <<= 1) am = fmaxf(am, __shfl_xor(am, o));
        float ss = 0.f;
#pragma unroll
        for (int j = 0; j < 4; ++j) ss += (v[j][0] * v[j][0] + v[j][1] * v[j][1]) + (v[j][2] * v[j][2] + v[j][3] * v[j][3]);
        ss = wave_sum(ss);
        const float s_rms = 0.48f * sqrtf(ss * (1.0f / D)), s_lo = am * (1.0f / 12.0f), s_hi = am * (1.0f / 6.0f);
        const float step = am > 0.f ? fminf(fmaxf(s_rms, s_lo), s_hi) : 1.0f, rs = 1.0f / step;
        unsigned n[16];
#pragma unroll
        for (int j = 0; j < 4; ++j)
#pragma unroll
            for (int i = 0; i < 4; ++i) { const float y = v[j][i] * rs, ay = fabsf(y);
                const unsigned mag = (ay >= 0.25f ? 1u : 0u) + (ay >= 0.75f ? 1u : 0u) + (ay >= 1.25f ? 1u : 0u) + (ay >= 1.75f ? 1u : 0u) + (ay >= 2.5f ? 1u : 0u) + (ay >= 3.5f ? 1u : 0u) + (ay >= 5.0f ? 1u : 0u);
                n[4 * j + i] = mag | ((y < 0.f && mag != 0u) ? 8u : 0u); }
        u32x2 w; w.x = 0u; w.y = 0u;
#pragma unroll
        for (int k = 0; k < 4; ++k) { w.x |= (n[2 * k] | (n[2 * k + 1] << 4)) << (8 * k); w.y |= (n[8 + 2 * k] | (n[9 + 2 * k] << 4)) << (8 * k); }
        *(u32x2*)(dst + (size_t)row * 512 + 8 * lane) = w;
        if (lane == 0) step_out[row] = step;
    }
}

__device__ __forceinline__ float relu1(float d) { float r; asm("v_max_f32 %0, 0, %1" : "=v"(r) : "v"(d)); return r; }
__device__ __forceinline__ bool scan_hist_row(const LAS unsigned* row, int lane, unsigned target, unsigned& dsel, unsigned& ca, unsigned& csel, unsigned& tot_all) {
    unsigned wd[8];
#pragma unroll
    for (int i = 0; i < 8; ++i) wd[i] = row[8 * lane + i];
    unsigned tot = 0;
#pragma unroll
    for (int i = 0; i < 8; ++i) tot += (wd[i] & 0xffffu) + (wd[i] >> 16);
    unsigned incl = tot;
#pragma unroll
    for (int off = 1; off < 64; off <<= 1) { const unsigned t = __shfl_down(incl, off); if (lane + off < 64) incl += t; }
    tot_all = __shfl(incl, 0);
    const unsigned above = incl - tot;
    dsel = 0; ca = above; csel = 0;
    if (!(above < target && target <= incl)) return false;
    bool found = false;
#pragma unroll
    for (int i = 15; i >= 0; --i) { const unsigned c = (i & 1) ? (wd[i >> 1] >> 16) : (wd[i >> 1] & 0xffffu);
        if (!found) { if (ca + c >= target) { found = true; dsel = (unsigned)(16 * lane + i); csel = c; } else ca += c; } }
    return true;
}
__device__ __forceinline__ void select_exact_wave(const LAS float* S, int ng, LAS unsigned* wh, u64* __restrict__ mq, int lane) {
    unsigned prefix = 0u, need = 256u;
#pragma unroll 1
    for (int pass = 0; pass < 4; ++pass) {
        const int shift = 24 - 8 * pass;
        *(LAS u32x4*)(wh + 4 * lane) = (u32x4){0u, 0u, 0u, 0u};
        asm volatile("s_waitcnt lgkmcnt(0)" ::: "memory");
#pragma unroll 4
        for (int g = 0; g < ng; ++g) { const unsigned u = f2sort(S[g * 64 + lane]);
            if (((u >> shift) >> 8) == prefix) __hip_atomic_fetch_add(wh + ((u >> shift) & 255u), 1u, __ATOMIC_RELAXED, __HIP_MEMORY_SCOPE_WORKGROUP); }
        asm volatile("s_waitcnt lgkmcnt(0)" ::: "memory");
        unsigned cc[4];
#pragma unroll
        for (int i = 0; i < 4; ++i) cc[i] = wh[4 * lane + i];
        const unsigned tot = cc[0] + cc[1] + cc[2] + cc[3];
        unsigned incl = tot;
#pragma unroll
        for (int off = 1; off < 64; off <<= 1) { const unsigned t = __shfl_down(incl, off); if (lane + off < 64) incl += t; }
        const unsigned above = incl - tot;
        const bool hit = above < need && need <= incl;
        unsigned ca = above, dsel = 0u; bool found = false;
#pragma unroll
        for (int i = 3; i >= 0; --i) if (!found) { if (ca + cc[i] >= need) { found = true; dsel = (unsigned)(4 * lane + i); } else ca += cc[i]; }
        const u64 hm = __ballot(hit); const int hl = hm ? (int)__builtin_ctzll(hm) : 0;
        const unsigned bsel = (unsigned)__shfl((int)dsel, hl), bca = (unsigned)__shfl((int)ca, hl);
        prefix = (prefix << 8) | bsel; need -= bca;
        asm volatile("" ::: "memory");
    }
    unsigned rem = need;
#pragma unroll 2
    for (int g = 0; g < ng; ++g) { const unsigned u = f2sort(S[g * 64 + lane]);
        const u64 gt = __ballot(u > prefix), eq = __ballot(u == prefix);
        const unsigned below = __builtin_amdgcn_mbcnt_hi((unsigned)(eq >> 32), __builtin_amdgcn_mbcnt_lo((unsigned)eq, 0u));
        const u64 pick = __ballot(u == prefix && below < rem);
        const unsigned np = (unsigned)__builtin_popcountll(pick);
        rem -= np;
        if (lane == 0) mq[(size_t)g * 4096] = gt | pick; }
}
template <int MODE>
__device__ __forceinline__ void select_sweep(const bf16_t* __restrict__ ikb, const bf16x8 (&bq)[4][2], const f32x4 wq, int kh, int ng, int fr, int fq, bool active, unsigned P0, unsigned P1,
                                             LAS unsigned* hrow, u64* __restrict__ mrow, float flo = 0.f, float finv = 0.f, float* amax = nullptr, LAS unsigned* lcnt = nullptr, LAS u64* lrow = nullptr, unsigned cap = 0u, unsigned zg = 0u, unsigned zk = 0u, unsigned fs = 0u, bool dmp = false, LAS float* scb = nullptr) {
    const float tin = (P0 == 0u) ? -INFINITY : (float)P0;
    const float tsel = (P1 & 1u) ? tin : ((P0 >= 1023u) ? INFINITY : (float)(P0 + 1u));
    bf16x8 ka[8];
#define SEL_LOAD1(G, KT) do { const bf16_t* kp = ikb + (size_t)((G) * 64 + (KT) * 16 + fr) * 64 + 8 * fq; ka[2 * (KT)] = *(const bf16x8*)kp; ka[2 * (KT) + 1] = *(const bf16x8*)(kp + 32); } while (0)
    int g = kh;
    if (g < ng) {
#pragma unroll
        for (int kt = 0; kt < 4; ++kt) SEL_LOAD1(g, kt);
    }
#pragma unroll 1
    for (; g < ng; g += 2) {
        unsigned lo_ = 0u, hi_ = 0u, zlo_ = 0u, zhi_ = 0u;
        const bool more = (g + 2 < ng);
#pragma unroll
        for (int kt = 0; kt < 4; ++kt) {
            f32x4 dd[4];
#pragma unroll
            for (int j = 0; j < 4; ++j) {
                dd[j] = __builtin_amdgcn_mfma_f32_16x16x32_bf16(ka[2 * kt], bq[j][0], (f32x4){0.f, 0.f, 0.f, 0.f}, 0, 0, 0);
                dd[j] = __builtin_amdgcn_mfma_f32_16x16x32_bf16(ka[2 * kt + 1], bq[j][1], dd[j], 0, 0, 0);
            }
            if (more) SEL_LOAD1(g + 2, kt);
            f32x4 sc = (f32x4){0.f, 0.f, 0.f, 0.f};
#pragma unroll
            for (int j = 0; j < 4; ++j)
#pragma unroll
                for (int r = 0; r < 4; ++r) sc[r] += wq[j] * relu1(dd[j][r]);
            unsigned nib = 0u, znib = 0u;
#pragma unroll
            for (int r = 0; r < 4; ++r) {
                const unsigned u = f2sort(sc[r] + 0.0f), inv = (unsigned)(4095 - (g * 64 + kt * 16 + 4 * fq + r));
                if (MODE == 5) { nib |= ((u > P0) || (u == P0 && inv >= P1)) ? (1u << r) : 0u; }
                else if (MODE == 6) { *amax = fmaxf(*amax, fabsf(sc[r])); }
                else if (MODE == 7) { const unsigned bi = (unsigned)(int)fminf(fmaxf(__builtin_fmaf(sc[r], finv, 512.0f), 0.f), 1023.f);
                    if (bi >= P0) __hip_atomic_fetch_add(hrow + (bi >> 1), (bi & 1u) ? 65536u : 1u, __ATOMIC_RELAXED, __HIP_MEMORY_SCOPE_WORKGROUP);
                    if (lcnt != nullptr && sc[r] == 0.0f) znib += 1u; }
                else if (MODE == 8) { const float tb = __builtin_fmaf(sc[r], finv, 512.0f);
                    const bool s1 = fs == 0u && tb >= tsel;
                    nib |= s1 ? (1u << r) : 0u;
                    if (fs == 0u && !s1 && tb >= tin) {
                        if ((P1 & 2u) != 0u && sc[r] == 0.0f) znib |= (1u << r);
                        else { const unsigned pos = __hip_atomic_fetch_add(lcnt, 1u, __ATOMIC_RELAXED, __HIP_MEMORY_SCOPE_WORKGROUP); if (pos < cap) lrow[pos] = ((u64)u << 12) | (u64)inv; } } }
                else if (MODE == 9) { }
                else { bool match; unsigned dg;
                    if (MODE == 0) { match = active; dg = u >> 22; }
                    else if (MODE == 1) { match = active && (u >> 22) == P0; dg = (u >> 12) & 1023u; }
                    else if (MODE == 2) { match = active && (u >> 12) == P0; dg = (u >> 2) & 1023u; }
                    else if (MODE == 3) { match = active && (u >> 2) == P0; dg = ((u & 3u) << 8) | (inv >> 4); }
                    else { match = active && u == P0 && (inv >> 4) == P1; dg = inv & 15u; }
                    if (match) __hip_atomic_fetch_add(hrow + (dg >> 1), (dg & 1u) ? 65536u : 1u, __ATOMIC_RELAXED, __HIP_MEMORY_SCOPE_WORKGROUP); }
            }
            if (MODE == 8 || MODE == 9) { if (dmp) *(LAS f32x4*)(scb + g * 64 + kt * 16 + 4 * fq) = sc + 0.0f; }
            if (MODE == 5 || MODE == 8) { const unsigned sh = (unsigned)((kt & 1) * 16 + 4 * fq); if (kt < 2) lo_ |= nib << sh; else hi_ |= nib << sh; }
            if (MODE == 8) { const unsigned sh = (unsigned)((kt & 1) * 16 + 4 * fq); if (kt < 2) zlo_ |= znib << sh; else zhi_ |= znib << sh; }
            if (MODE == 7) { if (znib != 0u) __hip_atomic_fetch_add(lcnt + (g >> 1), znib << (16 * (g & 1)), __ATOMIC_RELAXED, __HIP_MEMORY_SCOPE_WORKGROUP); }
        }
        if (MODE == 5 || MODE == 8) { lo_ |= __shfl_xor(lo_, 16); lo_ |= __shfl_xor(lo_, 32); hi_ |= __shfl_xor(hi_, 16); hi_ |= __shfl_xor(hi_, 32);
            u64 word = ((u64)hi_ << 32) | (u64)lo_;
            if (MODE == 8 && (P1 & 2u) != 0u) {
                zlo_ |= __shfl_xor(zlo_, 16); zlo_ |= __shfl_xor(zlo_, 32); zhi_ |= __shfl_xor(zhi_, 16); zhi_ |= __shfl_xor(zhi_, 32);
                u64 zm = ((u64)zhi_ << 32) | (u64)zlo_;
                if (g > (int)zg) zm = 0ull; else if (g == (int)zg) { u64 pick = 0ull; for (unsigned i = 0; i < zk; ++i) { const u64 bb = zm & (0ull - zm); pick |= bb; zm ^= bb; } zm = pick; }
                word |= zm; }
            if (fq == 0 && (MODE != 8 || fs == 0u)) mrow[(size_t)g * 4096] = word; }
    }
#undef SEL_LOAD1
}
__device__ __forceinline__ void select_item(const Frame& F, int b, int qb, const bf16_t* __restrict__ IQ, const bf16_t* __restrict__ IK, const float* __restrict__ IW, u64* __restrict__ MASK) {
    constexpr int HS = 513;
    LAS unsigned* hist = (LAS unsigned*)(F.lds + LDS_A);
    LAS u64* Pq = (LAS u64*)(F.lds + LDS_B + 2048);
    LAS u64* Thr = (LAS u64*)(F.lds + LDS_B + 2048 + 512);
    LAS unsigned* Need = (LAS unsigned*)(F.lds + LDS_B + 2048 + 1024);
    LAS unsigned* Done = (LAS unsigned*)(F.lds + LDS_B + 2048 + 1280);
    LAS unsigned* NDone = (LAS unsigned*)(F.lds + LDS_B + 2048 + 1536);
    const int lane = lane_id_fresh(), w = WAVE_FRESH(), qg = w & 3, kh = w >> 2, fr = lane & 15, fq = lane >> 4;
    const int q0 = qb * 64, ql = 16 * qg + fr, ng = qb + 1, tid = w * 64 + lane;
    u64* mrow = MASK + (size_t)b * 64 * 4096 + (q0 + ql);
    if (qb < 4) {
        for (int g = kh; g < ng; g += 2) if (fq == 0) mrow[(size_t)g * 4096] = ~0ull;
        return;
    }
    bf16x8 bq[4][2]; f32x4 wq;
#pragma unroll
    for (int j = 0; j < 4; ++j)
#pragma unroll
        for (int ks = 0; ks < 2; ++ks) bq[j][ks] = *(const bf16x8*)(IQ + ((size_t)((b * 4 + j) * 4096 + q0 + ql)) * 64 + 32 * ks + 8 * fq);
    wq = *(const f32x4*)(IW + (size_t)(b * 4096 + q0 + ql) * 4);
    const bf16_t* ikb = IK + (size_t)b * 4096 * 64;
    {
        constexpr unsigned CAP = 128u, NSLOT = 4u;
        LAS unsigned* AMX = (LAS unsigned*)(F.lds + LDS_B + 2048 + 1792);
        LAS unsigned* LCN = (LAS unsigned*)(F.lds + LDS_B + 2048 + 2048);
        LAS unsigned* ALQ = (LAS unsigned*)(F.lds + LDS_B + 2048 + 2304);
        LAS u64* LST = (LAS u64*)(F.lds + LDS_A);
        LAS unsigned* ZH = (LAS unsigned*)(F.lds + LDS_B + 8192);
        LAS unsigned* ZGK = (LAS unsigned*)(F.lds + LDS_B + 2048 + 3072);
        LAS unsigned* OVF = (LAS unsigned*)(F.lds + LDS_B + 2048 + 2560);
        LAS unsigned* FSL = (LAS unsigned*)(F.lds + LDS_B + 2048 + 3328);
        LAS unsigned* FQS = (LAS unsigned*)(F.lds + LDS_B + 2048 + 3840);
        LAS unsigned* NFL = (LAS unsigned*)(F.lds + LDS_B + 2048 + 3584);
        LAS float* SCB = (LAS float*)(F.lds + LDS_A + 65536);
        if (tid < 64) { AMX[tid] = 0u; LCN[tid] = 0u; ALQ[tid] = 0u; Need[tid] = 256u; Pq[tid] = 0ull; ZGK[tid] = 0u; FSL[tid] = 0u; }
        if (tid == 0) { OVF[0] = 0u; NFL[0] = 0u; }
#define SEL_RESCUE(Q) do { const unsigned s_ = __hip_atomic_fetch_add(NFL, 1u, __ATOMIC_RELAXED, __HIP_MEMORY_SCOPE_WORKGROUP); if (s_ < 64u) { FSL[Q] = s_ + 1u; FQS[s_] = (unsigned)(Q); } else OVF[0] = 1u; } while (0)
        for (int i = tid; i < 64 * 32; i += NTHREADS) ZH[i] = 0u;
        for (int i = tid; i < (64 * HS + 3) / 4; i += NTHREADS) ((LAS u32x4*)hist)[i] = (u32x4){0u, 0u, 0u, 0u};
        __syncthreads();
        { float am = 0.f;
          select_sweep<6>(ikb, bq, wq, kh, 2, fr, fq, true, 0u, 0u, hist, mrow, 0.f, 0.f, &am);
          am = fmaxf(am, __shfl_xor(am, 16)); am = fmaxf(am, __shfl_xor(am, 32));
          if (fq == 0) __hip_atomic_fetch_max(AMX + ql, __float_as_uint(am), __ATOMIC_RELAXED, __HIP_MEMORY_SCOPE_WORKGROUP); }
        __syncthreads();
        const float fhi = __uint_as_float(((AMX[ql] >> 23) + 2u) << 23), flo = -fhi, finv = 512.0f / fhi;
        LAS unsigned* LBN = (LAS unsigned*)(F.lds + LDS_B + 2048 + 2816);
        select_sweep<7>(ikb, bq, wq, kh, 2, fr, fq, true, 0u, 0u, hist + ql * HS, mrow, flo, finv);
        __syncthreads();
        { const unsigned nvis = 64u * (unsigned)ng; unsigned msel = (128u * 256u * 3u + nvis - 1u) / nvis + 8u;
          for (int qi = 0; qi < 8; ++qi) { const int q = 8 * w + qi; unsigned dsel, ca, csel, tall;
              const bool hit = scan_hist_row(hist + q * HS, lane, msel, dsel, ca, csel, tall);
              if (msel >= 128u) { if (lane == 0) LBN[q] = 0u; } else if (hit) LBN[q] = dsel; } }
        __syncthreads();
        for (int i = tid; i < (64 * HS + 3) / 4; i += NTHREADS) ((LAS u32x4*)hist)[i] = (u32x4){0u, 0u, 0u, 0u};
        __syncthreads();
        select_sweep<7>(ikb, bq, wq, kh, ng, fr, fq, true, LBN[ql], 0u, hist + ql * HS, mrow, flo, finv, nullptr, ZH + ql * 32);
        __syncthreads();
        for (int qi = 0; qi < 8; ++qi) {
            const int q = 8 * w + qi; unsigned dsel, ca, csel, tall;
            const bool hit = scan_hist_row(hist + q * HS, lane, 256u, dsel, ca, csel, tall);
            if (lane == 0 && tall < 256u) SEL_RESCUE(q);
            const u64 hm = __ballot(hit); const int hl = hm ? (int)__builtin_ctzll(hm) : 0;
            const unsigned bsel = (unsigned)__shfl((int)dsel, hl), bca = (unsigned)__shfl((int)ca, hl), bcs = (unsigned)__shfl((int)csel, hl);
            if (hm != 0ull) {
                const unsigned nneed = 256u - bca;
                if (lane == 0) { Pq[q] = (u64)bsel; Need[q] = nneed; }
                if (bcs == nneed) { if (lane == 0) ALQ[q] = 1u; }
                else { const float qhi = __uint_as_float(((AMX[q] >> 23) + 2u) << 23); const unsigned bz = (unsigned)(int)fminf(fmaxf((0.0f + qhi) * (512.0f / qhi), 0.f), 1023.f);
                    unsigned cl = bcs;
                    if (bsel == bz) {
                        const unsigned zz = ZH[q * 32 + (lane >> 1)], zc = (lane & 1) ? (zz >> 16) : (zz & 0xffffu);
                        unsigned incl = zc;
#pragma unroll
                        for (int off = 1; off < 64; off <<= 1) { const unsigned t = (unsigned)__shfl_up((int)incl, off); if (lane >= off) incl += t; }
                        const unsigned Z = (unsigned)__shfl((int)incl, 63);
                        const unsigned p = bcs - Z;
                        const unsigned zsel = nneed > p ? (nneed - p < Z ? nneed - p : Z) : 0u;
                        const u64 gm = __ballot(incl >= zsel && zsel != 0u); const int gl = gm ? (int)__builtin_ctzll(gm) : 0;
                        const unsigned gex = (unsigned)__shfl((int)(incl - zc), gl);
                        const unsigned G = zsel ? (unsigned)gl : 0u, kin = zsel ? zsel - gex : 0u;
                        if (lane == 0) ZGK[q] = ((G << 8) | kin) + 1u;
                        cl = p; }
                    if (cl > CAP && lane == 0) SEL_RESCUE(q); } }
        }
        __syncthreads();
        if (OVF[0] == 0u) {
            LAS u64* lrow = LST + ql * CAP;
            const unsigned zgk = ZGK[ql], fs = FSL[ql];
            select_sweep<8>(ikb, bq, wq, kh, ng, fr, fq, true, (unsigned)Pq[ql], ALQ[ql] | (zgk != 0u ? 2u : 0u), hist, mrow, flo, finv, nullptr, LCN + ql, lrow, CAP, (zgk - 1u) >> 8, (zgk - 1u) & 255u, fs, fs != 0u && fs <= NSLOT, SCB + ((fs - 1u) & (NSLOT - 1u)) * 4096u);
            asm volatile("s_waitcnt vmcnt(0)" ::: "memory");
            __syncthreads();
            for (int qi = 0; qi < 8; ++qi) {
                const int q = 8 * w + qi;
                if (ALQ[q] != 0u || FSL[q] != 0u) continue;
                const unsigned c = LCN[q], need = Need[q];
                const LAS u64* lq = LST + q * CAP;
                u64 ci[2]; unsigned rank[2];
#pragma unroll
                for (int m = 0; m < 2; ++m) { ci[m] = ((unsigned)(lane + 64 * m) < c) ? lq[lane + 64 * m] : ~0ull; rank[m] = 0u; }
                for (unsigned j = 0; j < c; ++j) { const u64 cj = lq[j];
#pragma unroll
                    for (int m = 0; m < 2; ++m) rank[m] += (cj > ci[m]) ? 1u : 0u; }
                u64* mq = MASK + (size_t)b * 64 * 4096 + (q0 + q);
#pragma unroll
                for (int m = 0; m < 2; ++m) if ((unsigned)(lane + 64 * m) < c && rank[m] < need) { const unsigned key = 4095u - (unsigned)(ci[m] & 4095ull);
                    __hip_atomic_fetch_or(mq + (size_t)(key >> 6) * 4096, 1ull << (key & 63u), __ATOMIC_RELAXED, __HIP_MEMORY_SCOPE_AGENT); }
            }
            const unsigned nfl = NFL[0];
            if ((unsigned)w < (nfl < NSLOT ? nfl : NSLOT)) { const unsigned q = FQS[w];
                select_exact_wave(SCB + w * 4096, ng, ZH + w * 256, MASK + (size_t)b * 64 * 4096 + (q0 + (int)q), lane); }
            if (__builtin_expect(nfl > NSLOT, 0))
_Pragma("unroll 1")
            for (unsigned base = NSLOT; base < nfl; base += 8u) {
                __syncthreads();
                const bool dm = fs > base && fs <= base + 8u;
                select_sweep<9>(ikb, bq, wq, kh, ng, fr, fq, true, 0u, 0u, hist, mrow, 0.f, 0.f, nullptr, nullptr, nullptr, 0u, 0u, 0u, fs, dm, (LAS float*)(F.lds + LDS_A) + ((fs - base - 1u) & 7u) * 4096u);
                __syncthreads();
                if (base + (unsigned)w < nfl) { const unsigned q = FQS[base + w];
                    select_exact_wave((LAS float*)(F.lds + LDS_A) + w * 4096, ng, ZH + w * 256, MASK + (size_t)b * 64 * 4096 + (q0 + (int)q), lane); }
            }
            __syncthreads();
            return;
        }
#undef SEL_RESCUE
    }
    if (tid < 64) { Pq[tid] = 0ull; Need[tid] = 256u; Done[tid] = 0u; Thr[tid] = 0ull; }
    if (tid == 0) NDone[0] = 0u;
    __syncthreads();
    for (int pass = 0; pass < 5; ++pass) {
        const int sh_hi = 44 - 10 * pass, wbits = sh_hi < 10 ? sh_hi : 10, sh_lo = sh_hi - wbits;
        for (int i = tid; i < (64 * HS + 3) / 4; i += NTHREADS) ((LAS u32x4*)hist)[i] = (u32x4){0u, 0u, 0u, 0u};
        __syncthreads();
        const u64 myP = Pq[ql]; const bool active = Done[ql] == 0u;
        LAS unsigned* hrow = hist + ql * HS;
        if (pass == 0) select_sweep<0>(ikb, bq, wq, kh, ng, fr, fq, active, 0u, 0u, hrow, mrow);
        else if (pass == 1) select_sweep<1>(ikb, bq, wq, kh, ng, fr, fq, active, (unsigned)myP, 0u, hrow, mrow);
        else if (pass == 2) select_sweep<2>(ikb, bq, wq, kh, ng, fr, fq, active, (unsigned)myP, 0u, hrow, mrow);
        else if (pass == 3) select_sweep<3>(ikb, bq, wq, kh, ng, fr, fq, active, (unsigned)myP, 0u, hrow, mrow);
        else select_sweep<4>(ikb, bq, wq, kh, ng, fr, fq, active, (unsigned)(myP >> 8), (unsigned)myP & 255u, hrow, mrow);
        __syncthreads();
        for (int qi = 0; qi < 8; ++qi) {
            const int q = 8 * w + qi;
            if (Done[q] != 0u) continue;
            unsigned wd[8];
#pragma unroll
            for (int i = 0; i < 8; ++i) wd[i] = hist[q * HS + 8 * lane + i];
            unsigned tot = 0;
#pragma unroll
            for (int i = 0; i < 8; ++i) tot += (wd[i] & 0xffffu) + (wd[i] >> 16);
            unsigned incl = tot;
#pragma unroll
            for (int off = 1; off < 64; off <<= 1) { const unsigned t = __shfl_down(incl, off); if (lane + off < 64) incl += t; }
            const unsigned above = incl - tot, need = Need[q];
            if (above < need && need <= incl) {
                unsigned ca = above, dsel = 0, csel = 0; bool found = false;
#pragma unroll
                for (int i = 15; i >= 0; --i) { const unsigned c = (i & 1) ? (wd[i >> 1] >> 16) : (wd[i >> 1] & 0xffffu);
                    if (!found) { if (ca + c >= need) { found = true; dsel = (unsigned)(16 * lane + i); csel = c; } else ca += c; } }
                const unsigned nneed = need - ca;
                const u64 np = (Pq[q] << wbits) | (u64)dsel;
                Pq[q] = np; Need[q] = nneed;
                if (csel == nneed || sh_lo == 0) { Done[q] = 1u; Thr[q] = np << sh_lo; __hip_atomic_fetch_add(NDone, 1u, __ATOMIC_RELAXED, __HIP_MEMORY_SCOPE_WORKGROUP); }
            }
        }
        __syncthreads();
        if (NDone[0] >= 64u) break;
    }
    const u64 thr = Thr[ql];
    select_sweep<5>(ikb, bq, wq, kh, ng, fr, fq, true, (unsigned)(thr >> 12), (unsigned)thr & 4095u, hist, mrow);
    __syncthreads();
}

__device__ __forceinline__ void knorm_item(const Frame& F, const bf16_t* __restrict__ Kt, float* __restrict__ out) {
    const int lane = lane_id_fresh(), tid = F.wave * 64 + lane;
    float mx = 0.f;
    for (int r = tid; r < 2048; r += NTHREADS) {
        const u32x4* p = (const u32x4*)(Kt + (size_t)r * 64); float s = 0.f;
#pragma unroll
        for (int c = 0; c < 8; ++c) { const u32x4 v = p[c];
            s += bf_lo(v.x) * bf_lo(v.x) + bf_hi(v.x) * bf_hi(v.x) + bf_lo(v.y) * bf_lo(v.y) + bf_hi(v.y) * bf_hi(v.y) + bf_lo(v.z) * bf_lo(v.z) + bf_hi(v.z) * bf_hi(v.z) + bf_lo(v.w) * bf_lo(v.w) + bf_hi(v.w) * bf_hi(v.w); }
        mx = fmaxf(mx, s);
    }
#pragma unroll
    for (int o = 1; o < 64; o <<= 1) mx = fmaxf(mx, __shfl_xor(mx, o));
    LAS float* red = (LAS float*)(F.lds + LDS_B + 6144);
    if (lane == 0) red[F.wave] = mx;
    __syncthreads();
    if (tid == 0) { float m = red[0];
#pragma unroll
        for (int i = 1; i < NWAVES; ++i) m = fmaxf(m, red[i]);
        *out = m; }
    __syncthreads();
}
typedef float f32x16 __attribute__((ext_vector_type(16)));
__device__ __forceinline__ float fadd_s(float a, float b) { float r; asm("v_add_f32 %0, %1, %2" : "=v"(r) : "v"(a), "v"(b)); return r; }
template <bool DSA>
__device__ __forceinline__ void attn_item(const Frame& F, int b, int hsel, int QB, const bf16_t* __restrict__ Qg, const bf16_t* __restrict__ Kg, const bf16_t* __restrict__ VTg,
                                          const u64* __restrict__ MASK, bf16_t* __restrict__ MIX, float lam, float lam_init, const float* __restrict__ subln_g, const float* __restrict__ KN) {
    constexpr int NDB = DSA ? 2 : 4;
    constexpr float THR = 6.0f;
    const int lane = lane_id_fresh(), w = WAVE_FRESH(), tid = w * 64 + lane, st = w >> 2, wq = w & 3, r32 = lane & 31, hh = lane >> 5;
    const int q0 = QB * 128, tq = q0 + 32 * wq + r32, nt = 2 * QB + 2, mychunk = 2 * QB + (wq >> 1);
    const int head = 2 * hsel + st;
    const float slope = DSA ? exp2f(-(float)(head + 1)) : exp2f(-2.0f * (float)(hsel + 1));
    const float SL = slope * LOG2E;
    bf16x8 qf[4];
    { const bf16_t* qp = Qg + ((size_t)((b * 8 + head) * 4096 + tq)) * 64 + 8 * hh;
#pragma unroll
      for (int ks = 0; ks < 4; ++ks) qf[ks] = *(const bf16x8*)(qp + 16 * ks); }
    float BQK;
    { float q2 = 0.f;
#pragma unroll
      for (int ks = 0; ks < 4; ++ks) { const u32x4 qw = __builtin_bit_cast(u32x4, qf[ks]);
          q2 += bf_lo(qw.x) * bf_lo(qw.x) + bf_hi(qw.x) * bf_hi(qw.x) + bf_lo(qw.y) * bf_lo(qw.y) + bf_hi(qw.y) * bf_hi(qw.y) + bf_lo(qw.z) * bf_lo(qw.z) + bf_hi(qw.z) * bf_hi(qw.z) + bf_lo(qw.w) * bf_lo(qw.w) + bf_hi(qw.w) * bf_hi(qw.w); }
      q2 += __shfl_xor(q2, 32);
#pragma unroll
      for (int o = 1; o < 32; o <<= 1) q2 = fmaxf(q2, __shfl_xor(q2, o));
      const float* knp = KN + ((b * 16 + (DSA ? 8 : 0) + head) * 2);
      BQK = sqrtf(q2) * sqrtf(fmaxf(knp[0], knp[1])) * 1.0001f + 0.01f; }
    asm volatile("" : "+v"(BQK));
    LAS int* DN = (LAS int*)(F.lds + LDS_B + 4096);
    if (lane == 0) DN[w] = -1;
    int mydn = -1;
    const int lrow = 8 * w + (lane >> 3), lc = (lane & 7) ^ ((lrow >> 1) & 7);
    const unsigned koff = (unsigned)(lrow * 64 + lc * 8) * 2u, voff = (unsigned)(lrow * 4096 + lc * 8) * 2u;
    const unsigned char* gb[4];
    gb[0] = (const unsigned char*)(Kg + ((size_t)((b * 8 + 2 * hsel + 0) * 4096)) * 64);
    gb[1] = (const unsigned char*)(Kg + ((size_t)((b * 8 + 2 * hsel + 1) * 4096)) * 64);
    if (DSA) { gb[2] = (const unsigned char*)(VTg + ((size_t)((b * 8 + 2 * hsel + 0) * 64)) * 4096); gb[3] = (const unsigned char*)(VTg + ((size_t)((b * 8 + 2 * hsel + 1) * 64)) * 4096); }
    else     { gb[2] = (const unsigned char*)(VTg + ((size_t)((b * 4 + hsel) * 128)) * 4096);         gb[3] = (const unsigned char*)(VTg + ((size_t)((b * 4 + hsel) * 128 + 64)) * 4096); }
    const u64* mgsrc = DSA ? (MASK + ((size_t)b * 64 * 4096 + q0) + 2 * lane) : nullptr;
    LAS unsigned char* const ring = F.lds + LDS_A + w * 1024;
    LAS unsigned char* const mring = F.lds + LDS_B + 12288;
#ifdef PROBE_DMA2
#define ATT_REP_ 2
#else
#define ATT_REP_ 1
#endif
#define ATT_ISSUE(TT, STG) do { const int tt_ = (TT) < 0 ? 0 : (TT); \
        _Pragma("unroll") for (int rr_ = 0; rr_ < ATT_REP_; ++rr_) _Pragma("unroll") for (int i_ = 0; i_ < 4; ++i_) __builtin_amdgcn_global_load_lds((const unsigned*)(gb[i_] + (i_ < 2 ? (size_t)tt_ * 8192 : (size_t)tt_ * 128) + (i_ < 2 ? koff : voff)), (LAS unsigned*)(ring + (STG) * 32768 + i_ * 8192), 16, 0, 0); \
        if (DSA && w == 0) __builtin_amdgcn_global_load_lds((const unsigned*)(mgsrc + (size_t)tt_ * 4096), (LAS unsigned*)(mring + (STG) * 1024), 16, 0, 0); } while (0)
    const int swz = (r32 >> 1) & 7;
    const int kbase = st * 8192 + r32 * 128, vbase = 16384 + ((DSA ? st * 64 : 0) + r32) * 128;
    f32x16 o[NDB];
#pragma unroll
    for (int i = 0; i < NDB; ++i)
#pragma unroll
        for (int r = 0; r < 16; ++r) o[i][r] = 0.f;
    float mref = -INFINITY, lsum = 0.f;
    ATT_ISSUE(nt - 1, 0); ATT_ISSUE(nt - 2, 1);
    for (int ip = 0; ip < nt / 2; ++ip) {
        asm volatile("s_waitcnt vmcnt(0)" ::: "memory");
        __builtin_amdgcn_s_barrier();
        asm volatile("" ::: "memory");
        if (ip > 0) {
            const u32x4 d0 = *(const LAS u32x4*)DN, d1 = *(const LAS u32x4*)(DN + 4);
            const int dm = min(min(min((int)d0.x, (int)d0.y), min((int)d0.z, (int)d0.w)), min(min((int)d1.x, (int)d1.y), min((int)d1.z, (int)d1.w)));
            if (dm >= nt - 1 - 2 * ip) break;
        }
        if (ip + 1 < nt / 2) { ATT_ISSUE(nt - 3 - 2 * ip, 2 * ((ip + 1) & 1)); ATT_ISSUE(nt - 4 - 2 * ip, 2 * ((ip + 1) & 1) + 1); }
#pragma unroll 1
        for (int sub = 0; sub < 2; ++sub) {
        const int t = nt - 1 - 2 * ip - sub, stg = 2 * (ip & 1) + sub;
        LAS unsigned char* sb = F.lds + LDS_A + stg * 32768;
        if (t <= mychunk && t > mydn) {
            bf16x8 pb[4];
            bf16x8 kf[8];
#pragma unroll
            for (int kb = 0; kb < 2; ++kb)
#pragma unroll
                for (int ks = 0; ks < 4; ++ks) kf[kb * 4 + ks] = *(const LAS bf16x8*)(sb + kbase + kb * 4096 + (((2 * ks + hh) ^ swz) << 4));
            const bool unset = (mref == -INFINITY);
            const float mr = unset ? 0.f : mref;
            const float relq = (float)(tq - 64 * t - 4 * hh);
            unsigned mlo = 0u, mhi = 0u;
            if (DSA) { const u64 mw = *(const LAS u64*)(mring + stg * 1024 + (32 * wq + r32) * 8) >> (4 * hh); mlo = (unsigned)mw; mhi = (unsigned)(mw >> 32); }
            f32x16 s[2];
            if (t == mychunk) {
#pragma unroll
                for (int kb = 0; kb < 2; ++kb)
#pragma unroll
                    for (int r = 0; r < 16; ++r) { const float c = (float)(32 * kb + (r & 3) + 8 * (r >> 2)); s[kb][r] = -SL * fabsf(relq - c) - mr; }
            } else {
                const float B0 = -SL * relq - mr, SL8 = 8.0f * SL;
                float gb_ = B0;
#pragma unroll
                for (int kb = 0; kb < 2; ++kb)
#pragma unroll
                    for (int g4 = 0; g4 < 4; ++g4) {
                        float e_ = gb_; s[kb][4 * g4] = e_;
#pragma unroll
                        for (int j = 1; j < 4; ++j) { e_ = fadd_s(e_, SL); s[kb][4 * g4 + j] = e_; }
                        gb_ = fadd_s(gb_, SL8);
                    }
            }
            if (DSA) {
#pragma unroll
                for (int kb = 0; kb < 2; ++kb)
#pragma unroll
                    for (int r = 0; r < 16; ++r) { const int tm = __builtin_amdgcn_sbfe((int)(kb ? mhi : mlo), (r & 3) + 8 * (r >> 2), 1);
                        const float sv = s[kb][r]; s[kb][r] = __int_as_float((__float_as_int(sv) & tm) | (~tm & (int)0xff800000)); }
            }
#pragma unroll
            for (int kb = 0; kb < 2; ++kb)
#pragma unroll
                for (int ks = 0; ks < 4; ++ks) s[kb] = __builtin_amdgcn_mfma_f32_32x32x16_bf16(kf[kb * 4 + ks], qf[ks], s[kb], 0, 0, 0);
            __builtin_amdgcn_sched_group_barrier(0x100, 4, 0);
#pragma unroll
            for (int i = 0; i < 4; ++i) { __builtin_amdgcn_sched_group_barrier(0x008, 1, 0); __builtin_amdgcn_sched_group_barrier(0x100, 1, 0); }
            __builtin_amdgcn_sched_group_barrier(0x008, 4, 0);
            float mx = -INFINITY;
#pragma unroll
            for (int kb = 0; kb < 2; ++kb)
#pragma unroll
                for (int r = 0; r < 16; ++r) mx = fmaxf(mx, s[kb][r]);
            mx = fmaxf(mx, __shfl_xor(mx, 32));
            const bool need = unset ? (mx != -INFINITY) : (mx > THR);
            if (__any(need)) {
                const float delta = need ? mx : 0.f;
                const float scl = (unset || !need) ? 1.f : __builtin_amdgcn_exp2f(-delta);
#pragma unroll
                for (int kb = 0; kb < 2; ++kb)
#pragma unroll
                    for (int r = 0; r < 16; ++r) s[kb][r] -= delta;
#pragma unroll
                for (int i = 0; i < NDB; ++i)
#pragma unroll
                    for (int r = 0; r < 16; ++r) o[i][r] *= scl;
                lsum *= scl;
                mref = need ? (mr + delta) : mref;
            }
#pragma unroll
            for (int r = 0; r < 16; ++r) { s[0][r] = __builtin_amdgcn_exp2f(s[0][r]); s[1][r] = __builtin_amdgcn_exp2f(s[1][r]); }
            __builtin_amdgcn_sched_barrier(0);
            float ps0 = s[0][0], ps1 = s[1][0];
#pragma unroll
            for (int r = 1; r < 16; ++r) { ps0 = fadd_s(ps0, s[0][r]); ps1 = fadd_s(ps1, s[1][r]); }
            lsum += ps0 + ps1;
#pragma unroll
            for (int kb = 0; kb < 2; ++kb)
#pragma unroll
                for (int s2 = 0; s2 < 2; ++s2) {
                    u32x4 pk; pk.x = cvt_pk_bf16(s[kb][8 * s2 + 0], s[kb][8 * s2 + 1]); pk.y = cvt_pk_bf16(s[kb][8 * s2 + 2], s[kb][8 * s2 + 3]);
                    pk.z = cvt_pk_bf16(s[kb][8 * s2 + 4], s[kb][8 * s2 + 5]); pk.w = cvt_pk_bf16(s[kb][8 * s2 + 6], s[kb][8 * s2 + 7]);
                    pb[2 * kb + s2] = __builtin_bit_cast(bf16x8, pk);
                }
#pragma unroll
            for (int db = 0; db < NDB; ++db)
#pragma unroll
                for (int sg = 0; sg < 4; ++sg) {
                    const bf16x8 a = *(const LAS bf16x8*)(sb + vbase + db * 4096 + (((2 * sg + hh) ^ swz) << 4));
                    o[db] = __builtin_amdgcn_mfma_f32_32x32x16_bf16(a, pb[sg], o[db], 0, 0, 0);
                }
            __builtin_amdgcn_sched_group_barrier(0x100, 4, 1);
#pragma unroll
            for (int i = 0; i < 4 * NDB - 4; ++i) { __builtin_amdgcn_sched_group_barrier(0x008, 1, 1); __builtin_amdgcn_sched_group_barrier(0x100, 1, 1); }
            __builtin_amdgcn_sched_group_barrier(0x008, 4, 1);
            if (t > 0) {
                const float dmin = (float)(q0 + 32 * wq - 64 * t + 1);
                const bool okk = (mref != -INFINITY) && (BQK - SL * dmin - mref < -150.0f);
                if (__all(okk)) { mydn = t - 1; if (lane == 0) DN[w] = t - 1; }
            }
        }
        }
    }
    asm volatile("s_waitcnt vmcnt(0)" ::: "memory");
#undef ATT_ISSUE
    __syncthreads();
    lsum += __shfl_xor(lsum, 32);
    const float inv = 1.0f / lsum;
    const size_t tok = (size_t)b * 4096 + tq;
    if (DSA) {
#pragma unroll
        for (int db = 0; db < NDB; ++db)
#pragma unroll
            for (int g4 = 0; g4 < 4; g4 += 2) {
                const float z = inv;
                u32x2 pa, pb2;
                pa.x = cvt_pk_bf16(o[db][4 * g4 + 0] * z, o[db][4 * g4 + 1] * z); pa.y = cvt_pk_bf16(o[db][4 * g4 + 2] * z, o[db][4 * g4 + 3] * z);
                pb2.x = cvt_pk_bf16(o[db][4 * g4 + 4] * z, o[db][4 * g4 + 5] * z); pb2.y = cvt_pk_bf16(o[db][4 * g4 + 6] * z, o[db][4 * g4 + 7] * z);
                { auto r_ = __builtin_amdgcn_permlane32_swap(pa.x, pb2.x, false, false); pa.x = r_[0]; pb2.x = r_[1]; }
                { auto r_ = __builtin_amdgcn_permlane32_swap(pa.y, pb2.y, false, false); pa.y = r_[0]; pb2.y = r_[1]; }
                *(u32x4*)(MIX + tok * D + 512 + head * 64 + 32 * db + 8 * g4 + 8 * hh) = (u32x4){pa.x, pa.y, pb2.x, pb2.y}; }
    } else {
        LAS float* XB = (LAS float*)(F.lds + LDS_A);
        const int xq = (32 * wq + r32) * 132 + 4 * hh;
        if (st == 1) {
#pragma unroll
            for (int db = 0; db < NDB; ++db)
#pragma unroll
                for (int g4 = 0; g4 < 4; ++g4) *(LAS f32x4*)(XB + xq + 32 * db + 8 * g4) = (f32x4){o[db][4 * g4] * inv, o[db][4 * g4 + 1] * inv, o[db][4 * g4 + 2] * inv, o[db][4 * g4 + 3] * inv};
        }
        __syncthreads();
        if (st == 0) {
            float ss = 0.f;
#pragma unroll
            for (int db = 0; db < NDB; ++db)
#pragma unroll
                for (int g4 = 0; g4 < 4; ++g4) { const f32x4 o1 = *(const LAS f32x4*)(XB + xq + 32 * db + 8 * g4);
#pragma unroll
                    for (int j = 0; j < 4; ++j) { const float a = o[db][4 * g4 + j] * inv - o1[j] * lam; o[db][4 * g4 + j] = a; ss += a * a; } }
            ss += __shfl_xor(ss, 32);
            const float rn = (1.0f / sqrtf(ss * (1.0f / 128.0f) + LN_EPS)) * (1.0f - lam_init);
#pragma unroll
            for (int db = 0; db < NDB; ++db)
#pragma unroll
                for (int g4 = 0; g4 < 4; g4 += 2) { const f32x4 ga = *(const f32x4*)(subln_g + 32 * db + 8 * g4 + 4 * hh), gb = *(const f32x4*)(subln_g + 32 * db + 8 * g4 + 8 + 4 * hh);
                    u32x2 pa, pb2;
                    pa.x = cvt_pk_bf16(o[db][4 * g4 + 0] * rn * ga[0], o[db][4 * g4 + 1] * rn * ga[1]); pa.y = cvt_pk_bf16(o[db][4 * g4 + 2] * rn * ga[2], o[db][4 * g4 + 3] * rn * ga[3]);
                    pb2.x = cvt_pk_bf16(o[db][4 * g4 + 4] * rn * gb[0], o[db][4 * g4 + 5] * rn * gb[1]); pb2.y = cvt_pk_bf16(o[db][4 * g4 + 6] * rn * gb[2], o[db][4 * g4 + 7] * rn * gb[3]);
                    { auto r_ = __builtin_amdgcn_permlane32_swap(pa.x, pb2.x, false, false); pa.x = r_[0]; pb2.x = r_[1]; }
                    { auto r_ = __builtin_amdgcn_permlane32_swap(pa.y, pb2.y, false, false); pa.y = r_[0]; pb2.y = r_[1]; }
                    *(u32x4*)(MIX + tok * D + hsel * 128 + 32 * db + 8 * g4 + 8 * hh) = (u32x4){pa.x, pa.y, pb2.x, pb2.y}; }
        }
        __syncthreads();
    }
}
struct CandTab { unsigned char a[52], b[52]; };
__host__ __device__ constexpr CandTab make_cand_tab() {
    CandTab t{}; int n = 0;
    for (int a = 0; a < 16; ++a) for (int b = 0; b < 16; ++b) if ((a + 1) * (b + 1) <= 16) { t.a[n] = (unsigned char)a; t.b[n] = (unsigned char)b; ++n; }
    for (; n < 52; ++n) { t.a[n] = 0; t.b[n] = 0; }
    return t;
}
constexpr CandTab CAND = make_cand_tab();
constexpr int NCAND = 50;

#define PK_CEX(A, B) do { const unsigned hi_ = (A) > (B) ? (A) : (B), lo_ = (A) > (B) ? (B) : (A); (A) = hi_; (B) = lo_; } while (0)
__device__ __forceinline__ void pk_bitonic_merge16(unsigned (&x)[16]) {
#pragma unroll
    for (int j = 8; j >= 1; j >>= 1)
#pragma unroll
        for (int i = 0; i < 16; ++i) { const int l = i ^ j; if (l > i) PK_CEX(x[i], x[l]); }
}
__device__ __forceinline__ void pk_sort16(unsigned (&x)[16]) {
#pragma unroll
    for (int k = 2; k <= 16; k <<= 1)
#pragma unroll
        for (int j = k >> 1; j >= 1; j >>= 1)
#pragma unroll
            for (int i = 0; i < 16; ++i) { const int l = i ^ j; if (l > i) { if ((i & k) == 0) PK_CEX(x[i], x[l]); else PK_CEX(x[l], x[i]); } }
}
template <int XM>
__device__ __forceinline__ void pk_merge_lanes16(unsigned (&x)[16]) {
    unsigned y[16];
#pragma unroll
    for (int i = 0; i < 16; ++i) y[i] = (unsigned)__shfl_xor((int)x[15 - i], XM);
#pragma unroll
    for (int i = 0; i < 16; ++i) x[i] = x[i] > y[i] ? x[i] : y[i];
    pk_bitonic_merge16(x);
}
__device__ __forceinline__ void peer_topk_phase(const Frame& F, const bf16_t* __restrict__ PQ, const bf16_t* __restrict__ SUBK_l, int* __restrict__ EG) {
    const int lane = lane_id_fresh(), w = WAVE_FRESH(), tid = w * 64 + lane, fr = lane & 15, fq = lane >> 4;
    LAS unsigned char* sk = F.lds + LDS_A;
    LAS unsigned* LST = (LAS unsigned*)(F.lds + LDS_A + 65536) + w * 512;
#pragma unroll 1
    for (int lg = F.wg; lg < 256; lg += F.G) {
    const int pm = 16 * (lg & 7) + (lg >> 4), par = (lg >> 3) & 1;
#pragma unroll 1
    for (int hi = 0; hi < 4; ++hi) {
    const int h = par + 2 * hi;
    __syncthreads();
#pragma unroll
    for (int i = 0; i < 8; ++i) { const int id = tid + 512 * i, cs = id >> 11, row = (id >> 4) & 127, c16 = id & 15;
        const u32x4 v = *(const u32x4*)(SUBK_l + ((size_t)((h * 2 + cs) * 128 + row)) * 128 + c16 * 8);
        *(LAS u32x4*)(sk + cs * 32768 + row * 256 + ((c16 ^ (row & 15)) << 4)) = v; }
    __syncthreads();
    for (int it = 0; it < 2; ++it) {
        const int tt = 16 * pm + 2 * w + it, token = tt * 16 + fr;
#pragma unroll 1
        for (int cs = 0; cs < 2; ++cs) {
            bf16x8 qf[4];
#pragma unroll
            for (int ks = 0; ks < 4; ++ks) qf[ks] = *(const bf16x8*)(PQ + (size_t)(h >> 1) * PQ_PLANE + (size_t)token * 512 + (h & 1) * 256 + cs * 128 + 32 * ks + 8 * fq);
            unsigned x0[16], x1[16];
#pragma unroll
            for (int kt = 0; kt < 8; ++kt) {
                f32x4 sc = (f32x4){0.f, 0.f, 0.f, 0.f};
#pragma unroll
                for (int ks = 0; ks < 4; ++ks) { const int row = 16 * kt + fr, c16 = ks * 4 + fq;
                    const bf16x8 a = *(const LAS bf16x8*)(sk + cs * 32768 + row * 256 + ((c16 ^ (row & 15)) << 4));
                    sc = __builtin_amdgcn_mfma_f32_16x16x32_bf16(a, qf[ks], sc, 0, 0, 0); }
#pragma unroll
                for (int r = 0; r < 4; ++r) { const unsigned key = (f2sort(sc[r]) & ~127u) | (unsigned)(127 - (16 * kt + 4 * fq + r));
                    if (kt < 4) x0[kt * 4 + r] = key; else x1[(kt - 4) * 4 + r] = key; }
            }
            pk_sort16(x0); pk_sort16(x1);
#pragma unroll
            for (int i = 0; i < 16; ++i) x0[i] = x0[i] > x1[15 - i] ? x0[i] : x1[15 - i];
            pk_bitonic_merge16(x0);
            pk_merge_lanes16<16>(x0);
            pk_merge_lanes16<32>(x0);
            if (fq == 0) {
#pragma unroll
                for (int i = 0; i < 4; ++i) *(LAS u32x4*)(LST + cs * 256 + fr * 16 + 4 * i) = (u32x4){x0[4 * i], x0[4 * i + 1], x0[4 * i + 2], x0[4 * i + 3]};
            }
        }
        LDS_WAIT();
        unsigned win[16];
#pragma unroll
        for (int t = 0; t < 16; ++t) win[t] = 0u;
#pragma unroll
        for (int t = 0; t < 13; ++t) {
            const int a = fq == 0 ? CAND.a[t] : fq == 1 ? CAND.a[13 + t] : fq == 2 ? CAND.a[26 + t] : CAND.a[39 + t];
            const int bb = fq == 0 ? CAND.b[t] : fq == 1 ? CAND.b[13 + t] : fq == 2 ? CAND.b[26 + t] : CAND.b[39 + t];
            const unsigned k1 = LST[fr * 16 + a], k2 = LST[256 + fr * 16 + bb];
            const float cv = sort2f(k1 & ~127u) + sort2f(k2 & ~127u);
            const unsigned key = (f2sort(cv) & ~255u) | (unsigned)(255 - (a * 16 + bb));
            win[t] = (fq * 13 + t < NCAND) ? key : 0u;
        }
        pk_sort16(win);
        pk_merge_lanes16<16>(win);
        pk_merge_lanes16<32>(win);
        const float v0 = sort2f(win[0] & ~255u);
        float ev[16], es = 0.f;
#pragma unroll
        for (int k = 0; k < 16; ++k) { ev[k] = __expf(sort2f(win[k] & ~255u) - v0); es += ev[k]; }
        const float rs = 1.0f / es;
        int* egp = EG + ((size_t)token * 128 + h * 16) * 2;
#pragma unroll
        for (int k = 0; k < 16; ++k) {
            if ((k >> 2) == fq) {
                const unsigned flat = 255u - (win[k] & 255u), a = flat >> 4, bb = flat & 15u;
                const unsigned i1 = 127u - (LST[fr * 16 + a] & 127u), i2 = 127u - (LST[256 + fr * 16 + bb] & 127u);
                u32x2 e; e.x = i1 * 128u + i2; e.y = __float_as_uint(ev[k] * rs);
                *(u32x2*)(egp + 2 * k) = e;
            }
        }
        LDS_WAIT();
    }
    }
    }
    __syncthreads();
}

__device__ __forceinline__ float cvt_ubyte(unsigned x, int k) {
    float r;
    if (k == 0) asm("v_cvt_f32_ubyte0 %0, %1" : "=v"(r) : "v"(x));
    else if (k == 1) asm("v_cvt_f32_ubyte1 %0, %1" : "=v"(r) : "v"(x));
    else if (k == 2) asm("v_cvt_f32_ubyte2 %0, %1" : "=v"(r) : "v"(x));
    else asm("v_cvt_f32_ubyte3 %0, %1" : "=v"(r) : "v"(x));
    return r;
}
__device__ __forceinline__ void peer_gather_phase(const Frame& F, const bf16_t* __restrict__ H1, const int* __restrict__ EG, const unsigned char* __restrict__ U8, const unsigned char* __restrict__ V8,
                                                  const float* __restrict__ USC, const float* __restrict__ VSC, bf16_t* __restrict__ R2) {
    const int lane = lane_id_fresh(), w = WAVE_FRESH(), fr = lane & 15, fq = lane >> 4;
    LAS unsigned char* wl = F.lds + LDS_A + w * 12288;
    LAS float* WL16 = (LAS float*)(wl + 4096);
    LAS unsigned char* XS = wl; LAS float* WL = (LAS float*)(wl + 1024); LAS int* EL = (LAS int*)(wl + 1536); LAS float* USL = (LAS float*)(wl + 2048); LAS float* VSL = (LAS float*)(wl + 2560);
    for (int gwi = (F.G == 256 ? 256 * (F.wg & 7) + 8 * (F.wg >> 3) + w : F.wg * NWAVES + w); gwi < T / 16; gwi += (F.G == 256 ? T / 16 : F.G * NWAVES)) {
    for (int it = 0; it < 16; ++it) {
        const int token = gwi * 16 + it;
        const int* eg = EG + (size_t)token * 256;
        unsigned uoff[8];
#pragma unroll
        for (int hh = 0; hh < 8; ++hh) uoff[hh] = (unsigned)eg[(hh * 16 + fr) * 2] * 512u + 16u * fq;
        const int e0 = eg[lane * 2], e1 = eg[(64 + lane) * 2];
        const float us0 = USC[e0], us1 = USC[e1], vs0 = VSC[e0], vs1 = VSC[e1], g0 = __int_as_float(eg[lane * 2 + 1]), g1 = __int_as_float(eg[(64 + lane) * 2 + 1]);
        const u32x4 x0 = *(const u32x4*)(H1 + (size_t)token * D + 16 * lane), x1 = *(const u32x4*)(H1 + (size_t)token * D + 16 * lane + 8);
        float xf[16] = {bf_lo(x0.x), bf_hi(x0.x), bf_lo(x0.y), bf_hi(x0.y), bf_lo(x0.z), bf_hi(x0.z), bf_lo(x0.w), bf_hi(x0.w), bf_lo(x1.x), bf_hi(x1.x), bf_lo(x1.y), bf_hi(x1.y), bf_lo(x1.z), bf_hi(x1.z), bf_lo(x1.w), bf_hi(x1.w)};
        float am = 0.f;
#pragma unroll
        for (int i = 0; i < 16; ++i) am = fmaxf(am, fabsf(xf[i]));
#pragma unroll
        for (int o = 1; o < 64; o <<= 1) am = fmaxf(am, __shfl_xor(am, o));
        const float xinv = am > 0.f ? am * (1.0f / 127.0f) : 1.0f, xsc = 1.0f / xinv;
        int xsum = 0;
        { unsigned xp[4] = {0u, 0u, 0u, 0u};
#pragma unroll
          for (int i = 0; i < 16; ++i) { int q = (int)rintf(xf[i] * xsc); q = q < -127 ? -127 : (q > 127 ? 127 : q); xsum += q; xp[i >> 2] |= ((unsigned)q & 0xffu) << (8 * (i & 3)); }
          *(LAS u32x4*)(XS + 16 * lane) = (u32x4){xp[0], xp[1], xp[2], xp[3]}; }
#pragma unroll
        for (int o = 1; o < 64; o <<= 1) xsum += __shfl_xor(xsum, o);
        LDS_WAIT();
        typedef int i32x4 __attribute__((ext_vector_type(4)));
        i32x4 acc[8];
#pragma unroll
        for (int hh = 0; hh < 8; ++hh) acc[hh] = (i32x4){0, 0, 0, 0};
#define U_LOAD(SET, P) do { _Pragma("unroll") for (int hh = 0; hh < 8; ++hh) SET[hh] = *(const u32x4*)(U8 + uoff[hh] + 64 * (P)); } while (0)
#define U_MMA(SET, P) do { const i32x4 xb0 = *(const LAS i32x4*)(XS + 128 * (P) + 32 * fq), xb1 = *(const LAS i32x4*)(XS + 128 * (P) + 32 * fq + 16); \
            _Pragma("unroll") for (int hh = 0; hh < 8; ++hh) { \
                const i32x4 a0 = (i32x4){(int)(SET[hh].x & 0x0f0f0f0fu), (int)(SET[hh].y & 0x0f0f0f0fu), (int)((SET[hh].x >> 4) & 0x0f0f0f0fu), (int)((SET[hh].y >> 4) & 0x0f0f0f0fu)}; \
                const i32x4 a1 = (i32x4){(int)(SET[hh].z & 0x0f0f0f0fu), (int)(SET[hh].w & 0x0f0f0f0fu), (int)((SET[hh].z >> 4) & 0x0f0f0f0fu), (int)((SET[hh].w >> 4) & 0x0f0f0f0fu)}; \
                acc[hh] = __builtin_amdgcn_mfma_i32_16x16x64_i8(a0, xb0, acc[hh], 0, 0, 0); \
                acc[hh] = __builtin_amdgcn_mfma_i32_16x16x64_i8(a1, xb1, acc[hh], 0, 0, 0); } } while (0)
        u32x4 ua[8], ub[8];
        U_LOAD(ua, 0); U_LOAD(ub, 1);
#pragma unroll 1
        for (int p = 0; p < 6; p += 2) {
            U_MMA(ua, p); U_LOAD(ua, p + 2);
            U_MMA(ub, p + 1); U_LOAD(ub, p + 3);
        }
        U_MMA(ua, 6); U_MMA(ub, 7);
#undef U_LOAD
#undef U_MMA
        LAS int* AL = (LAS int*)(wl + 1536);
        if (fr == 0) {
#pragma unroll
            for (int hh = 0; hh < 8; ++hh) *(LAS i32x4*)(AL + hh * 16 + 4 * fq) = acc[hh];
        }
        LDS_WAIT();
        { const float d0 = ((float)AL[lane] - 7.5f * (float)xsum) * us0 * xinv, d1 = ((float)AL[64 + lane] - 7.5f * (float)xsum) * us1 * xinv;
          WL16[it * 128 + lane] = g0 * (0.5f * d0 * (1.0f + erff(d0 * 0.70710678118654752f))) * vs0;
          WL16[it * 128 + 64 + lane] = g1 * (0.5f * d1 * (1.0f + erff(d1 * 0.70710678118654752f))) * vs1; }
        LDS_WAIT();
    }
    for (int it = 0; it < 16; ++it) {
        const int token = gwi * 16 + it;
        const int* eg = EG + (size_t)token * 256;
        const int e0 = eg[lane * 2], e1 = eg[(64 + lane) * 2];
        const u32x4 x0 = *(const u32x4*)(H1 + (size_t)token * D + 16 * lane), x1 = *(const u32x4*)(H1 + (size_t)token * D + 16 * lane + 8);
        const float xf[16] = {bf_lo(x0.x), bf_hi(x0.x), bf_lo(x0.y), bf_hi(x0.y), bf_lo(x0.z), bf_hi(x0.z), bf_lo(x0.w), bf_hi(x0.w), bf_lo(x1.x), bf_hi(x1.x), bf_lo(x1.y), bf_hi(x1.y), bf_lo(x1.z), bf_hi(x1.z), bf_lo(x1.w), bf_hi(x1.w)};
        LAS float* WL = WL16 + it * 128;
        f32x2 o2[8];
#pragma unroll
        for (int i = 0; i < 8; ++i) o2[i] = (f32x2){0.f, 0.f};
        const float wr0 = WL[lane], wr1 = WL[64 + lane];
        const unsigned vlane = 8u * (unsigned)lane;

#define V_LOAD(SET, EREG, S0) do { _Pragma("unroll") for (int i = 0; i < 16; ++i) { const unsigned e = (unsigned)__builtin_amdgcn_readlane(EREG, (S0) + i); \
            SET[i] = *(const u32x2*)(V8 + (size_t)e * 512u + vlane); } } while (0)
#define V_FMA(SET, WREG, S0) do { _Pragma("unroll") for (int i = 0; i < 16; ++i) { const float ws = __builtin_bit_cast(float, __builtin_amdgcn_readlane(__builtin_bit_cast(int, WREG), (S0) + i)); \
            asm volatile("" : "+v"(SET[i].x), "+v"(SET[i].y), "+v"(o2[0]), "+v"(o2[1]), "+v"(o2[2]), "+v"(o2[3]), "+v"(o2[4]), "+v"(o2[5]), "+v"(o2[6]), "+v"(o2[7])); \
            const f32x2 w2_ = (f32x2){ws, ws}; \
            o2[0] = w2_ * __builtin_amdgcn_cvt_scalef32_pk_f32_fp4(SET[i].x, 1.0f, 0) + o2[0]; o2[1] = w2_ * __builtin_amdgcn_cvt_scalef32_pk_f32_fp4(SET[i].x, 1.0f, 1) + o2[1]; \
            o2[2] = w2_ * __builtin_amdgcn_cvt_scalef32_pk_f32_fp4(SET[i].x, 1.0f, 2) + o2[2]; o2[3] = w2_ * __builtin_amdgcn_cvt_scalef32_pk_f32_fp4(SET[i].x, 1.0f, 3) + o2[3]; \
            o2[4] = w2_ * __builtin_amdgcn_cvt_scalef32_pk_f32_fp4(SET[i].y, 1.0f, 0) + o2[4]; o2[5] = w2_ * __builtin_amdgcn_cvt_scalef32_pk_f32_fp4(SET[i].y, 1.0f, 1) + o2[5]; \
            o2[6] = w2_ * __builtin_amdgcn_cvt_scalef32_pk_f32_fp4(SET[i].y, 1.0f, 2) + o2[6]; o2[7] = w2_ * __builtin_amdgcn_cvt_scalef32_pk_f32_fp4(SET[i].y, 1.0f, 3) + o2[7]; } } while (0)
        u32x2 va[16], vb2[16];
        V_LOAD(va, e0, 0); V_LOAD(vb2, e0, 16);
        V_FMA(va, wr0, 0); V_LOAD(va, e0, 32); V_FMA(vb2, wr0, 16); V_LOAD(vb2, e0, 48);
        V_FMA(va, wr0, 32); V_LOAD(va, e1, 0); V_FMA(vb2, wr0, 48); V_LOAD(vb2, e1, 16);
        V_FMA(va, wr1, 0); V_LOAD(va, e1, 32); V_FMA(vb2, wr1, 16); V_LOAD(vb2, e1, 48);
        V_FMA(va, wr1, 32); V_FMA(vb2, wr1, 48);
#undef V_LOAD
#undef V_FMA
        float out[16];
#pragma unroll
        for (int i = 0; i < 16; ++i) out[i] = o2[i >> 1][i & 1];
#ifdef PROBE_ZERO_PEER
#pragma unroll
        for (int i = 0; i < 16; ++i) out[i] = 0.f;
#endif
        u32x4 r0, r1;
        r0.x = cvt_pk_bf16(ALPHA * xf[0] + out[0], ALPHA * xf[1] + out[1]); r0.y = cvt_pk_bf16(ALPHA * xf[2] + out[2], ALPHA * xf[3] + out[3]);
        r0.z = cvt_pk_bf16(ALPHA * xf[4] + out[4], ALPHA * xf[5] + out[5]); r0.w = cvt_pk_bf16(ALPHA * xf[6] + out[6], ALPHA * xf[7] + out[7]);
        r1.x = cvt_pk_bf16(ALPHA * xf[8] + out[8], ALPHA * xf[9] + out[9]); r1.y = cvt_pk_bf16(ALPHA * xf[10] + out[10], ALPHA * xf[11] + out[11]);
        r1.z = cvt_pk_bf16(ALPHA * xf[12] + out[12], ALPHA * xf[13] + out[13]); r1.w = cvt_pk_bf16(ALPHA * xf[14] + out[14], ALPHA * xf[15] + out[15]);
        *(u32x4*)(R2 + (size_t)token * D + 16 * lane) = r0; *(u32x4*)(R2 + (size_t)token * D + 16 * lane + 8) = r1;
    }
    LDS_WAIT();
    }
}
struct AttnItems { unsigned short v[1024]; };
__host__ __device__ constexpr AttnItems make_attn_items() {
    AttnItems t{}; int n = 0;
    const int lim[4] = {11, 37, 64, 64};
    for (int c = 66; c >= 0; --c)
        for (int b = 0; b < 8; ++b) for (int h = 0; h < 4; ++h) for (int q = 0; q < 32; ++q) {
            int tiles = 2 * q + 2; if (tiles > lim[h]) tiles = lim[h];
            if (tiles + 2 == c) t.v[n++] = (unsigned short)((b << 7) | (h << 5) | q);
        }
    return t;
}
__device__ const AttnItems ATTN_ITEMS = make_attn_items();
struct AttnItems1 { unsigned char v[128]; };
__host__ __device__ constexpr AttnItems1 make_attn_items1() {
    AttnItems1 t{}; int n = 0;
    const int lim[4] = {11, 37, 64, 64};
    for (int c = 66; c >= 0; --c)
        for (int h = 0; h < 4; ++h) for (int q = 0; q < 32; ++q) {
            int tiles = 2 * q + 2; if (tiles > lim[h]) tiles = lim[h];
            if (tiles + 2 == c) t.v[n++] = (unsigned char)((h << 5) | q);
        }
    return t;
}
__device__ const AttnItems1 ATTN_ITEMS1 = make_attn_items1();
constexpr int PH_PER_LAYER = 10, N_PHASES = 1 + DEPTH * PH_PER_LAYER;
struct Args {
    const float *x, *p, *ln_in_g, *ln_in_b, *w_in, *w_out, *diff_lambda, *diff_subln_g, *ln1_g, *ln1_b, *peer_wq, *peer_subkeys, *peer_u, *peer_v, *ple_wg, *ple_bg, *ple_wp, *ln2_g, *ln2_b;
    float* out; unsigned char* ws; int ph_lo, ph_hi;
};
__global__ void __launch_bounds__(NTHREADS, 2) fwd_kernel(Args args) {
    extern __shared__ __attribute__((aligned(16))) unsigned char lds_raw[];
    Frame F;
    F.lds = (LAS unsigned char*)lds_raw;
    F.tid = threadIdx.x; F.lane = F.tid & 63; F.wave = __builtin_amdgcn_readfirstlane(F.tid >> 6);
    F.G = gridDim.x; F.wg = blockIdx.x; F.ws = args.ws;
    unsigned char* ws = args.ws;
    if (F.tid < 64) ((LAS unsigned*)(F.lds + LDS_CTL))[F.tid] = 0u;
    __syncthreads();
    const int lo = args.ph_lo, hi = args.ph_hi; (void)lo; (void)hi;
#ifndef PHASE_MASK
#define PHASE_MASK 0x7ff
#endif
#ifndef REPEAT_MASK
#define REPEAT_MASK 0
#endif
#define REP(k) (1 + ((REPEAT_MASK >> (k)) & 1))
#define IN(k) (lo <= (k) && (k) < hi)
#define BOTH(k) (IN(k) && IN((k) + 1))
#if MK_PER_PHASE
#define GRID_BAR(k) do { } while (0)
#define GRP_BAR(k) do { } while (0)
#define PAIR_BAR(k) do { } while (0)
#else
    XcdBarrier bar = xcd_barrier_post((unsigned*)(ws + WS_CTL) + 4096, (volatile LAS unsigned*)(F.lds + LDS_CTL));
    if (F.G == 256) group_post(bar, (unsigned)(F.wg & 7));
#define GRID_BAR(k) do { if (BOTH(k)) { unsigned z_ = 0u; asm volatile("" : "+s"(z_)); XcdBarrier b2_ = bar; b2_.bar = bar.bar + z_; asm volatile("" : "+s"(b2_.x)); xcd_barrier(b2_); } } while (0)
#define GRP_BAR(k) do { if (BOTH(k)) { unsigned z_ = 0u; asm volatile("" : "+s"(z_)); XcdBarrier b2_ = bar; b2_.bar = bar.bar + z_; asm volatile("" : "+s"(b2_.x)); \
        group_barrier(b2_, XB_GRP(F.G == 256 ? (unsigned)(F.wg & 7) : 0u), F.G == 256 ? 32u : (unsigned)F.G); } } while (0)
#define TILE_PM (16 * (F.wg & 7) + (F.wg >> 4))
#define TILE_PAR ((F.wg >> 3) & 1)
#define PAIR_BAR(k) do { if (BOTH(k)) { unsigned z_ = 0u; asm volatile("" : "+s"(z_)); XcdBarrier b2_ = bar; b2_.bar = bar.bar + z_; asm volatile("" : "+s"(b2_.x)); \
        if (F.G == 256) group_barrier(b2_, XB_PAIR((unsigned)(TILE_PM)), 2u, 4); else group_barrier(b2_, XB_GRP(0u), (unsigned)F.G); } } while (0)
#endif
    const int gw = F.wg * NWAVES + F.wave, NGW = F.G * NWAVES;
#define ROW_BASE (F.G == 256 ? 4096 * (F.wg & 7) + 8 * (F.wg >> 3) + F.wave : gw)
#define ROW_STRIDE (F.G == 256 ? 256 : NGW)
#define ROW_END (F.G == 256 ? 4096 * ((F.wg & 7) + 1) : T)
#define TROW_BASE (F.G == 256 ? 256 * (16 * (F.wg & 7) + (F.wg >> 4)) + 128 * ((F.wg >> 3) & 1) + F.wave : gw)
#define TROW_STRIDE (F.G == 256 ? 8 : NGW)
#define TROW_END (F.G == 256 ? 256 * (16 * (F.wg & 7) + (F.wg >> 4)) + 128 * ((F.wg >> 3) & 1) + 128 : T)
    typedef const __attribute__((address_space(4))) Args* kargs_t;
    const kargs_t kp0 = (kargs_t)__builtin_amdgcn_kernarg_segment_ptr();
#define PHASE_ARGS() kargs_t ap = kp0; asm volatile("" : "+s"(ap)); unsigned char* const wsl = ap->ws; (void)wsl
#define H ((bf16_t*)(wsl + WS_H))
#define H1 ((bf16_t*)(wsl + WS_H1))
#define MIX ((bf16_t*)(wsl + WS_MIX))
#define R2 ((bf16_t*)(wsl + WS_R2))
#define RF ((bf16_t*)(wsl + WS_RF))
#define DQ ((bf16_t*)(wsl + WS_DQ))
#define DK ((bf16_t*)(wsl + WS_DK))
#define DVT ((bf16_t*)(wsl + WS_DVT))
#define SQ ((bf16_t*)(wsl + WS_SQ))
#define SK ((bf16_t*)(wsl + WS_SK))
#define SVT ((bf16_t*)(wsl + WS_SVT))
#define IQ ((bf16_t*)(wsl + WS_IQ))
#define IK ((bf16_t*)(wsl + WS_IK))
#define IW ((float*)(wsl + WS_IW))
#define PQ ((bf16_t*)(wsl + WS_PQ))
#define EG ((int*)(wsl + WS_EG))
#define MASK ((u64*)(wsl + WS_MASK))
#define PP MIX

    if (((PHASE_MASK >> 0) & 1) && IN(0)) for (int rep_ = 0; rep_ < REP(0); ++rep_) {
        PHASE_ARGS();
        LAS float* scr = (LAS float*)(F.lds + LDS_A + F.wave * 8448);
        for (int l = 0; l < DEPTH; ++l) {
            const float* win = ap->w_in + (size_t)l * D * IN_COLS;
            bf16_t* WIN = (bf16_t*)(wsl + WS_WIN) + (size_t)l * NMAIN * D; bf16_t* WINV = (bf16_t*)(wsl + WS_WINV) + (size_t)l * NVV * D;
#define DO_SEG(sgi, W_, WT_, K_, ldn_, c0_, nvalid_, ncols_) do { const int nblk = (ncols_) / 32, items = ((K_) / 64) * nblk, rot = (l * 9 + (sgi)) * 397; \
                for (int it = (gw + rot) % NGW; it < items; it += NGW) transpose_item((W_), (K_), (ldn_), (c0_), (nvalid_), (WT_), scr, it / nblk, it % nblk, F.lane); } while (0)
            DO_SEG(0, win, WIN, D, IN_COLS, 0, 1024, 1024);
            DO_SEG(1, win, WIN + (size_t)1024 * D, D, IN_COLS, 1536, 1024, 1024);
            DO_SEG(2, win, WIN + (size_t)2048 * D, D, IN_COLS, 3072, 324, 512);
            DO_SEG(3, win, WINV, D, IN_COLS, 1024, 512, 512);
            DO_SEG(4, win, WINV + (size_t)512 * D, D, IN_COLS, 2560, 512, 512);
            DO_SEG(5, ap->w_out + (size_t)l * D * D, (bf16_t*)(wsl + WS_WOUT) + (size_t)l * D * D, D, D, 0, D, D);
            DO_SEG(6, ap->peer_wq + (size_t)l * D * 2048, (bf16_t*)(wsl + WS_WPQ) + (size_t)l * 2048 * D, D, 2048, 0, 2048, 2048);
            DO_SEG(7, ap->ple_wg + (size_t)l * D * D, (bf16_t*)(wsl + WS_WG) + (size_t)l * D * D, D, D, 0, D, D);
            DO_SEG(8, ap->ple_wp + (size_t)l * 256 * D, (bf16_t*)(wsl + WS_WP) + (size_t)l * D * 256, 256, D, 0, D, D);
#undef DO_SEG
        }
        const size_t gtid = (size_t)F.wg * NTHREADS + F.tid, gthreads = (size_t)F.G * NTHREADS;
        convert_rows_i4(ap->peer_u, ws + WS_U8, (float*)(wsl + WS_USC), DEPTH * 16384, gw, NGW, F.lane);
        convert_rows_fp4(ap->peer_v, ws + WS_V8, (float*)(wsl + WS_VSC), DEPTH * 16384, gw, NGW, F.lane);
        convert_f32_bf16(ap->p, (bf16_t*)(wsl + WS_P16), (size_t)DEPTH * T * 256, gtid, gthreads);
        convert_f32_bf16(ap->peer_subkeys, (bf16_t*)(wsl + WS_SUBK), (size_t)DEPTH * 8 * 2 * 128 * 128, gtid, gthreads);
        for (int m = ROW_BASE; m < ROW_END; m += ROW_STRIDE) ln_row(ap->x + (size_t)m * D, ap->ln_in_g, ap->ln_in_b, H + (size_t)m * D, nullptr, F.lane);
        __syncthreads();
    }
    GRID_BAR(0);
#if !MK_PER_PHASE
    if (F.G == 256 && BOTH(0)) group_resolve(bar, (unsigned)(F.wg & 7));
#endif

    for (int l = 0; l < DEPTH; ++l) {
        const int pb = 1 + PH_PER_LAYER * l;
        const float lam_init = 0.8f - 0.6f * expf(-0.3f * (float)l);
        if (((PHASE_MASK >> 1) & 1) && IN(pb + 0)) for (int rep_ = 0; rep_ < REP(1); ++rep_) { PHASE_ARGS();
            { pg8::Gemm g{H, (const bf16_t*)(wsl + WS_WIN) + (size_t)l * NMAIN * D, T, NMAIN, D}; pg8::StaticOrder S; S.init(T, NMAIN, F.G, F.wg);
              epi::Proj E{DQ, DK, SQ, SK, IQ, IK, IW};
              pg8::gemm_phase<epi::Proj, pg8::StaticOrder, true, true>(F.lds + LDS_A, g, S, E, WAVE_FRESH()); }
            { pg8::Gemm g{H, (const bf16_t*)(wsl + WS_WINV) + (size_t)l * NVV * D, T, NVV, D}; pg8::StaticOrder S; S.init(T, NVV, F.G, F.wg);
              epi::ProjV E{DVT, SVT};
              pg8::gemm_phase<epi::ProjV, pg8::StaticOrder, true, true>(F.lds + LDS_A, g, S, E, WAVE_FRESH()); }
        }
        GRP_BAR(pb + 0);
        if (((PHASE_MASK >> 2) & 1) && IN(pb + 1)) for (int rep_ = 0; rep_ < REP(2); ++rep_) { PHASE_ARGS();
            for (int g = F.wg; g < 256; g += F.G) {
                const int kb_ = g & 7, pr = g >> 3, h16 = pr >> 1, hf = pr & 1;
                const bf16_t* Kt = (h16 < 8 ? DK : SK) + ((size_t)((kb_ * 8 + (h16 & 7)) * 4096 + hf * 2048)) * 64;
                knorm_item(F, Kt, (float*)(wsl + WS_KN) + ((kb_ * 16 + h16) * 2 + hf));
            }
            for (int g = F.wg; g < 256; g += F.G) {
                const int b = g & 7, j = g >> 3;
#pragma unroll 1
                for (int k = 0; k < 2; ++k) select_item(F, b, k ? j : 63 - j, IQ, IK, IW, MASK);
            }
        }
        GRP_BAR(pb + 1);
        if (((PHASE_MASK >> 3) & 1) && IN(pb + 2)) for (int rep_ = 0; rep_ < REP(3); ++rep_) { PHASE_ARGS();
            LAS float* lamw = (LAS float*)(F.lds + LDS_B + 8192);
            if (F.wave == 0) {
                const float* lv = ap->diff_lambda + (size_t)l * 256; const int ln = lane_id_fresh();
                const float s01 = wave_sum(lv[ln] * lv[64 + ln]), s23 = wave_sum(lv[128 + ln] * lv[192 + ln]);
                if (ln == 0) lamw[0] = expf(s01) - expf(s23) + lam_init;
            }
            __syncthreads();
            const float lam = lamw[0];
            const float* sg = ap->diff_subln_g + (size_t)l * 128;
#ifdef ATTN_GLOBAL_DEAL
            for (int r = 0; r < 4; ++r) {
                for (int g = F.wg; g < 256; g += F.G) {
                    const int itm = ATTN_ITEMS.v[256 * r + ((r & 1) ? 255 - g : g)];
                    attn_item<false>(F, itm >> 7, (itm >> 5) & 3, itm & 31, DQ, DK, DVT, nullptr, MIX, lam, lam_init, sg, (const float*)(wsl + WS_KN));
                }
            }
            for (int r = 0; r < 4; ++r) {
                for (int g = F.wg; g < 256; g += F.G) {
                    const int itm = ATTN_ITEMS.v[256 * r + ((r & 1) ? 255 - g : g)];
                    attn_item<true>(F, itm >> 7, (itm >> 5) & 3, itm & 31, SQ, SK, SVT, MASK, MIX, 0.f, 0.f, nullptr, (const float*)(wsl + WS_KN));
                }
            }
#else
            for (int r = 0; r < 4; ++r) {
                for (int g = F.wg; g < 256; g += F.G) {
                    const int xb = g & 7, c = g >> 3, itm = ATTN_ITEMS1.v[32 * r + ((r & 1) ? 31 - c : c)];
                    attn_item<false>(F, xb, itm >> 5, itm & 31, DQ, DK, DVT, nullptr, MIX, lam, lam_init, sg, (const float*)(wsl + WS_KN));
                }
            }
            for (int r = 0; r < 4; ++r) {
                for (int g = F.wg; g < 256; g += F.G) {
                    const int xb = g & 7, c = g >> 3, itm = ATTN_ITEMS1.v[32 * r + ((r & 1) ? 31 - c : c)];
                    attn_item<true>(F, xb, itm >> 5, itm & 31, SQ, SK, SVT, MASK, MIX, 0.f, 0.f, nullptr, (const float*)(wsl + WS_KN));
                }
            }
#endif
        }
        GRP_BAR(pb + 2);
        if (((PHASE_MASK >> 4) & 1) && IN(pb + 3)) for (int rep_ = 0; rep_ < REP(4); ++rep_) { PHASE_ARGS();
            pg8::Gemm g{MIX, (const bf16_t*)(wsl + WS_WOUT) + (size_t)l * D * D, T, D, D}; pg8::StaticOrder S; if (F.G == 256) S.init_tile(D, TILE_PM, TILE_PAR); else S.init(T, D, F.G, F.wg);
            epi::OutRes E{H, RF};
            pg8::gemm_phase<epi::OutRes, pg8::StaticOrder, true, true>(F.lds + LDS_A, g, S, E, WAVE_FRESH());
        }
        PAIR_BAR(pb + 3);
        if (((PHASE_MASK >> 5) & 1) && IN(pb + 4)) for (int rep_ = 0; rep_ < REP(5); ++rep_) { PHASE_ARGS();
            ln_rows_bf(RF, ap->ln1_g + (size_t)l * D, ap->ln1_b + (size_t)l * D, H1, nullptr, TROW_BASE, TROW_STRIDE, TROW_END, lane_id_fresh());
        }
        PAIR_BAR(pb + 4);
        if (((PHASE_MASK >> 6) & 1) && IN(pb + 5)) for (int rep_ = 0; rep_ < REP(6); ++rep_) { PHASE_ARGS();
            pg8::Gemm g{H1, (const bf16_t*)(wsl + WS_WPQ) + (size_t)l * 2048 * D, T, 2048, D}; pg8::StaticOrder S; if (F.G == 256) S.init_tile(2048, TILE_PM, TILE_PAR); else S.init(T, 2048, F.G, F.wg);
            epi::PlainBf16 E{PQ, 512, 1, 1, (unsigned)PQ_PLANE};
            pg8::gemm_phase<epi::PlainBf16, pg8::StaticOrder, true, true>(F.lds + LDS_A, g, S, E, WAVE_FRESH());
        }
        PAIR_BAR(pb + 5);
        if (((PHASE_MASK >> 7) & 1) && IN(pb + 6)) for (int rep_ = 0; rep_ < REP(7); ++rep_) { PHASE_ARGS(); peer_topk_phase(F, PQ, (const bf16_t*)(wsl + WS_SUBK) + (size_t)l * 8 * 2 * 128 * 128, EG); }
        PAIR_BAR(pb + 6);
        if (((PHASE_MASK >> 8) & 1) && IN(pb + 7)) for (int rep_ = 0; rep_ < REP(8); ++rep_) { PHASE_ARGS(); peer_gather_phase(F, H1, EG, ws + WS_U8 + (size_t)l * 16384 * 512, ws + WS_V8 + (size_t)l * 16384 * 512, (const float*)(wsl + WS_USC) + (size_t)l * 16384, (const float*)(wsl + WS_VSC) + (size_t)l * 16384, R2); }
        PAIR_BAR(pb + 7);
        if (((PHASE_MASK >> 9) & 1) && IN(pb + 8)) for (int rep_ = 0; rep_ < REP(9); ++rep_) { PHASE_ARGS();
            { pg8::Gemm g{(const bf16_t*)(wsl + WS_P16) + (size_t)l * T * 256, (const bf16_t*)(wsl + WS_WP) + (size_t)l * D * 256, T, D, 256}; pg8::StaticOrder S; if (F.G == 256) S.init_tile(D, TILE_PM, TILE_PAR); else S.init(T, D, F.G, F.wg);
              epi::PlainBf16 E{PP, D, 8, 255, 0u};
              pg8::gemm_phase<epi::PlainBf16, pg8::StaticOrder, true, true>(F.lds + LDS_A, g, S, E, WAVE_FRESH()); }
            VM_WAIT(); __syncthreads();
            { pg8::Gemm g{R2, (const bf16_t*)(wsl + WS_WG) + (size_t)l * D * D, T, D, D}; pg8::StaticOrder S; if (F.G == 256) S.init_tile(D, TILE_PM, TILE_PAR); else S.init(T, D, F.G, F.wg);
              epi::Gate E{R2, PP, ap->ple_bg + (size_t)l * D, RF};
              pg8::gemm_phase<epi::Gate, pg8::StaticOrder, true, true>(F.lds + LDS_A, g, S, E, WAVE_FRESH()); }
        }
        PAIR_BAR(pb + 8);
        if (((PHASE_MASK >> 10) & 1) && IN(pb + 9)) for (int rep_ = 0; rep_ < REP(10); ++rep_) { PHASE_ARGS();
            const bool last = (l == DEPTH - 1);
            ln_rows_bf(RF, ap->ln2_g + (size_t)l * D, ap->ln2_b + (size_t)l * D, last ? nullptr : H, last ? ap->out : nullptr, TROW_BASE, TROW_STRIDE, TROW_END, lane_id_fresh());
        }
        if (l + 1 < DEPTH) GRP_BAR(pb + 9);
    }
#undef IN
#undef BOTH
#undef H
#undef H1
#undef MIX
#undef R2
#undef RF
#undef DQ
#undef DK
#undef DVT
#undef SQ
#undef SK
#undef SVT
#undef IQ
#undef IK
#undef IW
#undef PQ
#undef EG
#undef MASK
#undef PP
}

extern "C" void kernel_launch(void* const* d_in, const int* in_sizes, int n_in, void* d_out, int out_size, void* d_ws, size_t ws_size, hipStream_t stream) {
    static int grid = 0;
    if (grid == 0) {
        if (n_in != 19 || in_sizes[0] != T * D || out_size != T * D || ws_size < WS_END) {
            fprintf(stderr, "kernel_launch: unexpected problem: n_in %d in0 %d out %d ws %zu (need %zu); nothing launched\n", n_in, n_in > 0 ? in_sizes[0] : -1, out_size, ws_size, (size_t)WS_END); grid = -1; return; }
        int dev = 0, cus = 0, per_cu = 0;
        if (hipGetDevice(&dev) != hipSuccess || hipDeviceGetAttribute(&cus, hipDeviceAttributeMultiprocessorCount, dev) != hipSuccess) { fprintf(stderr, "kernel_launch: device query failed\n"); grid = -1; return; }
        if (hipFuncSetAttribute((const void*)fwd_kernel, hipFuncAttributeMaxDynamicSharedMemorySize, LDS_BYTES) != hipSuccess) { fprintf(stderr, "kernel_launch: hipFuncSetAttribute failed\n"); grid = -1; return; }
        if (hipOccupancyMaxActiveBlocksPerMultiprocessor(&per_cu, (const void*)fwd_kernel, NTHREADS, LDS_BYTES) != hipSuccess || per_cu < 1) { fprintf(stderr, "kernel_launch: occupancy query says %d blocks per CU\n", per_cu); }
        (void)hipGetLastError();
        grid = cus < 256 ? cus : 256;
    }
    if (grid < 0) return;
    if (hipMemsetAsync((char*)d_ws + WS_CTL, 0, CTL_ZERO_BYTES, stream) != hipSuccess) { fprintf(stderr, "kernel_launch: memset failed\n"); return; }
    Args a{};
    a.x = (const float*)d_in[0]; a.p = (const float*)d_in[1]; a.ln_in_g = (const float*)d_in[2]; a.ln_in_b = (const float*)d_in[3]; a.w_in = (const float*)d_in[4]; a.w_out = (const float*)d_in[5];
    a.diff_lambda = (const float*)d_in[6]; a.diff_subln_g = (const float*)d_in[7]; a.ln1_g = (const float*)d_in[8]; a.ln1_b = (const float*)d_in[9]; a.peer_wq = (const float*)d_in[10];
    a.peer_subkeys = (const float*)d_in[11]; a.peer_u = (const float*)d_in[12]; a.peer_v = (const float*)d_in[13]; a.ple_wg = (const float*)d_in[14]; a.ple_bg = (const float*)d_in[15];
    a.ple_wp = (const float*)d_in[16]; a.ln2_g = (const float*)d_in[17]; a.ln2_b = (const float*)d_in[18];
    a.out = (float*)d_out; a.ws = (unsigned char*)d_ws;
#if MK_PER_PHASE
    for (int ph = 0; ph < N_PHASES; ++ph) { a.ph_lo = ph; a.ph_hi = ph + 1; hipLaunchKernelGGL(fwd_kernel, dim3(grid), dim3(NTHREADS), LDS_BYTES, stream, a); }
#else
    a.ph_lo = 0; a.ph_hi = N_PHASES;
    hipLaunchKernelGGL(fwd_kernel, dim3(grid), dim3(NTHREADS), LDS_BYTES, stream, a);
#endif
    const hipError_t le = hipPeekAtLastError();
    if (le != hipSuccess) fprintf(stderr, "kernel_launch: launch failed: %s\n", hipGetErrorName(le));
}
```

```cpp
#include <hip/hip_runtime.h>
#include <cstdio>
#include <cstdint>
#include <cmath>

#ifndef MK_PER_PHASE
#define MK_PER_PHASE 0
#endif

#define LAS __attribute__((address_space(3)))
typedef unsigned short bf16_t;
typedef short bf16x8 __attribute__((ext_vector_type(8)));
typedef float f32x4 __attribute__((ext_vector_type(4)));
typedef float f32x2 __attribute__((ext_vector_type(2)));
typedef unsigned u32x4 __attribute__((ext_vector_type(4)));
typedef unsigned u32x2 __attribute__((ext_vector_type(2)));
typedef unsigned long long u64;

constexpr int D = 1024, BATCH = 8, SEQ = 4096, DEPTH = 4, T = BATCH * SEQ;
constexpr int IN_COLS = 3396;
constexpr int NMAIN = 2560;
constexpr int NVV = 1024;
constexpr int NWAVES = 8, NTHREADS = 512;
constexpr float LN_EPS = 1e-5f;
constexpr float ALPHA = 1.6817928305074290f;
constexpr float LOG2E = 1.4426950408889634f;

constexpr size_t MiB = 1u << 20;
constexpr size_t WS_CTL = 0, CTL_ZERO_BYTES = 1 * MiB;
constexpr size_t WS_WIN = 1 * MiB;
constexpr size_t WS_WINV = 21 * MiB;
constexpr size_t WS_WOUT = 29 * MiB;
constexpr size_t WS_WPQ = 37 * MiB;
constexpr size_t WS_WG = 53 * MiB;
constexpr size_t WS_WP = 61 * MiB;
constexpr size_t WS_SUBK = 63 * MiB;
constexpr size_t WS_U8 = 65 * MiB;
constexpr size_t WS_V8 = 129 * MiB;
constexpr size_t WS_USC = 193 * MiB;
constexpr size_t WS_VSC = 194 * MiB;
constexpr size_t WS_KN = 195 * MiB;
constexpr size_t WS_P16 = 321 * MiB;
constexpr size_t WS_H = 385 * MiB;
constexpr size_t WS_H1 = 449 * MiB;
constexpr size_t WS_MIX = 513 * MiB;
constexpr size_t WS_R2 = 577 * MiB;
constexpr size_t WS_RF = 641 * MiB;
constexpr size_t WS_PROJ = 769 * MiB;
constexpr size_t WS_DQ = WS_PROJ + 0 * MiB, WS_DK = WS_PROJ + 32 * MiB, WS_DVT = WS_PROJ + 64 * MiB, WS_SQ = WS_PROJ + 96 * MiB, WS_SK = WS_PROJ + 128 * MiB,
                 WS_SVT = WS_PROJ + 160 * MiB, WS_IQ = WS_PROJ + 192 * MiB, WS_IK = WS_PROJ + 208 * MiB, WS_IW = WS_PROJ + 212 * MiB;
constexpr size_t WS_PQ = WS_PROJ;
constexpr size_t PQ_PLANE = 32 * MiB / 2;
constexpr size_t WS_EG = WS_PROJ + 128 * MiB;
constexpr size_t WS_MASK = 993 * MiB;
constexpr size_t WS_END = 1009 * MiB;

constexpr int LDS_A = 0;
constexpr int LDS_B = 131072;
constexpr int LDS_CTL = 153600;
constexpr int LDS_BYTES = 155648;

__device__ __forceinline__ unsigned cvt_pk_bf16(float lo, float hi) { unsigned r; asm volatile("v_cvt_pk_bf16_f32 %0, %1, %2" : "=v"(r) : "v"(lo), "v"(hi)); return r; }
__device__ __forceinline__ float bf_lo(unsigned w) { return __uint_as_float(w << 16); }
__device__ __forceinline__ float bf_hi(unsigned w) { return __uint_as_float(w & 0xffff0000u); }
template <int CTRL, int RM, int BM> __device__ __forceinline__ float dpp_f(float old, float v) { return __int_as_float(__builtin_amdgcn_update_dpp(__float_as_int(old), __float_as_int(v), CTRL, RM, BM, false)); }
template <int CTRL, int RM, int BM> __device__ __forceinline__ unsigned dpp_u(unsigned old, unsigned v) { return (unsigned)__builtin_amdgcn_update_dpp((int)old, (int)v, CTRL, RM, BM, false); }
__device__ __forceinline__ float lane_f(float v, int l) { return __int_as_float(__builtin_amdgcn_readlane(__float_as_int(v), l)); }
__device__ __forceinline__ float wave_sum(float v) {
    v += dpp_f<0xB1, 0xf, 0xf>(v, v); v += dpp_f<0x4E, 0xf, 0xf>(v, v); v += dpp_f<0x141, 0xf, 0xf>(v, v); v += dpp_f<0x140, 0xf, 0xf>(v, v);
    return (lane_f(v, 0) + lane_f(v, 16)) + (lane_f(v, 32) + lane_f(v, 48));
}
__device__ __forceinline__ float wave_max(float v) {
    v = fmaxf(v, dpp_f<0xB1, 0xf, 0xf>(v, v)); v = fmaxf(v, dpp_f<0x4E, 0xf, 0xf>(v, v)); v = fmaxf(v, dpp_f<0x141, 0xf, 0xf>(v, v)); v = fmaxf(v, dpp_f<0x140, 0xf, 0xf>(v, v));
    return fmaxf(fmaxf(lane_f(v, 0), lane_f(v, 16)), fmaxf(lane_f(v, 32), lane_f(v, 48)));
}
__device__ __forceinline__ unsigned wave_prefix_sum(unsigned x) {
    unsigned p = x;
    p += dpp_u<0x111, 0xf, 0xf>(0u, p); p += dpp_u<0x112, 0xf, 0xf>(0u, p); p += dpp_u<0x114, 0xf, 0xf>(0u, p); p += dpp_u<0x118, 0xf, 0xf>(0u, p);
    p += dpp_u<0x142, 0xa, 0xf>(0u, p); p += dpp_u<0x143, 0xc, 0xf>(0u, p);
    return p;
}
__device__ __forceinline__ int wave_sum_i(int v) {
    v += __builtin_amdgcn_update_dpp(v, v, 0xB1, 0xf, 0xf, false); v += __builtin_amdgcn_update_dpp(v, v, 0x4E, 0xf, 0xf, false);
    v += __builtin_amdgcn_update_dpp(v, v, 0x141, 0xf, 0xf, false); v += __builtin_amdgcn_update_dpp(v, v, 0x140, 0xf, 0xf, false);
    return (__builtin_amdgcn_readlane(v, 0) + __builtin_amdgcn_readlane(v, 16)) + (__builtin_amdgcn_readlane(v, 32) + __builtin_amdgcn_readlane(v, 48));
}
__device__ __forceinline__ float xhalf_max(float v) { auto r_ = __builtin_amdgcn_permlane32_swap(__float_as_uint(v), __float_as_uint(v), false, false); return fmaxf(__uint_as_float(r_[0]), __uint_as_float(r_[1])); }
__device__ __forceinline__ unsigned f2sort(float f) { const unsigned u = __float_as_uint(f); return (u & 0x80000000u) ? ~u : (u | 0x80000000u); }
__device__ __forceinline__ float sort2f(unsigned s) { const unsigned u = (s & 0x80000000u) ? (s & 0x7fffffffu) : ~s; return __uint_as_float(u); }
__device__ __forceinline__ int lane_id_fresh() { int l; asm volatile("v_mbcnt_lo_u32_b32 %0, -1, 0\n\tv_mbcnt_hi_u32_b32 %0, -1, %0" : "=v"(l)); return l; }
#define WAVE_FRESH() ({ int w_ = F.wave; asm volatile("" : "+s"(w_)); w_; })
#define LDS_WAIT() asm volatile("s_waitcnt lgkmcnt(0)" ::: "memory")
#define VM_WAIT() asm volatile("s_waitcnt vmcnt(0)" ::: "memory")
namespace pg8 {
#define PG8_LAS __attribute__((address_space(3)))
constexpr int BM = 256, BK = 64, HALF = 128, HTB = HALF * BK * 2  , STAGE_BYTES = 8 * HTB, NXCD = 8, WGM = 8;

__host__ __device__ __forceinline__ int lds_byte(int r, int c) { const int st = (r >> 4) * 2 + (c >> 5), rr = r & 15, cc = c & 31, ob = rr * 64 + cc * 2; return st * 1024 + (ob ^ (((ob >> 9) & 1) << 5)); }
__host__ __device__ __forceinline__ void stage_rc(int b, int& R, int& C) { const int st = b / 1024, sb = b % 1024, swz = sb ^ (((sb >> 9) & 1) << 5); R = (st >> 1) * 16 + swz / 64; C = (st & 1) * 32 + (swz % 64) / 2; }
__host__ __device__ __forceinline__ int perm32(int rho) { const int n = rho >> 4, i = rho & 15; return 8 * (i >> 2) + 4 * n + (i & 3); }

struct Unit { int pm, pn; };
struct Gemm { const bf16_t* A; const bf16_t* Bt; int M, N, K; };

struct StaticOrder {
    int nM, nN, nwg, G, c, tile;
    __host__ __device__ void init(int M, int N, int G_, int c_) { nM = M / BM; nN = N / BM; nwg = nM * nN; G = G_; c = c_; tile = -1; }
    __host__ __device__ void init_tile(int N, int tile_, int par) { nM = 0; nN = N / BM; nwg = 0; G = 0; c = par; tile = tile_; }
    __host__ __device__ bool next(int i, Unit& u) const {
        if (tile >= 0) { const int pn = c + 2 * i; if (pn >= nN) return false; u.pm = tile; u.pn = pn; return true; }
        const long L = (long)i * G + c; if (L >= nwg) return false;
        int wgid = (int)L; { const int q = nwg / NXCD, r = nwg % NXCD, xcd = wgid % NXCD, off = wgid / NXCD; wgid = (xcd < r ? xcd * (q + 1) : r * (q + 1) + (xcd - r) * q) + off; }
        const int nig = WGM * nN, gid = wgid / nig, fm = gid * WGM, gsz = (nM - fm) < WGM ? (nM - fm) : WGM;
        u.pm = fm + ((wgid % nig) % gsz); u.pn = (wgid % nig) / gsz; return true;
    }
    __device__ __forceinline__ void a_ready(const Unit&) const {}
    __device__ __forceinline__ void done(const Unit&) const {}
};

template <class Epi, class Sched, bool ALIGN_EPI = false, bool SP2 = false>
__device__ __forceinline__ void gemm_phase(PG8_LAS unsigned char* lds, const Gemm g, const Sched& S, const Epi& E, int wave_id) {
    const int lane = lane_id_fresh(), wid = wave_id, tid = wid * 64 + lane,
              wr = wid >> 2, wc = wid & 3, fr = lane & 15, fq = lane >> 4;
    const int K = g.K, nt = K / BK;
    unsigned voffA[2], voffB[2];
#pragma unroll
    for (int i = 0; i < 2; ++i) { int R, C; stage_rc(tid * 16 + i * 8192, R, C); const int Rb = Epi::PERM ? ((R & ~31) + perm32(R & 31)) : R;
        voffA[i] = (unsigned)(R * K + C) * 2u; voffB[i] = (unsigned)(Rb * K + C) * 2u; }
    const size_t kstep = (size_t)(BK * 2);
    const size_t hstep = (size_t)HALF * K * 2;
    const size_t tstep = 2 * hstep;
    const unsigned ldsw = (unsigned)wid * 1024u;
    const int aoff = lds_byte(wr * 64 + fr, fq * 8), boff = lds_byte(wc * 32 + fr, fq * 8);
#define PG8_SA(b, h) (((b) * 2 + (h)) * HTB)
#define PG8_SB(b, h) ((4 + (b) * 2 + (h)) * HTB)
#define PG8_STAGE(bufoff, gbase, voff) do { _Pragma("unroll") for (int _i = 0; _i < 2; ++_i) \
        __builtin_amdgcn_global_load_lds((const unsigned*)((const char*)(gbase) + (voff)[_i]), (PG8_LAS unsigned*)(lds + (bufoff) + ldsw + _i * 8192), 16, 0, 0); } while (0)
#define PG8_LDA(dst, b, h) do { _Pragma("unroll") for (int m = 0; m < 4; ++m) _Pragma("unroll") for (int k = 0; k < 2; ++k) dst[m][k] = *(const PG8_LAS bf16x8*)(lds + PG8_SA(b, h) + aoff + m * 2048 + k * 1024); } while (0)
#define PG8_LDB(dst, b, h) do { _Pragma("unroll") for (int n = 0; n < 2; ++n) _Pragma("unroll") for (int k = 0; k < 2; ++k) dst[n][k] = *(const PG8_LAS bf16x8*)(lds + PG8_SB(b, h) + boff + n * 2048 + k * 1024); } while (0)
#define PG8_MMA(ai, bj, At, Bt) do { __builtin_amdgcn_s_setprio(1); _Pragma("unroll") for (int m = 0; m < 4; ++m) _Pragma("unroll") for (int n = 0; n < 2; ++n) _Pragma("unroll") for (int k = 0; k < 2; ++k) \
        acc[ai][bj][m][n] = Epi::SWAP ? __builtin_amdgcn_mfma_f32_16x16x32_bf16(At[m][k], Bt[n][k], acc[ai][bj][m][n], 0, 0, 0) : __builtin_amdgcn_mfma_f32_16x16x32_bf16(Bt[n][k], At[m][k], acc[ai][bj][m][n], 0, 0, 0); __builtin_amdgcn_s_setprio(0); } while (0)
#define PG8_WAIT_V(n) asm volatile("s_waitcnt vmcnt(" #n ")" ::: "memory")
#define PG8_WAIT_L(n) asm volatile("s_waitcnt lgkmcnt(" #n ")" ::: "memory")
#define PG8_BAR __builtin_amdgcn_s_barrier()
#define PG8_SCHED __builtin_amdgcn_sched_barrier(0)
    Unit cur, nxt; int ui = 0;
    if (!S.next(0, cur)) return;
    f32x4 acc[2][2][4][2];
#pragma unroll
    for (int a = 0; a < 2; ++a)
#pragma unroll
        for (int b = 0; b < 2; ++b)
#pragma unroll
            for (int m = 0; m < 4; ++m)
#pragma unroll
                for (int n = 0; n < 2; ++n) acc[a][b][m][n] = (f32x4){0.f, 0.f, 0.f, 0.f};
    bf16x8 At[4][2], B0[2][2], B1[2][2];
    const char* cA = (const char*)g.A + (size_t)cur.pm * tstep; const char* cB = (const char*)g.Bt + (size_t)cur.pn * tstep;
    S.a_ready(cur);
    if constexpr (SP2) {
        PG8_STAGE(PG8_SB(0, 0), cB, voffB); PG8_STAGE(PG8_SB(0, 1), cB + hstep, voffB); PG8_STAGE(PG8_SA(0, 0), cA, voffA); PG8_STAGE(PG8_SA(0, 1), cA + hstep, voffA);
        if (wr == 1) PG8_BAR;
        PG8_WAIT_V(2); PG8_BAR;
        PG8_STAGE(PG8_SB(1, 0), cB + kstep, voffB); PG8_STAGE(PG8_SA(1, 0), cA + kstep, voffA); PG8_STAGE(PG8_SB(1, 1), cB + hstep + kstep, voffB);
        PG8_WAIT_V(6); PG8_BAR;
    } else {
        PG8_STAGE(PG8_SB(0, 0), cB, voffB); PG8_STAGE(PG8_SA(0, 0), cA, voffA); PG8_STAGE(PG8_SB(0, 1), cB + hstep, voffB); PG8_STAGE(PG8_SA(0, 1), cA + hstep, voffA);
        if (wr == 1) PG8_BAR;
        PG8_WAIT_V(4); PG8_BAR;
        PG8_STAGE(PG8_SB(1, 0), cB + kstep, voffB); PG8_STAGE(PG8_SA(1, 0), cA + kstep, voffA); PG8_STAGE(PG8_SB(1, 1), cB + hstep + kstep, voffB);
        PG8_WAIT_V(6); PG8_BAR;
    }
    for (;;) {
        const bool has_next = S.next(ui + 1, nxt);
        const char* nA = has_next ? (const char*)g.A + (size_t)nxt.pm * tstep : cA; const char* nB = has_next ? (const char*)g.Bt + (size_t)nxt.pn * tstep : cB;
        for (int t = 0; t < nt; t += 2) {
            const bool last = (t == nt - 2);
            const char* a1 = cA + (size_t)(t + 1) * kstep;
            const char* a2 = last ? nA : cA + (size_t)(t + 2) * kstep; const char* b2 = last ? nB : cB + (size_t)(t + 2) * kstep;
            const char* a3 = a2 + kstep; const char* b3 = b2 + kstep;
            if (last && has_next) S.a_ready(nxt);
            if constexpr (SP2) {
            PG8_LDB(B0, 0, 0); PG8_LDB(B1, 0, 1); PG8_SCHED; PG8_LDA(At, 0, 0); PG8_STAGE(PG8_SA(1, 1), a1 + hstep, voffA);
            PG8_WAIT_V(8); PG8_WAIT_L(0); PG8_BAR; PG8_MMA(0, 0, At, B0); PG8_MMA(0, 1, At, B1); PG8_BAR; PG8_SCHED;
            PG8_LDA(At, 0, 1); PG8_STAGE(PG8_SB(0, 0), b2, voffB); PG8_STAGE(PG8_SB(0, 1), b2 + hstep, voffB); PG8_STAGE(PG8_SA(0, 0), a2, voffA);
            PG8_WAIT_V(8); PG8_WAIT_L(0); PG8_BAR; PG8_MMA(1, 0, At, B0); PG8_MMA(1, 1, At, B1); PG8_BAR; PG8_SCHED;
            PG8_LDB(B0, 1, 0); PG8_LDB(B1, 1, 1); PG8_SCHED; PG8_LDA(At, 1, 0); PG8_STAGE(PG8_SA(0, 1), a2 + hstep, voffA);
            PG8_WAIT_V(8); PG8_WAIT_L(0); PG8_BAR; PG8_MMA(0, 0, At, B0); PG8_MMA(0, 1, At, B1); PG8_BAR; PG8_SCHED;
            PG8_LDA(At, 1, 1); PG8_STAGE(PG8_SB(1, 0), b3, voffB); PG8_STAGE(PG8_SB(1, 1), b3 + hstep, voffB); PG8_STAGE(PG8_SA(1, 0), a3, voffA);
            PG8_WAIT_V(8); PG8_WAIT_L(0); PG8_BAR; PG8_MMA(1, 0, At, B0); PG8_MMA(1, 1, At, B1); PG8_BAR; PG8_SCHED;
            } else {
            PG8_LDB(B0, 0, 0); PG8_SCHED; PG8_LDA(At, 0, 0); PG8_STAGE(PG8_SA(1, 1), a1 + hstep, voffA);
            PG8_WAIT_L(8); PG8_BAR; PG8_WAIT_L(0); PG8_MMA(0, 0, At, B0); PG8_BAR; PG8_SCHED;
            PG8_LDB(B1, 0, 1); PG8_STAGE(PG8_SB(0, 0), b2, voffB);
            PG8_BAR; PG8_WAIT_L(0); PG8_MMA(0, 1, At, B1); PG8_BAR;
            PG8_LDA(At, 0, 1); PG8_STAGE(PG8_SA(0, 0), a2, voffA);
            PG8_BAR; PG8_WAIT_L(0); PG8_MMA(1, 0, At, B0); PG8_BAR; PG8_SCHED;
            PG8_STAGE(PG8_SB(0, 1), b2 + hstep, voffB);
            PG8_WAIT_V(6); PG8_BAR; PG8_MMA(1, 1, At, B1); PG8_BAR;
            PG8_LDB(B0, 1, 0); PG8_SCHED; PG8_LDA(At, 1, 0); PG8_STAGE(PG8_SA(0, 1), a2 + hstep, voffA);
            PG8_WAIT_L(8); PG8_BAR; PG8_WAIT_L(0); PG8_MMA(0, 0, At, B0); PG8_BAR; PG8_SCHED;
            PG8_LDB(B1, 1, 1); PG8_STAGE(PG8_SB(1, 0), b3, voffB);
            PG8_BAR; PG8_WAIT_L(0); PG8_MMA(0, 1, At, B1); PG8_BAR;
            PG8_LDA(At, 1, 1); PG8_STAGE(PG8_SA(1, 0), a3, voffA);
            PG8_BAR; PG8_WAIT_L(0); PG8_MMA(1, 0, At, B0); PG8_BAR; PG8_SCHED;
            PG8_STAGE(PG8_SB(1, 1), b3 + hstep, voffB);
            PG8_WAIT_V(6); PG8_BAR; PG8_MMA(1, 1, At, B1); PG8_BAR;
            }
        }
        if constexpr (ALIGN_EPI) { if (wr == 0) PG8_BAR; }
        if constexpr (!Epi::AFTER_DRAIN) { E(acc, cur, wr, wc, fr, fq); S.done(cur); }
        if (!has_next) break;
#pragma unroll
        for (int a = 0; a < 2; ++a)
#pragma unroll
            for (int b = 0; b < 2; ++b)
#pragma unroll
                for (int m = 0; m < 4; ++m)
#pragma unroll
                    for (int n = 0; n < 2; ++n) acc[a][b][m][n] = (f32x4){0.f, 0.f, 0.f, 0.f};
        cur = nxt; cA = nA; cB = nB; ++ui;
        if constexpr (ALIGN_EPI) { if (wr == 1) PG8_BAR; }
    }
    PG8_WAIT_V(0);
    if constexpr (!ALIGN_EPI) { if (wr == 0) PG8_BAR; }
    PG8_BAR;
    if constexpr (Epi::AFTER_DRAIN) { E.fused(acc, cur, wr, wc, fr, fq, lds, wid, lane); S.done(cur); }
#undef PG8_SA
#undef PG8_SB
#undef PG8_STAGE
#undef PG8_LDA
#undef PG8_LDB
#undef PG8_MMA
#undef PG8_WAIT_V
#undef PG8_WAIT_L
#undef PG8_BAR
#undef PG8_SCHED
}
}
namespace epi {
using pg8::Unit;
struct Proj {
    static constexpr bool PERM = true, AFTER_DRAIN = false, SWAP = false;
    bf16_t *DQ, *DK, *SQ, *SK, *IQ, *IK; float* IW;
    __device__ __forceinline__ void operator()(const f32x4 (&acc)[2][2][4][2], const Unit& u, int wr, int wc, int fr, int fq) const {
        const int row0 = u.pm * 256 + wr * 64 + fr;
#pragma unroll
        for (int bj = 0; bj < 2; ++bj) {
            const int cbase = u.pn * 256 + bj * 128 + wc * 32;
            if (cbase >= 2400) continue;
            const int c8 = cbase + 8 * fq;
            if (cbase >= 2368) {
                if (fq == 0) {
#pragma unroll
                    for (int ai = 0; ai < 2; ++ai)
#pragma unroll
                        for (int m = 0; m < 4; ++m) { const int row = row0 + ai * 128 + m * 16; *(f32x4*)(IW + (size_t)row * 4) = acc[ai][bj][m][0] * 0.5f; }
                }
                continue;
            }
            bf16_t* dst; int nh, hh; float sc = 1.0f;
            if (cbase < 512) { dst = DQ; nh = 8; hh = cbase >> 6; sc = 0.125f * LOG2E; }
            else if (cbase < 1024) { dst = DK; nh = 8; hh = (cbase - 512) >> 6; }
            else if (cbase < 1536) { dst = SQ; nh = 8; hh = (cbase - 1024) >> 6; sc = 0.125f * LOG2E; }
            else if (cbase < 2048) { dst = SK; nh = 8; hh = (cbase - 1536) >> 6; }
            else if (cbase < 2304) { dst = IQ; nh = 4; hh = (cbase - 2048) >> 6; sc = 0.125f; }
            else { dst = IK; nh = 1; hh = 0; }
            const int d = c8 & 63;
#pragma unroll
            for (int ai = 0; ai < 2; ++ai)
#pragma unroll
                for (int m = 0; m < 4; ++m) {
                    const int row = row0 + ai * 128 + m * 16, b = row >> 12, s = row & 4095;
                    const f32x4 v0 = acc[ai][bj][m][0] * sc, v1 = acc[ai][bj][m][1] * sc;
                    u32x4 w; w.x = cvt_pk_bf16(v0[0], v0[1]); w.y = cvt_pk_bf16(v0[2], v0[3]); w.z = cvt_pk_bf16(v1[0], v1[1]); w.w = cvt_pk_bf16(v1[2], v1[3]);
                    *(u32x4*)(dst + ((size_t)((b * nh + hh) * 4096 + s)) * 64 + d) = w;
                }
        }
    }
};
struct ProjV {
    static constexpr bool PERM = false, AFTER_DRAIN = false, SWAP = true;
    bf16_t *DVT, *SVT;
    __device__ __forceinline__ void operator()(const f32x4 (&acc)[2][2][4][2], const Unit& u, int wr, int wc, int fr, int fq) const {
#pragma unroll
        for (int ai = 0; ai < 2; ++ai)
#pragma unroll
            for (int m = 0; m < 4; ++m) {
                const int tok0 = u.pm * 256 + ai * 128 + wr * 64 + m * 16 + 4 * fq, b = tok0 >> 12, s0 = tok0 & 4095;
                const int pos = (s0 & ~63) + 16 * m + 8 * (fq & 1) + 4 * (fq >> 1);
#pragma unroll
                for (int bj = 0; bj < 2; ++bj)
#pragma unroll
                    for (int n = 0; n < 2; ++n) {
                        const int col = u.pn * 256 + bj * 128 + wc * 32 + n * 16 + fr;
                        bf16_t* dst;
                        if (col < 512) dst = DVT + ((size_t)((b * 4 + (col >> 7)) * 128 + (col & 127))) * 4096 + pos;
                        else { const int c2 = col - 512; dst = SVT + ((size_t)((b * 8 + (c2 >> 6)) * 64 + (c2 & 63))) * 4096 + pos; }
                        const f32x4 v = acc[ai][bj][m][n];
                        u32x2 w; w.x = cvt_pk_bf16(v[0], v[1]); w.y = cvt_pk_bf16(v[2], v[3]);
                        *(u32x2*)dst = w;
                    }
            }
    }
};
struct PlainBf16 {
    static constexpr bool PERM = true, AFTER_DRAIN = false, SWAP = false;
    bf16_t* O; int ldc; int psh, pmask; unsigned pstride;
    __device__ __forceinline__ void operator()(const f32x4 (&acc)[2][2][4][2], const Unit& u, int wr, int wc, int fr, int fq) const {
        const int row0 = u.pm * 256 + wr * 64 + fr, col0 = (u.pn & pmask) * 256 + wc * 32 + 8 * fq;
        bf16_t* Op = O + (size_t)((unsigned)(u.pn >> psh) * pstride);
#pragma unroll
        for (int ai = 0; ai < 2; ++ai)
#pragma unroll
            for (int m = 0; m < 4; ++m) { bf16_t* rowp = Op + (size_t)(row0 + ai * 128 + m * 16) * ldc + col0;
#pragma unroll
                for (int bj = 0; bj < 2; ++bj) { const f32x4 v0 = acc[ai][bj][m][0], v1 = acc[ai][bj][m][1];
                    u32x4 w; w.x = cvt_pk_bf16(v0[0], v0[1]); w.y = cvt_pk_bf16(v0[2], v0[3]); w.z = cvt_pk_bf16(v1[0], v1[1]); w.w = cvt_pk_bf16(v1[2], v1[3]);
                    *(u32x4*)(rowp + bj * 128) = w; } }
    }
};
struct OutRes {
    static constexpr bool PERM = true, AFTER_DRAIN = false, SWAP = false;
    const bf16_t* H; bf16_t* RF;
    __device__ __forceinline__ void operator()(const f32x4 (&acc)[2][2][4][2], const Unit& u, int wr, int wc, int fr, int fq) const {
        const int row0 = u.pm * 256 + wr * 64 + fr, col0 = u.pn * 256 + wc * 32 + 8 * fq;
#pragma unroll
        for (int ai = 0; ai < 2; ++ai)
#pragma unroll
            for (int m = 0; m < 4; ++m) { const size_t off = (size_t)(row0 + ai * 128 + m * 16) * D + col0;
#pragma unroll
                for (int bj = 0; bj < 2; ++bj) { const u32x4 h = *(const u32x4*)(H + off + bj * 128);
                    f32x4 o0, o1;
                    o0[0] = ALPHA * bf_lo(h.x) + acc[ai][bj][m][0][0]; o0[1] = ALPHA * bf_hi(h.x) + acc[ai][bj][m][0][1]; o0[2] = ALPHA * bf_lo(h.y) + acc[ai][bj][m][0][2]; o0[3] = ALPHA * bf_hi(h.y) + acc[ai][bj][m][0][3];
                    o1[0] = ALPHA * bf_lo(h.z) + acc[ai][bj][m][1][0]; o1[1] = ALPHA * bf_hi(h.z) + acc[ai][bj][m][1][1]; o1[2] = ALPHA * bf_lo(h.w) + acc[ai][bj][m][1][2]; o1[3] = ALPHA * bf_hi(h.w) + acc[ai][bj][m][1][3];
                    u32x4 w; w.x = cvt_pk_bf16(o0[0], o0[1]); w.y = cvt_pk_bf16(o0[2], o0[3]); w.z = cvt_pk_bf16(o1[0], o1[1]); w.w = cvt_pk_bf16(o1[2], o1[3]);
                    *(u32x4*)(RF + off + bj * 128) = w; }
                asm volatile("" ::: "memory"); }
    }
};
struct Gate {
    static constexpr bool PERM = true, AFTER_DRAIN = false, SWAP = false;
    const bf16_t* R2; const bf16_t* PP; const float* bg; bf16_t* RF;
    __device__ __forceinline__ float sg(float x) const { return __builtin_amdgcn_rcpf(1.0f + __builtin_amdgcn_exp2f(-LOG2E * x)); }
    __device__ __forceinline__ void operator()(const f32x4 (&acc)[2][2][4][2], const Unit& u, int wr, int wc, int fr, int fq) const {
        const int row0 = u.pm * 256 + wr * 64 + fr, col0 = u.pn * 256 + wc * 32 + 8 * fq;
        f32x4 bv[2][2];
#pragma unroll
        for (int bj = 0; bj < 2; ++bj) { bv[bj][0] = *(const f32x4*)(bg + col0 + bj * 128); bv[bj][1] = *(const f32x4*)(bg + col0 + bj * 128 + 4); }
#pragma unroll
        for (int ai = 0; ai < 2; ++ai)
#pragma unroll
            for (int m = 0; m < 4; ++m) { const size_t off = (size_t)(row0 + ai * 128 + m * 16) * D + col0;
#pragma unroll
                for (int bj = 0; bj < 2; ++bj) { const u32x4 r = *(const u32x4*)(R2 + off + bj * 128), p = *(const u32x4*)(PP + off + bj * 128);
                    const f32x4 a0 = acc[ai][bj][m][0] + bv[bj][0], a1 = acc[ai][bj][m][1] + bv[bj][1];
                    f32x4 o0, o1;
                    o0[0] = bf_lo(r.x) + sg(a0[0]) * bf_lo(p.x); o0[1] = bf_hi(r.x) + sg(a0[1]) * bf_hi(p.x); o0[2] = bf_lo(r.y) + sg(a0[2]) * bf_lo(p.y); o0[3] = bf_hi(r.y) + sg(a0[3]) * bf_hi(p.y);
                    o1[0] = bf_lo(r.z) + sg(a1[0]) * bf_lo(p.z); o1[1] = bf_hi(r.z) + sg(a1[1]) * bf_hi(p.z); o1[2] = bf_lo(r.w) + sg(a1[2]) * bf_lo(p.w); o1[3] = bf_hi(r.w) + sg(a1[3]) * bf_hi(p.w);
                    u32x4 w; w.x = cvt_pk_bf16(o0[0], o0[1]); w.y = cvt_pk_bf16(o0[2], o0[3]); w.z = cvt_pk_bf16(o1[0], o1[1]); w.w = cvt_pk_bf16(o1[2], o1[3]);
                    *(u32x4*)(RF + off + bj * 128) = w; }
                asm volatile("" ::: "memory"); }
    }
};
}
#define XB_TMO      128
#define XB_XCNT(j)  (256  + 64 * (j))
#define XB_XSUB(j)  (1280 + 64 * (j))
#define XB_XGEN(j)  (2304 + 64 * (j))
#define XB_TOP      3328
#define XB_TOPGEN   3392
#define XCD_BAR_WORDS 3456
#define XB_SPIN_CAP (1u << 22)

__device__ __forceinline__ unsigned xb_ld(unsigned* p)              { return __hip_atomic_load(p, __ATOMIC_RELAXED, __HIP_MEMORY_SCOPE_AGENT); }
__device__ __forceinline__ unsigned xb_add(unsigned* p, unsigned v) { return __hip_atomic_fetch_add(p, v, __ATOMIC_RELAXED, __HIP_MEMORY_SCOPE_AGENT); }
__device__ __forceinline__ unsigned xb_xcc_id() { return (unsigned)__builtin_amdgcn_s_getreg((3 << 11) | 20) & 0xFu; }
#define XB_SPIN(cond, bar) do { unsigned _sp = 0; while (cond) { __builtin_amdgcn_s_sleep(1); \
    if ((++_sp & 255u) == 0u) { if (xb_ld(&(bar)[XB_TMO])) break; if (_sp > XB_SPIN_CAP) { atomicAdd(&(bar)[XB_TMO], 1u); break; } } } } while (0)

struct XcdBarrier {
    unsigned* bar; unsigned x;
    volatile LAS unsigned* st;
};

__device__ __forceinline__ XcdBarrier xcd_barrier_post(unsigned* bar, volatile LAS unsigned* st) {
    XcdBarrier b; b.bar = bar; b.x = xb_xcc_id(); b.st = st;
    if (threadIdx.x == 0) (void)xb_add(&bar[XB_XCNT(b.x)], 1u);
    return b;
}
__device__ __forceinline__ void xcd_barrier_complete(unsigned* bar, unsigned x, unsigned& nloc, unsigned& nx) {
    const unsigned G = gridDim.x * gridDim.y * gridDim.z;
    unsigned sum, cnt, mine, sp = 0u;
    for (;;) {
        sum = 0u; cnt = 0u; mine = 0u;
#pragma unroll
        for (unsigned j = 0; j < 16; ++j) { const unsigned c = xb_ld(&bar[XB_XCNT(j)]); sum += c; cnt += (c > 0u) ? 1u : 0u; mine = (j == x) ? c : mine; }
        if (sum == G) break;
        __builtin_amdgcn_s_sleep(1);
        if ((++sp & 255u) == 0u) { if (xb_ld(&bar[XB_TMO])) break; if (sp > XB_SPIN_CAP) { atomicAdd(&bar[XB_TMO], 1u); break; } }
    }
    nloc = mine > 0u ? mine : 1u; nx = cnt > 0u ? cnt : 1u;
}

__device__ __forceinline__ void xcd_barrier(const XcdBarrier& b) {
    asm volatile("s_waitcnt vmcnt(0)" ::: "memory");
    __syncthreads();
    if (threadIdx.x == 0) {
        unsigned* bar = b.bar;
        __builtin_amdgcn_s_waitcnt(0);
        unsigned nloc = b.st[0], nx = b.st[1];
        if (nloc == 0u) { xcd_barrier_complete(bar, b.x, nloc, nx); b.st[0] = nloc; b.st[1] = nx; }
        const unsigned old = xb_add(&bar[XB_XSUB(b.x)], 1u);
        const unsigned gen = old / nloc;
        if (old + 1u == (gen + 1u) * nloc) {
            __builtin_amdgcn_fence(__ATOMIC_RELEASE, "agent");
            asm volatile("s_waitcnt vmcnt(0)" ::: "memory");
            const unsigned og = xb_add(&bar[XB_TOP], 1u);
            const unsigned tg = og / nx;
            if (og + 1u == (tg + 1u) * nx) xb_add(&bar[XB_TOPGEN], 1u);
            else XB_SPIN(xb_ld(&bar[XB_TOPGEN]) == tg, bar);
            __builtin_amdgcn_fence(__ATOMIC_ACQUIRE, "agent");
            xb_add(&bar[XB_XGEN(b.x)], 1u);
            asm volatile("s_waitcnt vmcnt(0)" ::: "memory");
        } else {
            XB_SPIN(xb_ld(&bar[XB_XGEN(b.x)]) == gen, bar);
            __builtin_amdgcn_fence(__ATOMIC_ACQUIRE, "agent");
            asm volatile("s_waitcnt vmcnt(0)" ::: "memory");
        }
    }
    __syncthreads();
}

#define XB_GRP(j) (3520 + 64 * (j))
#define XB_GMASK(j) (3520 + 64 * (j) + 32)
#define XB_PAIR(j) (8192 + 64 * (j))
__device__ __forceinline__ void group_barrier(const XcdBarrier& b, unsigned cword, unsigned gsize, int gslot = 2) {
    asm volatile("s_waitcnt vmcnt(0)" ::: "memory");
    __syncthreads();
    if (threadIdx.x == 0) {
        unsigned* bar = b.bar;
        __builtin_amdgcn_s_waitcnt(0);
        if (b.st[3] == 0u) {
            __builtin_amdgcn_fence(__ATOMIC_RELEASE, "agent");
            asm volatile("s_waitcnt vmcnt(0)" ::: "memory");
        }
        const unsigned gen = b.st[gslot];
        (void)xb_add(&bar[cword], 1u);
        const unsigned target = (gen + 1u) * gsize;
        XB_SPIN(xb_ld(&bar[cword]) < target, bar);
        __builtin_amdgcn_fence(__ATOMIC_ACQUIRE, "agent");
        asm volatile("s_waitcnt vmcnt(0)" ::: "memory");
        b.st[gslot] = gen + 1u;
    }
    __syncthreads();
}

__device__ __forceinline__ void group_post(const XcdBarrier& b, unsigned grp) { if (threadIdx.x == 0) (void)__hip_atomic_fetch_or(&b.bar[XB_GMASK(grp)], 1u << b.x, __ATOMIC_RELAXED, __HIP_MEMORY_SCOPE_AGENT); }
__device__ __forceinline__ void group_resolve(const XcdBarrier& b, unsigned grp) {
    if (threadIdx.x == 0) { const unsigned m = xb_ld(&b.bar[XB_GMASK(grp)]); b.st[3] = (m != 0u && (m & (m - 1u)) == 0u) ? 1u : 0u; }
    __syncthreads();
}
struct Frame {
    LAS unsigned char* lds;
    int tid, lane, wave, G, wg;
    unsigned char* ws;
};

__device__ __forceinline__ void transpose_item(const float* __restrict__ W, int K, int ldn, int src_c0, int nvalid, bf16_t* __restrict__ WT, LAS float* scr, int kb, int nb, int lane) {
    const int k0 = 64 * kb, n0 = 32 * nb, nn = n0 + (lane & 31);
    const bool ok = nn < nvalid;
#pragma unroll 8
    for (int i = 0; i < 32; ++i) { const int kk = 2 * i + (lane >> 5); scr[kk * 33 + (lane & 31)] = ok ? W[(size_t)(k0 + kk) * ldn + src_c0 + nn] : 0.0f; }
    LDS_WAIT();
    const int c = lane & 7;
#pragma unroll
    for (int j = 0; j < 4; ++j) { const int n = (lane >> 3) + 8 * j; const LAS float* s = scr + (8 * c) * 33 + n;
        u32x4 o; o.x = cvt_pk_bf16(s[0 * 33], s[1 * 33]); o.y = cvt_pk_bf16(s[2 * 33], s[3 * 33]); o.z = cvt_pk_bf16(s[4 * 33], s[5 * 33]); o.w = cvt_pk_bf16(s[6 * 33], s[7 * 33]);
        *(u32x4*)(WT + (size_t)(n0 + n) * K + k0 + 8 * c) = o; }
    LDS_WAIT();
}
__device__ __forceinline__ void ln_row(const float* __restrict__ xrow, const float* __restrict__ g, const float* __restrict__ bta, bf16_t* obf, float* of32, int lane) {
    const f32x4* xr = (const f32x4*)xrow + lane;
    f32x4 v[4]; float s = 0.f;
#pragma unroll
    for (int j = 0; j < 4; ++j) { v[j] = xr[64 * j]; s += (v[j][0] + v[j][1]) + (v[j][2] + v[j][3]); }
    const float mean = wave_sum(s) * (1.f / D); float s2 = 0.f;
#pragma unroll
    for (int j = 0; j < 4; ++j) { v[j] = v[j] - mean; s2 += (v[j][0] * v[j][0] + v[j][1] * v[j][1]) + (v[j][2] * v[j][2] + v[j][3] * v[j][3]); }
    const float rstd = 1.f / sqrtf(wave_sum(s2) * (1.f / D) + LN_EPS);
#pragma unroll
    for (int j = 0; j < 4; ++j) {
        const f32x4 gg = ((const f32x4*)g)[lane + 64 * j], bb = ((const f32x4*)bta)[lane + 64 * j];
        const f32x4 y = v[j] * rstd * gg + bb;
        if (obf) { u32x2 w; w.x = cvt_pk_bf16(y[0], y[1]); w.y = cvt_pk_bf16(y[2], y[3]); ((u32x2*)obf)[lane + 64 * j] = w; }
        if (of32) ((f32x4*)of32)[lane + 64 * j] = y;
    }
}
__device__ __forceinline__ void ln_row_bf(const bf16_t* __restrict__ xrow, const float* __restrict__ g, const float* __restrict__ bta, bf16_t* obf, float* of32, int lane) {
    const u32x4 a0 = *(const u32x4*)(xrow + 16 * lane), a1 = *(const u32x4*)(xrow + 16 * lane + 8);
    float v[16] = {bf_lo(a0.x), bf_hi(a0.x), bf_lo(a0.y), bf_hi(a0.y), bf_lo(a0.z), bf_hi(a0.z), bf_lo(a0.w), bf_hi(a0.w), bf_lo(a1.x), bf_hi(a1.x), bf_lo(a1.y), bf_hi(a1.y), bf_lo(a1.z), bf_hi(a1.z), bf_lo(a1.w), bf_hi(a1.w)};
    float s = 0.f;
#pragma unroll
    for (int i = 0; i < 16; ++i) s += v[i];
    const float mean = wave_sum(s) * (1.f / D); float s2 = 0.f;
#pragma unroll
    for (int i = 0; i < 16; ++i) { v[i] -= mean; s2 += v[i] * v[i]; }
    const float rstd = 1.f / sqrtf(wave_sum(s2) * (1.f / D) + LN_EPS);
    float y[16];
#pragma unroll
    for (int j = 0; j < 4; ++j) { const f32x4 gg = ((const f32x4*)g)[4 * lane + j], bb = ((const f32x4*)bta)[4 * lane + j];
#pragma unroll
        for (int i = 0; i < 4; ++i) y[4 * j + i] = v[4 * j + i] * rstd * gg[i] + bb[i]; }
    if (obf) { u32x4 w0, w1; w0.x = cvt_pk_bf16(y[0], y[1]); w0.y = cvt_pk_bf16(y[2], y[3]); w0.z = cvt_pk_bf16(y[4], y[5]); w0.w = cvt_pk_bf16(y[6], y[7]);
        w1.x = cvt_pk_bf16(y[8], y[9]); w1.y = cvt_pk_bf16(y[10], y[11]); w1.z = cvt_pk_bf16(y[12], y[13]); w1.w = cvt_pk_bf16(y[14], y[15]);
        *(u32x4*)(obf + 16 * lane) = w0; *(u32x4*)(obf + 16 * lane + 8) = w1; }
    if (of32) {
#pragma unroll
        for (int j = 0; j < 4; ++j) ((f32x4*)of32)[4 * lane + j] = (f32x4){y[4 * j], y[4 * j + 1], y[4 * j + 2], y[4 * j + 3]}; }
}
__device__ __forceinline__ void ln_rows_bf(const bf16_t* __restrict__ X, const float* __restrict__ g, const float* __restrict__ bta, bf16_t* obf, float* of32, int gw, int ngw, int mend, int lane) {
    f32x4 gg[4], bb[4];
#pragma unroll
    for (int j = 0; j < 4; ++j) { gg[j] = ((const f32x4*)g)[4 * lane + j]; bb[j] = ((const f32x4*)bta)[4 * lane + j]; }
    int m = gw;
    u32x4 n0 = (u32x4){0u, 0u, 0u, 0u}, n1 = n0;
    if (m < mend) { n0 = *(const u32x4*)(X + (size_t)m * D + 16 * lane); n1 = *(const u32x4*)(X + (size_t)m * D + 16 * lane + 8); }
#pragma unroll 1
    for (; m < mend; m += ngw) {
        const u32x4 a0 = n0, a1 = n1;
        if (m + ngw < mend) { n0 = *(const u32x4*)(X + (size_t)(m + ngw) * D + 16 * lane); n1 = *(const u32x4*)(X + (size_t)(m + ngw) * D + 16 * lane + 8); }
        float v[16] = {bf_lo(a0.x), bf_hi(a0.x), bf_lo(a0.y), bf_hi(a0.y), bf_lo(a0.z), bf_hi(a0.z), bf_lo(a0.w), bf_hi(a0.w), bf_lo(a1.x), bf_hi(a1.x), bf_lo(a1.y), bf_hi(a1.y), bf_lo(a1.z), bf_hi(a1.z), bf_lo(a1.w), bf_hi(a1.w)};
        float s = 0.f;
#pragma unroll
        for (int i = 0; i < 16; ++i) s += v[i];
        const float mean = wave_sum(s) * (1.f / D); float s2 = 0.f;
#pragma unroll
        for (int i = 0; i < 16; ++i) { v[i] -= mean; s2 += v[i] * v[i]; }
        const float rstd = 1.f / sqrtf(wave_sum(s2) * (1.f / D) + LN_EPS);
        float y[16];
#pragma unroll
        for (int j = 0; j < 4; ++j)
#pragma unroll
            for (int i = 0; i < 4; ++i) y[4 * j + i] = v[4 * j + i] * rstd * gg[j][i] + bb[j][i];
        if (obf) { u32x4 w0, w1; w0.x = cvt_pk_bf16(y[0], y[1]); w0.y = cvt_pk_bf16(y[2], y[3]); w0.z = cvt_pk_bf16(y[4], y[5]); w0.w = cvt_pk_bf16(y[6], y[7]);
            w1.x = cvt_pk_bf16(y[8], y[9]); w1.y = cvt_pk_bf16(y[10], y[11]); w1.z = cvt_pk_bf16(y[12], y[13]); w1.w = cvt_pk_bf16(y[14], y[15]);
            *(u32x4*)(obf + (size_t)m * D + 16 * lane) = w0; *(u32x4*)(obf + (size_t)m * D + 16 * lane + 8) = w1; }
        if (of32) {
#pragma unroll
            for (int j = 0; j < 4; ++j) ((f32x4*)(of32 + (size_t)m * D))[4 * lane + j] = (f32x4){y[4 * j], y[4 * j + 1], y[4 * j + 2], y[4 * j + 3]}; }
    }
}
__device__ __forceinline__ void convert_f32_bf16(const float* __restrict__ src, bf16_t* __restrict__ dst, size_t n, size_t gtid, size_t gthreads) {
    const size_t n8 = n >> 3;
    for (size_t i = gtid; i < n8; i += gthreads) {
        const f32x4 a = ((const f32x4*)src)[2 * i], b = ((const f32x4*)src)[2 * i + 1];
        u32x4 o; o.x = cvt_pk_bf16(a[0], a[1]); o.y = cvt_pk_bf16(a[2], a[3]); o.z = cvt_pk_bf16(b[0], b[1]); o.w = cvt_pk_bf16(b[2], b[3]);
        ((u32x4*)dst)[i] = o;
    }
}

__device__ __forceinline__ float fp8_row_scale(float amax, float* inv) {
    const int ex = (int)((__float_as_uint(amax) >> 23) & 0xffu);
    if (ex < 16 || ex > 240) { *inv = 1.0f; return 1.0f; }
    *inv = __uint_as_float((unsigned)(ex - 7) << 23);
    return __uint_as_float((unsigned)(261 - ex) << 23);
}
__device__ __forceinline__ unsigned pack4_fp8(float a, float b, float c, float d) {
    int w = __builtin_amdgcn_cvt_pk_fp8_f32(a, b, 0, false);
    w = __builtin_amdgcn_cvt_pk_fp8_f32(c, d, w, true);
    return (unsigned)w;
}
__device__ __forceinline__ void convert_rows_fp8(const float* __restrict__ src, unsigned char* __restrict__ dst, float* __restrict__ inv_scale, int nrows, int gw, int ngw, int lane) {
    for (int row = gw; row < nrows; row += ngw) {
        const f32x4* xr = (const f32x4*)(src + (size_t)row * D) + lane;
        f32x4 v[4]; float am = 0.f;
#pragma unroll
        for (int j = 0; j < 4; ++j) { v[j] = xr[64 * j]; am = fmaxf(am, fmaxf(fmaxf(fabsf(v[j][0]), fabsf(v[j][1])), fmaxf(fabsf(v[j][2]), fabsf(v[j][3])))); }
        am = wave_max(am);
        float inv; const float sc = fp8_row_scale(am, &inv);
#pragma unroll
        for (int j = 0; j < 4; ++j) ((unsigned*)(dst + (size_t)row * D))[lane + 64 * j] = pack4_fp8(v[j][0] * sc, v[j][1] * sc, v[j][2] * sc, v[j][3] * sc);
        if (lane == 0) inv_scale[row] = inv;
    }
}

__device__ __forceinline__ void convert_rows_i4(const float* __restrict__ src, unsigned char* __restrict__ dst, float* __restrict__ step_out, int nrows, int gw, int ngw, int lane) {
    f32x4 nv[4];
#pragma unroll
    for (int j = 0; j < 4; ++j) nv[j] = (f32x4){0.f, 0.f, 0.f, 0.f};
    if (gw < nrows) {
#pragma unroll
        for (int j = 0; j < 4; ++j) nv[j] = ((const f32x4*)(src + (size_t)gw * D + 16 * lane))[j]; }
#pragma unroll 1
    for (int row = gw; row < nrows; row += ngw) {
        f32x4 v[4]; float am = 0.f;
#pragma unroll
        for (int j = 0; j < 4; ++j) v[j] = nv[j];
        if (row + ngw < nrows) {
#pragma unroll
            for (int j = 0; j < 4; ++j) nv[j] = ((const f32x4*)(src + (size_t)(row + ngw) * D + 16 * lane))[j]; }
#pragma unroll
        for (int j = 0; j < 4; ++j) { am = fmaxf(am, fmaxf(fmaxf(fabsf(v[j][0]), fabsf(v[j][1])), fmaxf(fabsf(v[j][2]), fabsf(v[j][3])))); }
        am = wave_max(am);
        float ss = 0.f;
#pragma unroll
        for (int j = 0; j < 4; ++j) ss += (v[j][0] * v[j][0] + v[j][1] * v[j][1]) + (v[j][2] * v[j][2] + v[j][3] * v[j][3]);
        ss = wave_sum(ss);
        const float s_rms = 0.335f * sqrtf(ss * (1.0f / D)), s_lo = am * (1.0f / 15.0f), s_hi = am * (1.0f / 7.5f);
        const float step = am > 0.f ? fminf(fmaxf(s_rms, s_lo), s_hi) : 1.0f, rs = 1.0f / step;
        unsigned n[16];
#pragma unroll
        for (int j = 0; j < 4; ++j)
#pragma unroll
            for (int i = 0; i < 4; ++i) { const int q = (int)(v[j][i] * rs + 8.0f); n[4 * j + i] = (unsigned)(q < 0 ? 0 : (q > 15 ? 15 : q)); }
        u32x2 w; w.x = 0u; w.y = 0u;
#pragma unroll
        for (int k = 0; k < 4; ++k) { w.x |= (n[k] | (n[k + 8] << 4)) << (8 * k); w.y |= (n[4 + k] | (n[12 + k] << 4)) << (8 * k); }
        *(u32x2*)(dst + (size_t)row * 512 + 8 * lane) = w;
        if (lane == 0) step_out[row] = step;
    }
}

__device__ __forceinline__ void convert_rows_fp4(const float* __restrict__ src, unsigned char* __restrict__ dst, float* __restrict__ step_out, int nrows, int gw, int ngw, int lane) {
    f32x4 nv[4];
#pragma unroll
    for (int j = 0; j < 4; ++j) nv[j] = (f32x4){0.f, 0.f, 0.f, 0.f};
    if (gw < nrows) {
#pragma unroll
        for (int j = 0; j < 4; ++j) nv[j] = ((const f32x4*)(src + (size_t)gw * D + 16 * lane))[j]; }
#pragma unroll 1
    for (int row = gw; row < nrows; row += ngw) {
        f32x4 v[4]; float am = 0.f;
#pragma unroll
        for (int j = 0; j < 4; ++j) v[j] = nv[j];
        if (row + ngw < nrows) {
#pragma unroll
            for (int j = 0; j < 4; ++j) nv[j] = ((const f32x4*)(src + (size_t)(row + ngw) * D + 16 * lane))[j]; }
#pragma unroll
        for (int j = 0; j < 4; ++j) { am = fmaxf(am, fmaxf(fmaxf(fabsf(v[j][0]), fabsf(v[j][1])), fmaxf(fabsf(v[j][2]), fabsf(v[j][3])))); }
        am = wave_max(am);
        float ss = 0.f;
#pragma unroll
        for (int j = 0; j < 4; ++j) ss += (v[j][0] * v[j][0] + v[j][1] * v[j][1]) + (v[j][2] * v[j][2] + v[j][3] * v[j][3]);
        ss = wave_sum(ss);
        const float s_rms = 0.48f * sqrtf(ss * (1.0f / D)), s_lo = am * (1.0f / 12.0f), s_hi = am * (1.0f / 6.0f);
        const float step = am > 0.f ? fminf(fmaxf(s_rms, s_lo), s_hi) : 1.0f, rs = 1.0f / step;
        unsigned n[16];
#pragma unroll
        for (int j = 0; j < 4; ++j)
#pragma unroll
            for (int i = 0; i < 4; ++i) { const float y = v[j][i] * rs, ay = fabsf(y);
                const unsigned mag = (ay >= 0.25f ? 1u : 0u) + (ay >= 0.75f ? 1u : 0u) + (ay >= 1.25f ? 1u : 0u) + (ay >= 1.75f ? 1u : 0u) + (ay >= 2.5f ? 1u : 0u) + (ay >= 3.5f ? 1u : 0u) + (ay >= 5.0f ? 1u : 0u);
                n[4 * j + i] = mag | ((y < 0.f && mag != 0u) ? 8u : 0u); }
        u32x2 w; w.x = 0u; w.y = 0u;
#pragma unroll
        for (int k = 0; k < 4; ++k) { w.x |= (n[2 * k] | (n[2 * k + 1] << 4)) << (8 * k); w.y |= (n[8 + 2 * k] | (n[9 + 2 * k] << 4)) << (8 * k); }
        *(u32x2*)(dst + (size_t)row * 512 + 8 * lane) = w;
        if (lane == 0) step_out[row] = step;
    }
}

__device__ __forceinline__ float relu1(float d) { float r; asm("v_max_f32 %0, 0, %1" : "=v"(r) : "v"(d)); return r; }
__device__ __forceinline__ bool scan_hist_row(const LAS unsigned* row, int lane, unsigned target, unsigned& dsel, unsigned& ca, unsigned& csel, unsigned& tot_all) {
    unsigned wd[8];
#pragma unroll
    for (int i = 0; i < 8; ++i) wd[i] = row[8 * lane + i];
    unsigned tot = 0;
#pragma unroll
    for (int i = 0; i < 8; ++i) tot += (wd[i] & 0xffffu) + (wd[i] >> 16);
    unsigned pre_ = wave_prefix_sum(tot);
    asm volatile("" : "+v"(pre_));
    tot_all = (unsigned)__builtin_amdgcn_readlane((int)pre_, 63);
    const unsigned incl = tot_all - pre_ + tot;
    const unsigned above = incl - tot;
    dsel = 0; ca = above; csel = 0;
    if (!(above < target && target <= incl)) return false;
    bool found = false;
#pragma unroll
    for (int i = 15; i >= 0; --i) { const unsigned c = (i & 1) ? (wd[i >> 1] >> 16) : (wd[i >> 1] & 0xffffu);
        if (!found) { if (ca + c >= target) { found = true; dsel = (unsigned)(16 * lane + i); csel = c; } else ca += c; } }
    return true;
}
__device__ __forceinline__ void select_exact_wave(const LAS float* S, int ng, LAS unsigned* wh, u64* __restrict__ mq, int lane) {
    unsigned prefix = 0u, need = 256u;
#pragma unroll 1
    for (int pass = 0; pass < 4; ++pass) {
        const int shift = 24 - 8 * pass;
        *(LAS u32x4*)(wh + 4 * lane) = (u32x4){0u, 0u, 0u, 0u};
        asm volatile("s_waitcnt lgkmcnt(0)" ::: "memory");
#pragma unroll 4
        for (int g = 0; g < ng; ++g) { const unsigned u = f2sort(S[g * 64 + lane]);
            if (((u >> shift) >> 8) == prefix) __hip_atomic_fetch_add(wh + ((u >> shift) & 255u), 1u, __ATOMIC_RELAXED, __HIP_MEMORY_SCOPE_WORKGROUP); }
        asm volatile("s_waitcnt lgkmcnt(0)" ::: "memory");
        unsigned cc[4];
#pragma unroll
        for (int i = 0; i < 4; ++i) cc[i] = wh[4 * lane + i];
        const unsigned tot = cc[0] + cc[1] + cc[2] + cc[3];
        unsigned incl = tot;
#pragma unroll
        for (int off = 1; off < 64; off <<= 1) { const unsigned t = __shfl_down(incl, off); if (lane + off < 64) incl += t; }
        const unsigned above = incl - tot;
        const bool hit = above < need && need <= incl;
        unsigned ca = above, dsel = 0u; bool found = false;
#pragma unroll
        for (int i = 3; i >= 0; --i) if (!found) { if (ca + cc[i] >= need) { found = true; dsel = (unsigned)(4 * lane + i); } else ca += cc[i]; }
        const u64 hm = __ballot(hit); const int hl = hm ? (int)__builtin_ctzll(hm) : 0;
        const unsigned bsel = (unsigned)__shfl((int)dsel, hl), bca = (unsigned)__shfl((int)ca, hl);
        prefix = (prefix << 8) | bsel; need -= bca;
        asm volatile("" ::: "memory");
    }
    unsigned rem = need;
#pragma unroll 2
    for (int g = 0; g < ng; ++g) { const unsigned u = f2sort(S[g * 64 + lane]);
        const u64 gt = __ballot(u > prefix), eq = __ballot(u == prefix);
        const unsigned below = __builtin_amdgcn_mbcnt_hi((unsigned)(eq >> 32), __builtin_amdgcn_mbcnt_lo((unsigned)eq, 0u));
        const u64 pick = __ballot(u == prefix && below < rem);
        const unsigned np = (unsigned)__builtin_popcountll(pick);
        rem -= np;
        if (lane == 0) mq[(size_t)g * 4096] = gt | pick; }
}
template <int MODE>
__device__ __forceinline__ void select_sweep(const bf16_t* __restrict__ ikb, const bf16x8 (&bq)[4][2], const f32x4 wq, int kh, int ng, int fr, int fq, bool active, unsigned P0, unsigned P1,
                                             LAS unsigned* hrow, u64* __restrict__ mrow, float flo = 0.f, float finv = 0.f, float* amax = nullptr, LAS unsigned* lcnt = nullptr, LAS u64* lrow = nullptr, unsigned cap = 0u, unsigned zg = 0u, unsigned zk = 0u, unsigned fs = 0u, bool dmp = false, LAS float* scb = nullptr) {
    const float tin = (P0 == 0u) ? -INFINITY : (float)P0;
    const float tsel = (P1 & 1u) ? tin : ((P0 >= 1023u) ? INFINITY : (float)(P0 + 1u));
    bf16x8 ka[8];
#define SEL_LOAD1(G, KT) do { const bf16_t* kp = ikb + (size_t)((G) * 64 + (KT) * 16 + fr) * 64 + 8 * fq; ka[2 * (KT)] = *(const bf16x8*)kp; ka[2 * (KT) + 1] = *(const bf16x8*)(kp + 32); } while (0)
    int g = kh;
    if (g < ng) {
#pragma unroll
        for (int kt = 0; kt < 4; ++kt) SEL_LOAD1(g, kt);
    }
#pragma unroll 1
    for (; g < ng; g += 2) {
        unsigned lo_ = 0u, hi_ = 0u, zlo_ = 0u, zhi_ = 0u;
        const bool more = (g + 2 < ng);
#pragma unroll
        for (int kt = 0; kt < 4; ++kt) {
            f32x4 dd[4];
#pragma unroll
            for (int j = 0; j < 4; ++j) {
                dd[j] = __builtin_amdgcn_mfma_f32_16x16x32_bf16(ka[2 * kt], bq[j][0], (f32x4){0.f, 0.f, 0.f, 0.f}, 0, 0, 0);
                dd[j] = __builtin_amdgcn_mfma_f32_16x16x32_bf16(ka[2 * kt + 1], bq[j][1], dd[j], 0, 0, 0);
            }
            if (more) SEL_LOAD1(g + 2, kt);
            f32x4 sc = (f32x4){0.f, 0.f, 0.f, 0.f};
#pragma unroll
            for (int j = 0; j < 4; ++j)
#pragma unroll
                for (int r = 0; r < 4; ++r) sc[r] += wq[j] * relu1(dd[j][r]);
            unsigned nib = 0u, znib = 0u;
#pragma unroll
            for (int r = 0; r < 4; ++r) {
                const unsigned u = f2sort(sc[r] + 0.0f), inv = (unsigned)(4095 - (g * 64 + kt * 16 + 4 * fq + r));
                if (MODE == 5) { nib |= ((u > P0) || (u == P0 && inv >= P1)) ? (1u << r) : 0u; }
                else if (MODE == 6) { *amax = fmaxf(*amax, fabsf(sc[r])); }
                else if (MODE == 7) { const unsigned bi = (unsigned)(int)fminf(fmaxf(__builtin_fmaf(sc[r], finv, 512.0f), 0.f), 1023.f);
                    if (bi >= P0) __hip_atomic_fetch_add(hrow + (bi >> 1), (bi & 1u) ? 65536u : 1u, __ATOMIC_RELAXED, __HIP_MEMORY_SCOPE_WORKGROUP);
                    if (lcnt != nullptr && sc[r] == 0.0f) znib += 1u; }
                else if (MODE == 8) { const float tb = __builtin_fmaf(sc[r], finv, 512.0f);
                    const bool s1 = fs == 0u && tb >= tsel;
                    nib |= s1 ? (1u << r) : 0u;
                    if (fs == 0u && !s1 && tb >= tin) {
                        if ((P1 & 2u) != 0u && sc[r] == 0.0f) znib |= (1u << r);
                        else { const unsigned pos = __hip_atomic_fetch_add(lcnt, 1u, __ATOMIC_RELAXED, __HIP_MEMORY_SCOPE_WORKGROUP); if (pos < cap) lrow[pos] = ((u64)u << 12) | (u64)inv; } } }
                else if (MODE == 9) { }
                else { bool match; unsigned dg;
                    if (MODE == 0) { match = active; dg = u >> 22; }
                    else if (MODE == 1) { match = active && (u >> 22) == P0; dg = (u >> 12) & 1023u; }
                    else if (MODE == 2) { match = active && (u >> 12) == P0; dg = (u >> 2) & 1023u; }
                    else if (MODE == 3) { match = active && (u >> 2) == P0; dg = ((u & 3u) << 8) | (inv >> 4); }
                    else { match = active && u == P0 && (inv >> 4) == P1; dg = inv & 15u; }
                    if (match) __hip_atomic_fetch_add(hrow + (dg >> 1), (dg & 1u) ? 65536u : 1u, __ATOMIC_RELAXED, __HIP_MEMORY_SCOPE_WORKGROUP); }
            }
            if (MODE == 8 || MODE == 9) { if (dmp) *(LAS f32x4*)(scb + g * 64 + kt * 16 + 4 * fq) = sc + 0.0f; }
            if (MODE == 5 || MODE == 8) { const unsigned sh = (unsigned)((kt & 1) * 16 + 4 * fq); if (kt < 2) lo_ |= nib << sh; else hi_ |= nib << sh; }
            if (MODE == 8) { const unsigned sh = (unsigned)((kt & 1) * 16 + 4 * fq); if (kt < 2) zlo_ |= znib << sh; else zhi_ |= znib << sh; }
            if (MODE == 7) { if (znib != 0u) __hip_atomic_fetch_add(lcnt + (g >> 1), znib << (16 * (g & 1)), __ATOMIC_RELAXED, __HIP_MEMORY_SCOPE_WORKGROUP); }
        }
        if (MODE == 5 || MODE == 8) { lo_ |= __shfl_xor(lo_, 16); lo_ |= __shfl_xor(lo_, 32); hi_ |= __shfl_xor(hi_, 16); hi_ |= __shfl_xor(hi_, 32);
            u64 word = ((u64)hi_ << 32) | (u64)lo_;
            if (MODE == 8 && (P1 & 2u) != 0u) {
                zlo_ |= __shfl_xor(zlo_, 16); zlo_ |= __shfl_xor(zlo_, 32); zhi_ |= __shfl_xor(zhi_, 16); zhi_ |= __shfl_xor(zhi_, 32);
                u64 zm = ((u64)zhi_ << 32) | (u64)zlo_;
                if (g > (int)zg) zm = 0ull; else if (g == (int)zg) { u64 pick = 0ull; for (unsigned i = 0; i < zk; ++i) { const u64 bb = zm & (0ull - zm); pick |= bb; zm ^= bb; } zm = pick; }
                word |= zm; }
            if (fq == 0 && (MODE != 8 || fs == 0u)) mrow[(size_t)g * 4096] = word; }
    }
#undef SEL_LOAD1
}
__device__ __forceinline__ void select_item(const Frame& F, int b, int qb, const bf16_t* __restrict__ IQ, const bf16_t* __restrict__ IK, const float* __restrict__ IW, u64* __restrict__ MASK) {
    constexpr int HS = 513;
    LAS unsigned* hist = (LAS unsigned*)(F.lds + LDS_A);
    LAS u64* Pq = (LAS u64*)(F.lds + LDS_B + 2048);
    LAS u64* Thr = (LAS u64*)(F.lds + LDS_B + 2048 + 512);
    LAS unsigned* Need = (LAS unsigned*)(F.lds + LDS_B + 2048 + 1024);
    LAS unsigned* Done = (LAS unsigned*)(F.lds + LDS_B + 2048 + 1280);
    LAS unsigned* NDone = (LAS unsigned*)(F.lds + LDS_B + 2048 + 1536);
    const int lane = lane_id_fresh(), w = WAVE_FRESH(), qg = w & 3, kh = w >> 2, fr = lane & 15, fq = lane >> 4;
    const int q0 = qb * 64, ql = 16 * qg + fr, ng = qb + 1, tid = w * 64 + lane;
    u64* mrow = MASK + (size_t)b * 64 * 4096 + (q0 + ql);
    if (qb < 4) {
        for (int g = kh; g < ng; g += 2) if (fq == 0) mrow[(size_t)g * 4096] = ~0ull;
        return;
    }
    bf16x8 bq[4][2]; f32x4 wq;
#pragma unroll
    for (int j = 0; j < 4; ++j)
#pragma unroll
        for (int ks = 0; ks < 2; ++ks) bq[j][ks] = *(const bf16x8*)(IQ + ((size_t)((b * 4 + j) * 4096 + q0 + ql)) * 64 + 32 * ks + 8 * fq);
    wq = *(const f32x4*)(IW + (size_t)(b * 4096 + q0 + ql) * 4);
    const bf16_t* ikb = IK + (size_t)b * 4096 * 64;
    {
        constexpr unsigned CAP = 128u, NSLOT = 4u;
        LAS unsigned* AMX = (LAS unsigned*)(F.lds + LDS_B + 2048 + 1792);
        LAS unsigned* LCN = (LAS unsigned*)(F.lds + LDS_B + 2048 + 2048);
        LAS unsigned* ALQ = (LAS unsigned*)(F.lds + LDS_B + 2048 + 2304);
        LAS u64* LST = (LAS u64*)(F.lds + LDS_A);
        LAS unsigned* ZH = (LAS unsigned*)(F.lds + LDS_B + 8192);
        LAS unsigned* ZGK = (LAS unsigned*)(F.lds + LDS_B + 2048 + 3072);
        LAS unsigned* OVF = (LAS unsigned*)(F.lds + LDS_B + 2048 + 2560);
        LAS unsigned* FSL = (LAS unsigned*)(F.lds + LDS_B + 2048 + 3328);
        LAS unsigned* FQS = (LAS unsigned*)(F.lds + LDS_B + 2048 + 3840);
        LAS unsigned* NFL = (LAS unsigned*)(F.lds + LDS_B + 2048 + 3584);
        LAS float* SCB = (LAS float*)(F.lds + LDS_A + 65536);
        u64 zero64_ = 0ull; asm volatile("" : "+v"(zero64_));
        if (tid < 64) { AMX[tid] = 0u; LCN[tid] = 0u; ALQ[tid] = 0u; Need[tid] = 256u; Pq[tid] = zero64_; ZGK[tid] = 0u; FSL[tid] = 0u; }
        if (tid == 0) { OVF[0] = 0u; NFL[0] = 0u; }
#define SEL_RESCUE(Q) do { const unsigned s_ = __hip_atomic_fetch_add(NFL, 1u, __ATOMIC_RELAXED, __HIP_MEMORY_SCOPE_WORKGROUP); if (s_ < 64u) { FSL[Q] = s_ + 1u; FQS[s_] = (unsigned)(Q); } else OVF[0] = 1u; } while (0)
        for (int i = tid; i < 64 * 32; i += NTHREADS) ZH[i] = 0u;
        for (int i = tid; i < (64 * HS + 3) / 4; i += NTHREADS) ((LAS u32x4*)hist)[i] = (u32x4){0u, 0u, 0u, 0u};
        __syncthreads();
        { float am = 0.f;
          select_sweep<6>(ikb, bq, wq, kh, 2, fr, fq, true, 0u, 0u, hist, mrow, 0.f, 0.f, &am);
          am = fmaxf(am, __shfl_xor(am, 16)); am = fmaxf(am, __shfl_xor(am, 32));
          if (fq == 0) __hip_atomic_fetch_max(AMX + ql, __float_as_uint(am), __ATOMIC_RELAXED, __HIP_MEMORY_SCOPE_WORKGROUP); }
        __syncthreads();
        const float fhi = __uint_as_float(((AMX[ql] >> 23) + 2u) << 23), flo = -fhi, finv = 512.0f / fhi;
        LAS unsigned* LBN = (LAS unsigned*)(F.lds + LDS_B + 2048 + 2816);
        select_sweep<7>(ikb, bq, wq, kh, 2, fr, fq, true, 0u, 0u, hist + ql * HS, mrow, flo, finv);
        __syncthreads();
        { const unsigned nvis = 64u * (unsigned)ng; unsigned msel = (128u * 256u * 3u + nvis - 1u) / nvis + 8u;
          for (int qi = 0; qi < 8; ++qi) { const int q = 8 * w + qi; unsigned dsel, ca, csel, tall;
              const bool hit = scan_hist_row(hist + q * HS, lane, msel, dsel, ca, csel, tall);
              if (msel >= 128u) { if (lane == 0) LBN[q] = 0u; } else if (hit) LBN[q] = dsel; } }
        __syncthreads();
        for (int i = tid; i < (64 * HS + 3) / 4; i += NTHREADS) ((LAS u32x4*)hist)[i] = (u32x4){0u, 0u, 0u, 0u};
        __syncthreads();
        select_sweep<7>(ikb, bq, wq, kh, ng, fr, fq, true, LBN[ql], 0u, hist + ql * HS, mrow, flo, finv, nullptr, ZH + ql * 32);
        __syncthreads();
        for (int qi = 0; qi < 8; ++qi) {
            const int q = 8 * w + qi; unsigned dsel, ca, csel, tall;
            const bool hit = scan_hist_row(hist + q * HS, lane, 256u, dsel, ca, csel, tall);
            if (lane == 0 && tall < 256u) SEL_RESCUE(q);
            const u64 hm = __ballot(hit); const int hl = hm ? (int)__builtin_ctzll(hm) : 0;
            const unsigned bsel = (unsigned)__shfl((int)dsel, hl), bca = (unsigned)__shfl((int)ca, hl), bcs = (unsigned)__shfl((int)csel, hl);
            if (hm != 0ull) {
                const unsigned nneed = 256u - bca;
                if (lane == 0) { Pq[q] = (u64)bsel; Need[q] = nneed; }
                if (bcs == nneed) { if (lane == 0) ALQ[q] = 1u; }
                else { const float qhi = __uint_as_float(((AMX[q] >> 23) + 2u) << 23); const unsigned bz = (unsigned)(int)fminf(fmaxf((0.0f + qhi) * (512.0f / qhi), 0.f), 1023.f);
                    unsigned cl = bcs;
                    if (bsel == bz) {
                        const unsigned zz = ZH[q * 32 + (lane >> 1)], zc = (lane & 1) ? (zz >> 16) : (zz & 0xffffu);
                        unsigned incl = zc;
#pragma unroll
                        for (int off = 1; off < 64; off <<= 1) { const unsigned t = (unsigned)__shfl_up((int)incl, off); if (lane >= off) incl += t; }
                        const unsigned Z = (unsigned)__shfl((int)incl, 63);
                        const unsigned p = bcs - Z;
                        const unsigned zsel = nneed > p ? (nneed - p < Z ? nneed - p : Z) : 0u;
                        const u64 gm = __ballot(incl >= zsel && zsel != 0u); const int gl = gm ? (int)__builtin_ctzll(gm) : 0;
                        const unsigned gex = (unsigned)__shfl((int)(incl - zc), gl);
                        const unsigned G = zsel ? (unsigned)gl : 0u, kin = zsel ? zsel - gex : 0u;
                        if (lane == 0) ZGK[q] = ((G << 8) | kin) + 1u;
                        cl = p; }
                    if (cl > CAP && lane == 0) SEL_RESCUE(q); } }
        }
        __syncthreads();
        if (OVF[0] == 0u) {
            LAS u64* lrow = LST + ql * CAP;
            const unsigned zgk = ZGK[ql], fs = FSL[ql];
            select_sweep<8>(ikb, bq, wq, kh, ng, fr, fq, true, (unsigned)Pq[ql], ALQ[ql] | (zgk != 0u ? 2u : 0u), hist, mrow, flo, finv, nullptr, LCN + ql, lrow, CAP, (zgk - 1u) >> 8, (zgk - 1u) & 255u, fs, fs != 0u && fs <= NSLOT, SCB + ((fs - 1u) & (NSLOT - 1u)) * 4096u);
            asm volatile("s_waitcnt vmcnt(0)" ::: "memory");
            __syncthreads();
            for (int qi = 0; qi < 8; ++qi) {
                const int q = 8 * w + qi;
                if (ALQ[q] != 0u || FSL[q] != 0u) continue;
                const unsigned c = LCN[q], need = Need[q];
                const LAS u64* lq = LST + q * CAP;
                u64 ci[2]; unsigned rank[2];
#pragma unroll
                for (int m = 0; m < 2; ++m) { ci[m] = ((unsigned)(lane + 64 * m) < c) ? lq[lane + 64 * m] : ~0ull; rank[m] = 0u; }
                for (unsigned j = 0; j < c; ++j) { const u64 cj = lq[j];
#pragma unroll
                    for (int m = 0; m < 2; ++m) rank[m] += (cj > ci[m]) ? 1u : 0u; }
                u64* mq = MASK + (size_t)b * 64 * 4096 + (q0 + q);
#pragma unroll
                for (int m = 0; m < 2; ++m) if ((unsigned)(lane + 64 * m) < c && rank[m] < need) { const unsigned key = 4095u - (unsigned)(ci[m] & 4095ull);
                    __hip_atomic_fetch_or(mq + (size_t)(key >> 6) * 4096, 1ull << (key & 63u), __ATOMIC_RELAXED, __HIP_MEMORY_SCOPE_AGENT); }
            }
            const unsigned nfl = NFL[0];
            if ((unsigned)w < (nfl < NSLOT ? nfl : NSLOT)) { const unsigned q = FQS[w];
                select_exact_wave(SCB + w * 4096, ng, ZH + w * 256, MASK + (size_t)b * 64 * 4096 + (q0 + (int)q), lane); }
            if (__builtin_expect(nfl > NSLOT, 0))
_Pragma("unroll 1")
            for (unsigned base = NSLOT; base < nfl; base += 8u) {
                __syncthreads();
                const bool dm = fs > base && fs <= base + 8u;
                select_sweep<9>(ikb, bq, wq, kh, ng, fr, fq, true, 0u, 0u, hist, mrow, 0.f, 0.f, nullptr, nullptr, nullptr, 0u, 0u, 0u, fs, dm, (LAS float*)(F.lds + LDS_A) + ((fs - base - 1u) & 7u) * 4096u);
                __syncthreads();
                if (base + (unsigned)w < nfl) { const unsigned q = FQS[base + w];
                    select_exact_wave((LAS float*)(F.lds + LDS_A) + w * 4096, ng, ZH + w * 256, MASK + (size_t)b * 64 * 4096 + (q0 + (int)q), lane); }
            }
            __syncthreads();
            return;
        }
#undef SEL_RESCUE
    }
    if (tid < 64) { Pq[tid] = 0ull; Need[tid] = 256u; Done[tid] = 0u; Thr[tid] = 0ull; }
    if (tid == 0) NDone[0] = 0u;
    __syncthreads();
    for (int pass = 0; pass < 5; ++pass) {
        const int sh_hi = 44 - 10 * pass, wbits = sh_hi < 10 ? sh_hi : 10, sh_lo = sh_hi - wbits;
        for (int i = tid; i < (64 * HS + 3) / 4; i += NTHREADS) ((LAS u32x4*)hist)[i] = (u32x4){0u, 0u, 0u, 0u};
        __syncthreads();
        const u64 myP = Pq[ql]; const bool active = Done[ql] == 0u;
        LAS unsigned* hrow = hist + ql * HS;
        if (pass == 0) select_sweep<0>(ikb, bq, wq, kh, ng, fr, fq, active, 0u, 0u, hrow, mrow);
        else if (pass == 1) select_sweep<1>(ikb, bq, wq, kh, ng, fr, fq, active, (unsigned)myP, 0u, hrow, mrow);
        else if (pass == 2) select_sweep<2>(ikb, bq, wq, kh, ng, fr, fq, active, (unsigned)myP, 0u, hrow, mrow);
        else if (pass == 3) select_sweep<3>(ikb, bq, wq, kh, ng, fr, fq, active, (unsigned)myP, 0u, hrow, mrow);
        else select_sweep<4>(ikb, bq, wq, kh, ng, fr, fq, active, (unsigned)(myP >> 8), (unsigned)myP & 255u, hrow, mrow);
        __syncthreads();
        for (int qi = 0; qi < 8; ++qi) {
            const int q = 8 * w + qi;
            if (Done[q] != 0u) continue;
            unsigned wd[8];
#pragma unroll
            for (int i = 0; i < 8; ++i) wd[i] = hist[q * HS + 8 * lane + i];
            unsigned tot = 0;
#pragma unroll
            for (int i = 0; i < 8; ++i) tot += (wd[i] & 0xffffu) + (wd[i] >> 16);
            unsigned incl = tot;
#pragma unroll
            for (int off = 1; off < 64; off <<= 1) { const unsigned t = __shfl_down(incl, off); if (lane + off < 64) incl += t; }
            const unsigned above = incl - tot, need = Need[q];
            if (above < need && need <= incl) {
                unsigned ca = above, dsel = 0, csel = 0; bool found = false;
#pragma unroll
                for (int i = 15; i >= 0; --i) { const unsigned c = (i & 1) ? (wd[i >> 1] >> 16) : (wd[i >> 1] & 0xffffu);
                    if (!found) { if (ca + c >= need) { found = true; dsel = (unsigned)(16 * lane + i); csel = c; } else ca += c; } }
                const unsigned nneed = need - ca;
                const u64 np = (Pq[q] << wbits) | (u64)dsel;
                Pq[q] = np; Need[q] = nneed;
                if (csel == nneed || sh_lo == 0) { Done[q] = 1u; Thr[q] = np << sh_lo; __hip_atomic_fetch_add(NDone, 1u, __ATOMIC_RELAXED, __HIP_MEMORY_SCOPE_WORKGROUP); }
            }
        }
        __syncthreads();
        if (NDone[0] >= 64u) break;
    }
    const u64 thr = Thr[ql];
    select_sweep<5>(ikb, bq, wq, kh, ng, fr, fq, true, (unsigned)(thr >> 12), (unsigned)thr & 4095u, hist, mrow);
    __syncthreads();
}

__device__ __forceinline__ void knorm_item(const Frame& F, const bf16_t* __restrict__ Kt, float* __restrict__ out) {
    const int lane = lane_id_fresh(), tid = F.wave * 64 + lane;
    float mx = 0.f;
    for (int r = tid; r < 2048; r += NTHREADS) {
        const u32x4* p = (const u32x4*)(Kt + (size_t)r * 64); float s = 0.f;
#pragma unroll
        for (int c = 0; c < 8; ++c) { const u32x4 v = p[c];
            s += bf_lo(v.x) * bf_lo(v.x) + bf_hi(v.x) * bf_hi(v.x) + bf_lo(v.y) * bf_lo(v.y) + bf_hi(v.y) * bf_hi(v.y) + bf_lo(v.z) * bf_lo(v.z) + bf_hi(v.z) * bf_hi(v.z) + bf_lo(v.w) * bf_lo(v.w) + bf_hi(v.w) * bf_hi(v.w); }
        mx = fmaxf(mx, s);
    }
    mx = wave_max(mx);
    LAS float* red = (LAS float*)(F.lds + LDS_B + 6144);
    if (lane == 0) red[F.wave] = mx;
    __syncthreads();
    if (tid == 0) { float m = red[0];
#pragma unroll
        for (int i = 1; i < NWAVES; ++i) m = fmaxf(m, red[i]);
        *out = m; }
    __syncthreads();
}
typedef float f32x16 __attribute__((ext_vector_type(16)));
__device__ __forceinline__ float fadd_s(float a, float b) { float r; asm("v_add_f32 %0, %1, %2" : "=v"(r) : "v"(a), "v"(b)); return r; }
template <bool DSA>
__device__ __forceinline__ void attn_item(const Frame& F, int b, int hsel, int QB, const bf16_t* __restrict__ Qg, const bf16_t* __restrict__ Kg, const bf16_t* __restrict__ VTg,
                                          const u64* __restrict__ MASK, bf16_t* __restrict__ MIX, float lam, float lam_init, const float* __restrict__ subln_g, const float* __restrict__ KN) {
    constexpr int NDB = DSA ? 2 : 4;
    constexpr float THR = 6.0f;
    const int lane = lane_id_fresh(), w = WAVE_FRESH(), tid = w * 64 + lane, st = w >> 2, wq = w & 3, r32 = lane & 31, hh = lane >> 5;
    const int q0 = QB * 128, tq = q0 + 32 * wq + r32, nt = 2 * QB + 2, mychunk = 2 * QB + (wq >> 1);
    const int head = 2 * hsel + st;
    const float slope = DSA ? exp2f(-(float)(head + 1)) : exp2f(-2.0f * (float)(hsel + 1));
    const float SL = slope * LOG2E;
    bf16x8 qf[4];
    { const bf16_t* qp = Qg + ((size_t)((b * 8 + head) * 4096 + tq)) * 64 + 8 * hh;
#pragma unroll
      for (int ks = 0; ks < 4; ++ks) qf[ks] = *(const bf16x8*)(qp + 16 * ks); }
    float BQK;
    { float q2 = 0.f;
#pragma unroll
      for (int ks = 0; ks < 4; ++ks) { const u32x4 qw = __builtin_bit_cast(u32x4, qf[ks]);
          q2 += bf_lo(qw.x) * bf_lo(qw.x) + bf_hi(qw.x) * bf_hi(qw.x) + bf_lo(qw.y) * bf_lo(qw.y) + bf_hi(qw.y) * bf_hi(qw.y) + bf_lo(qw.z) * bf_lo(qw.z) + bf_hi(qw.z) * bf_hi(qw.z) + bf_lo(qw.w) * bf_lo(qw.w) + bf_hi(qw.w) * bf_hi(qw.w); }
      q2 += __shfl_xor(q2, 32);
#pragma unroll
      for (int o = 1; o < 32; o <<= 1) q2 = fmaxf(q2, __shfl_xor(q2, o));
      const float* knp = KN + ((b * 16 + (DSA ? 8 : 0) + head) * 2);
      BQK = sqrtf(q2) * sqrtf(fmaxf(knp[0], knp[1])) * 1.0001f + 0.01f; }
    asm volatile("" : "+v"(BQK));
    LAS int* DN = (LAS int*)(F.lds + LDS_B + 4096);
    if (lane == 0) DN[w] = -1;
    int mydn = -1;
    const int lrow = 8 * w + (lane >> 3), lc = (lane & 7) ^ ((lrow >> 1) & 7);
    const unsigned koff = (unsigned)(lrow * 64 + lc * 8) * 2u, voff = (unsigned)(lrow * 4096 + lc * 8) * 2u;
    const unsigned char* gb[4];
    gb[0] = (const unsigned char*)(Kg + ((size_t)((b * 8 + 2 * hsel + 0) * 4096)) * 64);
    gb[1] = (const unsigned char*)(Kg + ((size_t)((b * 8 + 2 * hsel + 1) * 4096)) * 64);
    if (DSA) { gb[2] = (const unsigned char*)(VTg + ((size_t)((b * 8 + 2 * hsel + 0) * 64)) * 4096); gb[3] = (const unsigned char*)(VTg + ((size_t)((b * 8 + 2 * hsel + 1) * 64)) * 4096); }
    else     { gb[2] = (const unsigned char*)(VTg + ((size_t)((b * 4 + hsel) * 128)) * 4096);         gb[3] = (const unsigned char*)(VTg + ((size_t)((b * 4 + hsel) * 128 + 64)) * 4096); }
    const u64* mgsrc = DSA ? (MASK + ((size_t)b * 64 * 4096 + q0) + 2 * lane) : nullptr;
    LAS unsigned char* const ring = F.lds + LDS_A + w * 1024;
    LAS unsigned char* const mring = F.lds + LDS_B + 12288;
#ifdef PROBE_DMA2
#define ATT_REP_ 2
#else
#define ATT_REP_ 1
#endif
#define ATT_ISSUE(TT, STG) do { const int tt_ = (TT) < 0 ? 0 : (TT); \
        _Pragma("unroll") for (int rr_ = 0; rr_ < ATT_REP_; ++rr_) _Pragma("unroll") for (int i_ = 0; i_ < 4; ++i_) __builtin_amdgcn_global_load_lds((const unsigned*)(gb[i_] + (i_ < 2 ? (size_t)tt_ * 8192 : (size_t)tt_ * 128) + (i_ < 2 ? koff : voff)), (LAS unsigned*)(ring + (STG) * 32768 + i_ * 8192), 16, 0, 0); \
        if (DSA && w == 0) __builtin_amdgcn_global_load_lds((const unsigned*)(mgsrc + (size_t)tt_ * 4096), (LAS unsigned*)(mring + (STG) * 1024), 16, 0, 0); } while (0)
    const int swz = (r32 >> 1) & 7;
    const int kbase = st * 8192 + r32 * 128, vbase = 16384 + ((DSA ? st * 64 : 0) + r32) * 128;
    f32x16 o[NDB];
#pragma unroll
    for (int i = 0; i < NDB; ++i)
#pragma unroll
        for (int r = 0; r < 16; ++r) o[i][r] = 0.f;
    float mref = -INFINITY, lsum = 0.f;
    ATT_ISSUE(nt - 1, 0); ATT_ISSUE(nt - 2, 1);
    for (int ip = 0; ip < nt / 2; ++ip) {
        asm volatile("s_waitcnt vmcnt(0)" ::: "memory");
        __builtin_amdgcn_s_barrier();
        asm volatile("" ::: "memory");
        if (ip > 0) {
            const u32x4 d0 = *(const LAS u32x4*)DN, d1 = *(const LAS u32x4*)(DN + 4);
            const int dm = min(min(min((int)d0.x, (int)d0.y), min((int)d0.z, (int)d0.w)), min(min((int)d1.x, (int)d1.y), min((int)d1.z, (int)d1.w)));
            if (dm >= nt - 1 - 2 * ip) break;
        }
        if (ip + 1 < nt / 2) { ATT_ISSUE(nt - 3 - 2 * ip, 2 * ((ip + 1) & 1)); ATT_ISSUE(nt - 4 - 2 * ip, 2 * ((ip + 1) & 1) + 1); }
#pragma unroll 1
        for (int sub = 0; sub < 2; ++sub) {
        const int t = nt - 1 - 2 * ip - sub, stg = 2 * (ip & 1) + sub;
        LAS unsigned char* sb = F.lds + LDS_A + stg * 32768;
        if (t <= mychunk && t > mydn) {
            bf16x8 pb[4];
            bf16x8 kf[8];
#pragma unroll
            for (int kb = 0; kb < 2; ++kb)
#pragma unroll
                for (int ks = 0; ks < 4; ++ks) kf[kb * 4 + ks] = *(const LAS bf16x8*)(sb + kbase + kb * 4096 + (((2 * ks + hh) ^ swz) << 4));
            const bool unset = (mref == -INFINITY);
            const float mr = unset ? 0.f : mref;
            const float relq = (float)(tq - 64 * t - 4 * hh);
            unsigned mlo = 0u, mhi = 0u;
            if (DSA) { const u64 mw = *(const LAS u64*)(mring + stg * 1024 + (32 * wq + r32) * 8) >> (4 * hh); mlo = (unsigned)mw; mhi = (unsigned)(mw >> 32); }
            f32x16 s[2];
            if (t == mychunk) {
#pragma unroll
                for (int kb = 0; kb < 2; ++kb)
#pragma unroll
                    for (int r = 0; r < 16; ++r) { const float c = (float)(32 * kb + (r & 3) + 8 * (r >> 2)); s[kb][r] = -SL * fabsf(relq - c) - mr; }
            } else {
                const float B0 = -SL * relq - mr, SL8 = 8.0f * SL;
                float gb_ = B0;
#pragma unroll
                for (int kb = 0; kb < 2; ++kb)
#pragma unroll
                    for (int g4 = 0; g4 < 4; ++g4) {
                        float e_ = gb_; s[kb][4 * g4] = e_;
#pragma unroll
                        for (int j = 1; j < 4; ++j) { e_ = fadd_s(e_, SL); s[kb][4 * g4 + j] = e_; }
                        gb_ = fadd_s(gb_, SL8);
                    }
            }
            if (DSA) {
#pragma unroll
                for (int kb = 0; kb < 2; ++kb)
#pragma unroll
                    for (int r = 0; r < 16; ++r) { const int tm = __builtin_amdgcn_sbfe((int)(kb ? mhi : mlo), (r & 3) + 8 * (r >> 2), 1);
                        const float sv = s[kb][r]; s[kb][r] = __int_as_float((__float_as_int(sv) & tm) | (~tm & (int)0xff800000)); }
            }
#pragma unroll
            for (int kb = 0; kb < 2; ++kb)
#pragma unroll
                for (int ks = 0; ks < 4; ++ks) s[kb] = __builtin_amdgcn_mfma_f32_32x32x16_bf16(kf[kb * 4 + ks], qf[ks], s[kb], 0, 0, 0);
            __builtin_amdgcn_sched_group_barrier(0x100, 4, 0);
#pragma unroll
            for (int i = 0; i < 4; ++i) { __builtin_amdgcn_sched_group_barrier(0x008, 1, 0); __builtin_amdgcn_sched_group_barrier(0x100, 1, 0); }
            __builtin_amdgcn_sched_group_barrier(0x008, 4, 0);
            float mx = -INFINITY;
#pragma unroll
            for (int kb = 0; kb < 2; ++kb)
#pragma unroll
                for (int r = 0; r < 16; ++r) mx = fmaxf(mx, s[kb][r]);
            mx = xhalf_max(mx);
            const bool need = unset ? (mx != -INFINITY) : (mx > THR);
            if (__any(need)) {
                const float delta = need ? mx : 0.f;
                const float scl = (unset || !need) ? 1.f : __builtin_amdgcn_exp2f(-delta);
#pragma unroll
                for (int kb = 0; kb < 2; ++kb)
#pragma unroll
                    for (int r = 0; r < 16; ++r) s[kb][r] -= delta;
#pragma unroll
                for (int i = 0; i < NDB; ++i)
#pragma unroll
                    for (int r = 0; r < 16; ++r) o[i][r] *= scl;
                lsum *= scl;
                mref = need ? (mr + delta) : mref;
            }
#pragma unroll
            for (int r = 0; r < 16; ++r) { s[0][r] = __builtin_amdgcn_exp2f(s[0][r]); s[1][r] = __builtin_amdgcn_exp2f(s[1][r]); }
            __builtin_amdgcn_sched_barrier(0);
            float ps0 = s[0][0], ps1 = s[1][0];
#pragma unroll
            for (int r = 1; r < 16; ++r) { ps0 = fadd_s(ps0, s[0][r]); ps1 = fadd_s(ps1, s[1][r]); }
            lsum += ps0 + ps1;
#pragma unroll
            for (int kb = 0; kb < 2; ++kb)
#pragma unroll
                for (int s2 = 0; s2 < 2; ++s2) {
                    u32x4 pk; pk.x = cvt_pk_bf16(s[kb][8 * s2 + 0], s[kb][8 * s2 + 1]); pk.y = cvt_pk_bf16(s[kb][8 * s2 + 2], s[kb][8 * s2 + 3]);
                    pk.z = cvt_pk_bf16(s[kb][8 * s2 + 4], s[kb][8 * s2 + 5]); pk.w = cvt_pk_bf16(s[kb][8 * s2 + 6], s[kb][8 * s2 + 7]);
                    pb[2 * kb + s2] = __builtin_bit_cast(bf16x8, pk);
                }
#pragma unroll
            for (int db = 0; db < NDB; ++db)
#pragma unroll
                for (int sg = 0; sg < 4; ++sg) {
                    const bf16x8 a = *(const LAS bf16x8*)(sb + vbase + db * 4096 + (((2 * sg + hh) ^ swz) << 4));
                    o[db] = __builtin_amdgcn_mfma_f32_32x32x16_bf16(a, pb[sg], o[db], 0, 0, 0);
                }
            __builtin_amdgcn_sched_group_barrier(0x100, 4, 1);
#pragma unroll
            for (int i = 0; i < 4 * NDB - 4; ++i) { __builtin_amdgcn_sched_group_barrier(0x008, 1, 1); __builtin_amdgcn_sched_group_barrier(0x100, 1, 1); }
            __builtin_amdgcn_sched_group_barrier(0x008, 4, 1);
            if (t > 0) {
                const float dmin = (float)(q0 + 32 * wq - 64 * t + 1);
                const bool okk = (mref != -INFINITY) && (BQK - SL * dmin - mref < -150.0f);
                if (__all(okk)) { mydn = t - 1; if (lane == 0) DN[w] = t - 1; }
            }
        }
        }
    }
    asm volatile("s_waitcnt vmcnt(0)" ::: "memory");
#undef ATT_ISSUE
    __syncthreads();
    lsum += __shfl_xor(lsum, 32);
    const float inv = 1.0f / lsum;
    const size_t tok = (size_t)b * 4096 + tq;
    if (DSA) {
#pragma unroll
        for (int db = 0; db < NDB; ++db)
#pragma unroll
            for (int g4 = 0; g4 < 4; g4 += 2) {
                const float z = inv;
                u32x2 pa, pb2;
                pa.x = cvt_pk_bf16(o[db][4 * g4 + 0] * z, o[db][4 * g4 + 1] * z); pa.y = cvt_pk_bf16(o[db][4 * g4 + 2] * z, o[db][4 * g4 + 3] * z);
                pb2.x = cvt_pk_bf16(o[db][4 * g4 + 4] * z, o[db][4 * g4 + 5] * z); pb2.y = cvt_pk_bf16(o[db][4 * g4 + 6] * z, o[db][4 * g4 + 7] * z);
                { auto r_ = __builtin_amdgcn_permlane32_swap(pa.x, pb2.x, false, false); pa.x = r_[0]; pb2.x = r_[1]; }
                { auto r_ = __builtin_amdgcn_permlane32_swap(pa.y, pb2.y, false, false); pa.y = r_[0]; pb2.y = r_[1]; }
                *(u32x4*)(MIX + tok * D + 512 + head * 64 + 32 * db + 8 * g4 + 8 * hh) = (u32x4){pa.x, pa.y, pb2.x, pb2.y}; }
    } else {
        LAS float* XB = (LAS float*)(F.lds + LDS_A);
        const int xq = (32 * wq + r32) * 132 + 4 * hh;
        if (st == 1) {
#pragma unroll
            for (int db = 0; db < NDB; ++db)
#pragma unroll
                for (int g4 = 0; g4 < 4; ++g4) *(LAS f32x4*)(XB + xq + 32 * db + 8 * g4) = (f32x4){o[db][4 * g4] * inv, o[db][4 * g4 + 1] * inv, o[db][4 * g4 + 2] * inv, o[db][4 * g4 + 3] * inv};
        }
        __syncthreads();
        if (st == 0) {
            float ss = 0.f;
#pragma unroll
            for (int db = 0; db < NDB; ++db)
#pragma unroll
                for (int g4 = 0; g4 < 4; ++g4) { const f32x4 o1 = *(const LAS f32x4*)(XB + xq + 32 * db + 8 * g4);
#pragma unroll
                    for (int j = 0; j < 4; ++j) { const float a = o[db][4 * g4 + j] * inv - o1[j] * lam; o[db][4 * g4 + j] = a; ss += a * a; } }
            ss += __shfl_xor(ss, 32);
            const float rn = (1.0f / sqrtf(ss * (1.0f / 128.0f) + LN_EPS)) * (1.0f - lam_init);
#pragma unroll
            for (int db = 0; db < NDB; ++db)
#pragma unroll
                for (int g4 = 0; g4 < 4; g4 += 2) { const f32x4 ga = *(const f32x4*)(subln_g + 32 * db + 8 * g4 + 4 * hh), gb = *(const f32x4*)(subln_g + 32 * db + 8 * g4 + 8 + 4 * hh);
                    u32x2 pa, pb2;
                    pa.x = cvt_pk_bf16(o[db][4 * g4 + 0] * rn * ga[0], o[db][4 * g4 + 1] * rn * ga[1]); pa.y = cvt_pk_bf16(o[db][4 * g4 + 2] * rn * ga[2], o[db][4 * g4 + 3] * rn * ga[3]);
                    pb2.x = cvt_pk_bf16(o[db][4 * g4 + 4] * rn * gb[0], o[db][4 * g4 + 5] * rn * gb[1]); pb2.y = cvt_pk_bf16(o[db][4 * g4 + 6] * rn * gb[2], o[db][4 * g4 + 7] * rn * gb[3]);
                    { auto r_ = __builtin_amdgcn_permlane32_swap(pa.x, pb2.x, false, false); pa.x = r_[0]; pb2.x = r_[1]; }
                    { auto r_ = __builtin_amdgcn_permlane32_swap(pa.y, pb2.y, false, false); pa.y = r_[0]; pb2.y = r_[1]; }
                    *(u32x4*)(MIX + tok * D + hsel * 128 + 32 * db + 8 * g4 + 8 * hh) = (u32x4){pa.x, pa.y, pb2.x, pb2.y}; }
        }
        __syncthreads();
    }
}
struct CandTab { unsigned char a[52], b[52]; };
__host__ __device__ constexpr CandTab make_cand_tab() {
    CandTab t{}; int n = 0;
    for (int a = 0; a < 16; ++a) for (int b = 0; b < 16; ++b) if ((a + 1) * (b + 1) <= 16) { t.a[n] = (unsigned char)a; t.b[n] = (unsigned char)b; ++n; }
    for (; n < 52; ++n) { t.a[n] = 0; t.b[n] = 0; }
    return t;
}
constexpr CandTab CAND = make_cand_tab();
constexpr int NCAND = 50;

#define PK_CEX(A, B) do { const unsigned hi_ = (A) > (B) ? (A) : (B), lo_ = (A) > (B) ? (B) : (A); (A) = hi_; (B) = lo_; } while (0)
__device__ __forceinline__ void pk_bitonic_merge16(unsigned (&x)[16]) {
#pragma unroll
    for (int j = 8; j >= 1; j >>= 1)
#pragma unroll
        for (int i = 0; i < 16; ++i) { const int l = i ^ j; if (l > i) PK_CEX(x[i], x[l]); }
}
__device__ __forceinline__ void pk_sort16(unsigned (&x)[16]) {
#pragma unroll
    for (int k = 2; k <= 16; k <<= 1)
#pragma unroll
        for (int j = k >> 1; j >= 1; j >>= 1)
#pragma unroll
            for (int i = 0; i < 16; ++i) { const int l = i ^ j; if (l > i) { if ((i & k) == 0) PK_CEX(x[i], x[l]); else PK_CEX(x[l], x[i]); } }
}
template <int XM>
__device__ __forceinline__ void pk_merge_lanes16(unsigned (&x)[16]) {
    unsigned y[16];
#pragma unroll
    for (int i = 0; i < 16; ++i) y[i] = (unsigned)__shfl_xor((int)x[15 - i], XM);
#pragma unroll
    for (int i = 0; i < 16; ++i) x[i] = x[i] > y[i] ? x[i] : y[i];
    pk_bitonic_merge16(x);
}
__device__ __forceinline__ void peer_topk_phase(const Frame& F, const bf16_t* __restrict__ PQ, const bf16_t* __restrict__ SUBK_l, int* __restrict__ EG) {
    const int lane = lane_id_fresh(), w = WAVE_FRESH(), tid = w * 64 + lane, fr = lane & 15, fq = lane >> 4;
    LAS unsigned char* sk = F.lds + LDS_A;
    LAS unsigned* LST = (LAS unsigned*)(F.lds + LDS_A + 65536) + w * 512;
#pragma unroll 1
    for (int lg = F.wg; lg < 256; lg += F.G) {
    const int pm = 16 * (lg & 7) + (lg >> 4), par = (lg >> 3) & 1;
#pragma unroll 1
    for (int hi = 0; hi < 4; ++hi) {
    const int h = par + 2 * hi;
    __syncthreads();
#pragma unroll
    for (int i = 0; i < 8; ++i) { const int id = tid + 512 * i, cs = id >> 11, row = (id >> 4) & 127, c16 = id & 15;
        const u32x4 v = *(const u32x4*)(SUBK_l + ((size_t)((h * 2 + cs) * 128 + row)) * 128 + c16 * 8);
        *(LAS u32x4*)(sk + cs * 32768 + row * 256 + ((c16 ^ (row & 15)) << 4)) = v; }
    __syncthreads();
    for (int it = 0; it < 2; ++it) {
        const int tt = 16 * pm + 2 * w + it, token = tt * 16 + fr;
#pragma unroll 1
        for (int cs = 0; cs < 2; ++cs) {
            bf16x8 qf[4];
#pragma unroll
            for (int ks = 0; ks < 4; ++ks) qf[ks] = *(const bf16x8*)(PQ + (size_t)(h >> 1) * PQ_PLANE + (size_t)token * 512 + (h & 1) * 256 + cs * 128 + 32 * ks + 8 * fq);
            unsigned x0[16], x1[16];
#pragma unroll
            for (int kt = 0; kt < 8; ++kt) {
                f32x4 sc = (f32x4){0.f, 0.f, 0.f, 0.f};
#pragma unroll
                for (int ks = 0; ks < 4; ++ks) { const int row = 16 * kt + fr, c16 = ks * 4 + fq;
                    const bf16x8 a = *(const LAS bf16x8*)(sk + cs * 32768 + row * 256 + ((c16 ^ (row & 15)) << 4));
                    sc = __builtin_amdgcn_mfma_f32_16x16x32_bf16(a, qf[ks], sc, 0, 0, 0); }
#pragma unroll
                for (int r = 0; r < 4; ++r) { const unsigned key = (f2sort(sc[r]) & ~127u) | (unsigned)(127 - (16 * kt + 4 * fq + r));
                    if (kt < 4) x0[kt * 4 + r] = key; else x1[(kt - 4) * 4 + r] = key; }
            }
            pk_sort16(x0); pk_sort16(x1);
#pragma unroll
            for (int i = 0; i < 16; ++i) x0[i] = x0[i] > x1[15 - i] ? x0[i] : x1[15 - i];
            pk_bitonic_merge16(x0);
            pk_merge_lanes16<16>(x0);
            pk_merge_lanes16<32>(x0);
            if (fq == 0) {
#pragma unroll
                for (int i = 0; i < 4; ++i) *(LAS u32x4*)(LST + cs * 256 + fr * 16 + 4 * i) = (u32x4){x0[4 * i], x0[4 * i + 1], x0[4 * i + 2], x0[4 * i + 3]};
            }
        }
        LDS_WAIT();
        unsigned win[16];
#pragma unroll
        for (int t = 0; t < 16; ++t) win[t] = 0u;
#pragma unroll
        for (int t = 0; t < 13; ++t) {
            const int a = fq == 0 ? CAND.a[t] : fq == 1 ? CAND.a[13 + t] : fq == 2 ? CAND.a[26 + t] : CAND.a[39 + t];
            const int bb = fq == 0 ? CAND.b[t] : fq == 1 ? CAND.b[13 + t] : fq == 2 ? CAND.b[26 + t] : CAND.b[39 + t];
            const unsigned k1 = LST[fr * 16 + a], k2 = LST[256 + fr * 16 + bb];
            const float cv = sort2f(k1 & ~127u) + sort2f(k2 & ~127u);
            const unsigned key = (f2sort(cv) & ~255u) | (unsigned)(255 - (a * 16 + bb));
            win[t] = (fq * 13 + t < NCAND) ? key : 0u;
        }
        pk_sort16(win);
        pk_merge_lanes16<16>(win);
        pk_merge_lanes16<32>(win);
        const float v0 = sort2f(win[0] & ~255u);
        float ev[16], es = 0.f;
#pragma unroll
        for (int k = 0; k < 16; ++k) { ev[k] = __expf(sort2f(win[k] & ~255u) - v0); es += ev[k]; }
        const float rs = 1.0f / es;
        int* egp = EG + ((size_t)token * 128 + h * 16) * 2;
#pragma unroll
        for (int k = 0; k < 16; ++k) {
            if ((k >> 2) == fq) {
                const unsigned flat = 255u - (win[k] & 255u), a = flat >> 4, bb = flat & 15u;
                const unsigned i1 = 127u - (LST[fr * 16 + a] & 127u), i2 = 127u - (LST[256 + fr * 16 + bb] & 127u);
                u32x2 e; e.x = i1 * 128u + i2; e.y = __float_as_uint(ev[k] * rs);
                *(u32x2*)(egp + 2 * k) = e;
            }
        }
        LDS_WAIT();
    }
    }
    }
    __syncthreads();
}

__device__ __forceinline__ float cvt_ubyte(unsigned x, int k) {
    float r;
    if (k == 0) asm("v_cvt_f32_ubyte0 %0, %1" : "=v"(r) : "v"(x));
    else if (k == 1) asm("v_cvt_f32_ubyte1 %0, %1" : "=v"(r) : "v"(x));
    else if (k == 2) asm("v_cvt_f32_ubyte2 %0, %1" : "=v"(r) : "v"(x));
    else asm("v_cvt_f32_ubyte3 %0, %1" : "=v"(r) : "v"(x));
    return r;
}
__device__ __forceinline__ void peer_gather_phase(const Frame& F, const bf16_t* __restrict__ H1, const int* __restrict__ EG, const unsigned char* __restrict__ U8, const unsigned char* __restrict__ V8,
                                                  const float* __restrict__ USC, const float* __restrict__ VSC, bf16_t* __restrict__ R2) {
    const int lane = lane_id_fresh(), w = WAVE_FRESH(), fr = lane & 15, fq = lane >> 4;
    LAS unsigned char* wl = F.lds + LDS_A + w * 12288;
    LAS float* WL16 = (LAS float*)(wl + 4096);
    LAS unsigned char* XS = wl; LAS float* WL = (LAS float*)(wl + 1024); LAS int* EL = (LAS int*)(wl + 1536); LAS float* USL = (LAS float*)(wl + 2048); LAS float* VSL = (LAS float*)(wl + 2560);
    for (int gwi = (F.G == 256 ? 256 * (F.wg & 7) + 8 * (F.wg >> 3) + w : F.wg * NWAVES + w); gwi < T / 16; gwi += (F.G == 256 ? T / 16 : F.G * NWAVES)) {
    for (int it = 0; it < 16; ++it) {
        const int token = gwi * 16 + it;
        const int* eg = EG + (size_t)token * 256;
        unsigned uoff[8];
#pragma unroll
        for (int hh = 0; hh < 8; ++hh) uoff[hh] = (unsigned)eg[(hh * 16 + fr) * 2] * 512u + 16u * fq;
        const int e0 = eg[lane * 2], e1 = eg[(64 + lane) * 2];
        const float us0 = USC[e0], us1 = USC[e1], vs0 = VSC[e0], vs1 = VSC[e1], g0 = __int_as_float(eg[lane * 2 + 1]), g1 = __int_as_float(eg[(64 + lane) * 2 + 1]);
        const u32x4 x0 = *(const u32x4*)(H1 + (size_t)token * D + 16 * lane), x1 = *(const u32x4*)(H1 + (size_t)token * D + 16 * lane + 8);
        float xf[16] = {bf_lo(x0.x), bf_hi(x0.x), bf_lo(x0.y), bf_hi(x0.y), bf_lo(x0.z), bf_hi(x0.z), bf_lo(x0.w), bf_hi(x0.w), bf_lo(x1.x), bf_hi(x1.x), bf_lo(x1.y), bf_hi(x1.y), bf_lo(x1.z), bf_hi(x1.z), bf_lo(x1.w), bf_hi(x1.w)};
        float am = 0.f;
#pragma unroll
        for (int i = 0; i < 16; ++i) am = fmaxf(am, fabsf(xf[i]));
        am = wave_max(am);
        const float xinv = am > 0.f ? am * (1.0f / 127.0f) : 1.0f, xsc = 1.0f / xinv;
        int xsum = 0;
        { unsigned xp[4] = {0u, 0u, 0u, 0u};
#pragma unroll
          for (int i = 0; i < 16; ++i) { int q = (int)rintf(xf[i] * xsc); q = q < -127 ? -127 : (q > 127 ? 127 : q); xsum += q; xp[i >> 2] |= ((unsigned)q & 0xffu) << (8 * (i & 3)); }
          *(LAS u32x4*)(XS + 16 * lane) = (u32x4){xp[0], xp[1], xp[2], xp[3]}; }
        xsum = wave_sum_i(xsum);
        LDS_WAIT();
        typedef int i32x4 __attribute__((ext_vector_type(4)));
        i32x4 acc[8];
#pragma unroll
        for (int hh = 0; hh < 8; ++hh) acc[hh] = (i32x4){0, 0, 0, 0};
#define U_LOAD(SET, P) do { _Pragma("unroll") for (int hh = 0; hh < 8; ++hh) SET[hh] = *(const u32x4*)(U8 + uoff[hh] + 64 * (P)); } while (0)
#define U_MMA(SET, P) do { const i32x4 xb0 = *(const LAS i32x4*)(XS + 128 * (P) + 32 * fq), xb1 = *(const LAS i32x4*)(XS + 128 * (P) + 32 * fq + 16); \
            _Pragma("unroll") for (int hh = 0; hh < 8; ++hh) { \
                const i32x4 a0 = (i32x4){(int)(SET[hh].x & 0x0f0f0f0fu), (int)(SET[hh].y & 0x0f0f0f0fu), (int)((SET[hh].x >> 4) & 0x0f0f0f0fu), (int)((SET[hh].y >> 4) & 0x0f0f0f0fu)}; \
                const i32x4 a1 = (i32x4){(int)(SET[hh].z & 0x0f0f0f0fu), (int)(SET[hh].w & 0x0f0f0f0fu), (int)((SET[hh].z >> 4) & 0x0f0f0f0fu), (int)((SET[hh].w >> 4) & 0x0f0f0f0fu)}; \
                acc[hh] = __builtin_amdgcn_mfma_i32_16x16x64_i8(a0, xb0, acc[hh], 0, 0, 0); \
                acc[hh] = __builtin_amdgcn_mfma_i32_16x16x64_i8(a1, xb1, acc[hh], 0, 0, 0); } } while (0)
        u32x4 ua[8], ub[8];
        U_LOAD(ua, 0); U_LOAD(ub, 1);
#pragma unroll 1
        for (int p = 0; p < 6; p += 2) {
            U_MMA(ua, p); U_LOAD(ua, p + 2);
            U_MMA(ub, p + 1); U_LOAD(ub, p + 3);
        }
        U_MMA(ua, 6); U_MMA(ub, 7);
#undef U_LOAD
#undef U_MMA
        LAS int* AL = (LAS int*)(wl + 1536);
        if (fr == 0) {
#pragma unroll
            for (int hh = 0; hh < 8; ++hh) *(LAS i32x4*)(AL + hh * 16 + 4 * fq) = acc[hh];
        }
        LDS_WAIT();
        { const float d0 = ((float)AL[lane] - 7.5f * (float)xsum) * us0 * xinv, d1 = ((float)AL[64 + lane] - 7.5f * (float)xsum) * us1 * xinv;
          WL16[it * 128 + lane] = g0 * (0.5f * d0 * (1.0f + erff(d0 * 0.70710678118654752f))) * vs0;
          WL16[it * 128 + 64 + lane] = g1 * (0.5f * d1 * (1.0f + erff(d1 * 0.70710678118654752f))) * vs1; }
        LDS_WAIT();
    }
    for (int it = 0; it < 16; ++it) {
        const int token = gwi * 16 + it;
        const int* eg = EG + (size_t)token * 256;
        const int e0 = eg[lane * 2], e1 = eg[(64 + lane) * 2];
        const u32x4 x0 = *(const u32x4*)(H1 + (size_t)token * D + 16 * lane), x1 = *(const u32x4*)(H1 + (size_t)token * D + 16 * lane + 8);
        const float xf[16] = {bf_lo(x0.x), bf_hi(x0.x), bf_lo(x0.y), bf_hi(x0.y), bf_lo(x0.z), bf_hi(x0.z), bf_lo(x0.w), bf_hi(x0.w), bf_lo(x1.x), bf_hi(x1.x), bf_lo(x1.y), bf_hi(x1.y), bf_lo(x1.z), bf_hi(x1.z), bf_lo(x1.w), bf_hi(x1.w)};
        LAS float* WL = WL16 + it * 128;
        f32x2 o2[8];
#pragma unroll
        for (int i = 0; i < 8; ++i) o2[i] = (f32x2){0.f, 0.f};
        const float wr0 = WL[lane], wr1 = WL[64 + lane];
        const unsigned vlane = 8u * (unsigned)lane;

#define V_LOAD(SET, EREG, S0) do { _Pragma("unroll") for (int i = 0; i < 16; ++i) { const unsigned e = (unsigned)__builtin_amdgcn_readlane(EREG, (S0) + i); \
            SET[i] = *(const u32x2*)(V8 + (size_t)e * 512u + vlane); } } while (0)
#define V_FMA(SET, WREG, S0) do { _Pragma("unroll") for (int i = 0; i < 16; ++i) { const float ws = __builtin_bit_cast(float, __builtin_amdgcn_readlane(__builtin_bit_cast(int, WREG), (S0) + i)); \
            asm volatile("" : "+v"(SET[i].x), "+v"(SET[i].y), "+v"(o2[0]), "+v"(o2[1]), "+v"(o2[2]), "+v"(o2[3]), "+v"(o2[4]), "+v"(o2[5]), "+v"(o2[6]), "+v"(o2[7])); \
            const f32x2 w2_ = (f32x2){ws, ws}; \
            o2[0] = w2_ * __builtin_amdgcn_cvt_scalef32_pk_f32_fp4(SET[i].x, 1.0f, 0) + o2[0]; o2[1] = w2_ * __builtin_amdgcn_cvt_scalef32_pk_f32_fp4(SET[i].x, 1.0f, 1) + o2[1]; \
            o2[2] = w2_ * __builtin_amdgcn_cvt_scalef32_pk_f32_fp4(SET[i].x, 1.0f, 2) + o2[2]; o2[3] = w2_ * __builtin_amdgcn_cvt_scalef32_pk_f32_fp4(SET[i].x, 1.0f, 3) + o2[3]; \
            o2[4] = w2_ * __builtin_amdgcn_cvt_scalef32_pk_f32_fp4(SET[i].y, 1.0f, 0) + o2[4]; o2[5] = w2_ * __builtin_amdgcn_cvt_scalef32_pk_f32_fp4(SET[i].y, 1.0f, 1) + o2[5]; \
            o2[6] = w2_ * __builtin_amdgcn_cvt_scalef32_pk_f32_fp4(SET[i].y, 1.0f, 2) + o2[6]; o2[7] = w2_ * __builtin_amdgcn_cvt_scalef32_pk_f32_fp4(SET[i].y, 1.0f, 3) + o2[7]; } } while (0)
        u32x2 va[16], vb2[16];
        V_LOAD(va, e0, 0); V_LOAD(vb2, e0, 16);
        V_FMA(va, wr0, 0); V_LOAD(va, e0, 32); V_FMA(vb2, wr0, 16); V_LOAD(vb2, e0, 48);
        V_FMA(va, wr0, 32); V_LOAD(va, e1, 0); V_FMA(vb2, wr0, 48); V_LOAD(vb2, e1, 16);
        V_FMA(va, wr1, 0); V_LOAD(va, e1, 32); V_FMA(vb2, wr1, 16); V_LOAD(vb2, e1, 48);
        V_FMA(va, wr1, 32); V_FMA(vb2, wr1, 48);
#undef V_LOAD
#undef V_FMA
        float out[16];
#pragma unroll
        for (int i = 0; i < 16; ++i) out[i] = o2[i >> 1][i & 1];
#ifdef PROBE_ZERO_PEER
#pragma unroll
        for (int i = 0; i < 16; ++i) out[i] = 0.f;
#endif
        u32x4 r0, r1;
        r0.x = cvt_pk_bf16(ALPHA * xf[0] + out[0], ALPHA * xf[1] + out[1]); r0.y = cvt_pk_bf16(ALPHA * xf[2] + out[2], ALPHA * xf[3] + out[3]);
        r0.z = cvt_pk_bf16(ALPHA * xf[4] + out[4], ALPHA * xf[5] + out[5]); r0.w = cvt_pk_bf16(ALPHA * xf[6] + out[6], ALPHA * xf[7] + out[7]);
        r1.x = cvt_pk_bf16(ALPHA * xf[8] + out[8], ALPHA * xf[9] + out[9]); r1.y = cvt_pk_bf16(ALPHA * xf[10] + out[10], ALPHA * xf[11] + out[11]);
        r1.z = cvt_pk_bf16(ALPHA * xf[12] + out[12], ALPHA * xf[13] + out[13]); r1.w = cvt_pk_bf16(ALPHA * xf[14] + out[14], ALPHA * xf[15] + out[15]);
        *(u32x4*)(R2 + (size_t)token * D + 16 * lane) = r0; *(u32x4*)(R2 + (size_t)token * D + 16 * lane + 8) = r1;
    }
    LDS_WAIT();
    }
}
struct AttnItems { unsigned short v[1024]; };
__host__ __device__ constexpr AttnItems make_attn_items() {
    AttnItems t{}; int n = 0;
    const int lim[4] = {11, 37, 64, 64};
    for (int c = 66; c >= 0; --c)
        for (int b = 0; b < 8; ++b) for (int h = 0; h < 4; ++h) for (int q = 0; q < 32; ++q) {
            int tiles = 2 * q + 2; if (tiles > lim[h]) tiles = lim[h];
            if (tiles + 2 == c) t.v[n++] = (unsigned short)((b << 7) | (h << 5) | q);
        }
    return t;
}
__device__ const AttnItems ATTN_ITEMS = make_attn_items();
struct AttnItems1 { unsigned char v[128]; };
__host__ __device__ constexpr AttnItems1 make_attn_items1() {
    AttnItems1 t{}; int n = 0;
    const int lim[4] = {11, 37, 64, 64};
    for (int c = 66; c >= 0; --c)
        for (int h = 0; h < 4; ++h) for (int q = 0; q < 32; ++q) {
            int tiles = 2 * q + 2; if (tiles > lim[h]) tiles = lim[h];
            if (tiles + 2 == c) t.v[n++] = (unsigned char)((h << 5) | q);
        }
    return t;
}
__device__ const AttnItems1 ATTN_ITEMS1 = make_attn_items1();
constexpr int PH_PER_LAYER = 10, N_PHASES = 1 + DEPTH * PH_PER_LAYER;
struct Args {
    const float *x, *p, *ln_in_g, *ln_in_b, *w_in, *w_out, *diff_lambda, *diff_subln_g, *ln1_g, *ln1_b, *peer_wq, *peer_subkeys, *peer_u, *peer_v, *ple_wg, *ple_bg, *ple_wp, *ln2_g, *ln2_b;
    float* out; unsigned char* ws; int ph_lo, ph_hi;
};
__global__ void __launch_bounds__(NTHREADS, 2) fwd_kernel(Args args) {
    extern __shared__ __attribute__((aligned(16))) unsigned char lds_raw[];
    Frame F;
    F.lds = (LAS unsigned char*)lds_raw;
    F.tid = threadIdx.x; F.lane = F.tid & 63; F.wave = __builtin_amdgcn_readfirstlane(F.tid >> 6);
    F.G = gridDim.x; F.wg = blockIdx.x; F.ws = args.ws;
    unsigned char* ws = args.ws;
    if (F.tid < 64) ((LAS unsigned*)(F.lds + LDS_CTL))[F.tid] = 0u;
    __syncthreads();
    const int lo = args.ph_lo, hi = args.ph_hi; (void)lo; (void)hi;
#ifndef PHASE_MASK
#define PHASE_MASK 0x7ff
#endif
#ifndef REPEAT_MASK
#define REPEAT_MASK 0
#endif
#define REP(k) (1 + ((REPEAT_MASK >> (k)) & 1))
#define IN(k) (lo <= (k) && (k) < hi)
#define BOTH(k) (IN(k) && IN((k) + 1))
#if MK_PER_PHASE
#define GRID_BAR(k) do { } while (0)
#define GRP_BAR(k) do { } while (0)
#define PAIR_BAR(k) do { } while (0)
#else
    XcdBarrier bar = xcd_barrier_post((unsigned*)(ws + WS_CTL) + 4096, (volatile LAS unsigned*)(F.lds + LDS_CTL));
    if (F.G == 256) group_post(bar, (unsigned)(F.wg & 7));
#define GRID_BAR(k) do { if (BOTH(k)) { unsigned z_ = 0u; asm volatile("" : "+s"(z_)); XcdBarrier b2_ = bar; b2_.bar = bar.bar + z_; asm volatile("" : "+s"(b2_.x)); xcd_barrier(b2_); } } while (0)
#define GRP_BAR(k) do { if (BOTH(k)) { unsigned z_ = 0u; asm volatile("" : "+s"(z_)); XcdBarrier b2_ = bar; b2_.bar = bar.bar + z_; asm volatile("" : "+s"(b2_.x)); \
        group_barrier(b2_, XB_GRP(F.G == 256 ? (unsigned)(F.wg & 7) : 0u), F.G == 256 ? 32u : (unsigned)F.G); } } while (0)
#define TILE_PM (16 * (F.wg & 7) + (F.wg >> 4))
#define TILE_PAR ((F.wg >> 3) & 1)
#define PAIR_BAR(k) do { if (BOTH(k)) { unsigned z_ = 0u; asm volatile("" : "+s"(z_)); XcdBarrier b2_ = bar; b2_.bar = bar.bar + z_; asm volatile("" : "+s"(b2_.x)); \
        if (F.G == 256) group_barrier(b2_, XB_PAIR((unsigned)(TILE_PM)), 2u, 4); else group_barrier(b2_, XB_GRP(0u), (unsigned)F.G); } } while (0)
#endif
    const int gw = F.wg * NWAVES + F.wave, NGW = F.G * NWAVES;
#define ROW_BASE (F.G == 256 ? 4096 * (F.wg & 7) + 8 * (F.wg >> 3) + F.wave : gw)
#define ROW_STRIDE (F.G == 256 ? 256 : NGW)
#define ROW_END (F.G == 256 ? 4096 * ((F.wg & 7) + 1) : T)
#define TROW_BASE (F.G == 256 ? 256 * (16 * (F.wg & 7) + (F.wg >> 4)) + 128 * ((F.wg >> 3) & 1) + F.wave : gw)
#define TROW_STRIDE (F.G == 256 ? 8 : NGW)
#define TROW_END (F.G == 256 ? 256 * (16 * (F.wg & 7) + (F.wg >> 4)) + 128 * ((F.wg >> 3) & 1) + 128 : T)
    typedef const __attribute__((address_space(4))) Args* kargs_t;
    const kargs_t kp0 = (kargs_t)__builtin_amdgcn_kernarg_segment_ptr();
#define PHASE_ARGS() kargs_t ap = kp0; asm volatile("" : "+s"(ap)); unsigned char* const wsl = ap->ws; (void)wsl
#define H ((bf16_t*)(wsl + WS_H))
#define H1 ((bf16_t*)(wsl + WS_H1))
#define MIX ((bf16_t*)(wsl + WS_MIX))
#define R2 ((bf16_t*)(wsl + WS_R2))
#define RF ((bf16_t*)(wsl + WS_RF))
#define DQ ((bf16_t*)(wsl + WS_DQ))
#define DK ((bf16_t*)(wsl + WS_DK))
#define DVT ((bf16_t*)(wsl + WS_DVT))
#define SQ ((bf16_t*)(wsl + WS_SQ))
#define SK ((bf16_t*)(wsl + WS_SK))
#define SVT ((bf16_t*)(wsl + WS_SVT))
#define IQ ((bf16_t*)(wsl + WS_IQ))
#define IK ((bf16_t*)(wsl + WS_IK))
#define IW ((float*)(wsl + WS_IW))
#define PQ ((bf16_t*)(wsl + WS_PQ))
#define EG ((int*)(wsl + WS_EG))
#define MASK ((u64*)(wsl + WS_MASK))
#define PP MIX

    if (((PHASE_MASK >> 0) & 1) && IN(0)) for (int rep_ = 0; rep_ < REP(0); ++rep_) {
        PHASE_ARGS();
        LAS float* scr = (LAS float*)(F.lds + LDS_A + F.wave * 8448);
        for (int l = 0; l < DEPTH; ++l) {
            const float* win = ap->w_in + (size_t)l * D * IN_COLS;
            bf16_t* WIN = (bf16_t*)(wsl + WS_WIN) + (size_t)l * NMAIN * D; bf16_t* WINV = (bf16_t*)(wsl + WS_WINV) + (size_t)l * NVV * D;
#define DO_SEG(sgi, W_, WT_, K_, ldn_, c0_, nvalid_, ncols_) do { const int nblk = (ncols_) / 32, items = ((K_) / 64) * nblk, rot = (l * 9 + (sgi)) * 397; \
                for (int it = (gw + rot) % NGW; it < items; it += NGW) transpose_item((W_), (K_), (ldn_), (c0_), (nvalid_), (WT_), scr, it / nblk, it % nblk, F.lane); } while (0)
            DO_SEG(0, win, WIN, D, IN_COLS, 0, 1024, 1024);
            DO_SEG(1, win, WIN + (size_t)1024 * D, D, IN_COLS, 1536, 1024, 1024);
            DO_SEG(2, win, WIN + (size_t)2048 * D, D, IN_COLS, 3072, 324, 512);
            DO_SEG(3, win, WINV, D, IN_COLS, 1024, 512, 512);
            DO_SEG(4, win, WINV + (size_t)512 * D, D, IN_COLS, 2560, 512, 512);
            DO_SEG(5, ap->w_out + (size_t)l * D * D, (bf16_t*)(wsl + WS_WOUT) + (size_t)l * D * D, D, D, 0, D, D);
            DO_SEG(6, ap->peer_wq + (size_t)l * D * 2048, (bf16_t*)(wsl + WS_WPQ) + (size_t)l * 2048 * D, D, 2048, 0, 2048, 2048);
            DO_SEG(7, ap->ple_wg + (size_t)l * D * D, (bf16_t*)(wsl + WS_WG) + (size_t)l * D * D, D, D, 0, D, D);
            DO_SEG(8, ap->ple_wp + (size_t)l * 256 * D, (bf16_t*)(wsl + WS_WP) + (size_t)l * D * 256, 256, D, 0, D, D);
#undef DO_SEG
        }
        const size_t gtid = (size_t)F.wg * NTHREADS + F.tid, gthreads = (size_t)F.G * NTHREADS;
        convert_rows_i4(ap->peer_u, ws + WS_U8, (float*)(wsl + WS_USC), DEPTH * 16384, gw, NGW, F.lane);
        convert_rows_fp4(ap->peer_v, ws + WS_V8, (float*)(wsl + WS_VSC), DEPTH * 16384, gw, NGW, F.lane);
        convert_f32_bf16(ap->p, (bf16_t*)(wsl + WS_P16), (size_t)DEPTH * T * 256, gtid, gthreads);
        convert_f32_bf16(ap->peer_subkeys, (bf16_t*)(wsl + WS_SUBK), (size_t)DEPTH * 8 * 2 * 128 * 128, gtid, gthreads);
        for (int m = ROW_BASE; m < ROW_END; m += ROW_STRIDE) ln_row(ap->x + (size_t)m * D, ap->ln_in_g, ap->ln_in_b, H + (size_t)m * D, nullptr, F.lane);
        __syncthreads();
    }
    GRID_BAR(0);
#if !MK_PER_PHASE
    if (F.G == 256 && BOTH(0)) group_resolve(bar, (unsigned)(F.wg & 7));
#endif

    for (int l = 0; l < DEPTH; ++l) {
        const int pb = 1 + PH_PER_LAYER * l;
        const float lam_init = 0.8f - 0.6f * expf(-0.3f * (float)l);
        if (((PHASE_MASK >> 1) & 1) && IN(pb + 0)) for (int rep_ = 0; rep_ < REP(1); ++rep_) { PHASE_ARGS();
            { pg8::Gemm g{H, (const bf16_t*)(wsl + WS_WIN) + (size_t)l * NMAIN * D, T, NMAIN, D}; pg8::StaticOrder S; S.init(T, NMAIN, F.G, F.wg);
              epi::Proj E{DQ, DK, SQ, SK, IQ, IK, IW};
              pg8::gemm_phase<epi::Proj, pg8::StaticOrder, true, true>(F.lds + LDS_A, g, S, E, WAVE_FRESH()); }
            { pg8::Gemm g{H, (const bf16_t*)(wsl + WS_WINV) + (size_t)l * NVV * D, T, NVV, D}; pg8::StaticOrder S; S.init(T, NVV, F.G, F.wg);
              epi::ProjV E{DVT, SVT};
              pg8::gemm_phase<epi::ProjV, pg8::StaticOrder, true, true>(F.lds + LDS_A, g, S, E, WAVE_FRESH()); }
        }
        GRP_BAR(pb + 0);
        if (((PHASE_MASK >> 2) & 1) && IN(pb + 1)) for (int rep_ = 0; rep_ < REP(2); ++rep_) { PHASE_ARGS();
            for (int g = F.wg; g < 256; g += F.G) {
                const int kb_ = g & 7, pr = g >> 3, h16 = pr >> 1, hf = pr & 1;
                const bf16_t* Kt = (h16 < 8 ? DK : SK) + ((size_t)((kb_ * 8 + (h16 & 7)) * 4096 + hf * 2048)) * 64;
                knorm_item(F, Kt, (float*)(wsl + WS_KN) + ((kb_ * 16 + h16) * 2 + hf));
            }
            for (int g = F.wg; g < 256; g += F.G) {
                const int b = g & 7, j = g >> 3;
#pragma unroll 1
                for (int k = 0; k < 2; ++k) select_item(F, b, k ? j : 63 - j, IQ, IK, IW, MASK);
            }
        }
        GRP_BAR(pb + 1);
        if (((PHASE_MASK >> 3) & 1) && IN(pb + 2)) for (int rep_ = 0; rep_ < REP(3); ++rep_) { PHASE_ARGS();
            LAS float* lamw = (LAS float*)(F.lds + LDS_B + 8192);
            if (F.wave == 0) {
                const float* lv = ap->diff_lambda + (size_t)l * 256; const int ln = lane_id_fresh();
                const float s01 = wave_sum(lv[ln] * lv[64 + ln]), s23 = wave_sum(lv[128 + ln] * lv[192 + ln]);
                if (ln == 0) lamw[0] = expf(s01) - expf(s23) + lam_init;
            }
            __syncthreads();
            const float lam = lamw[0];
            const float* sg = ap->diff_subln_g + (size_t)l * 128;
#ifdef ATTN_GLOBAL_DEAL
            for (int r = 0; r < 4; ++r) {
                for (int g = F.wg; g < 256; g += F.G) {
                    const int itm = ATTN_ITEMS.v[256 * r + ((r & 1) ? 255 - g : g)];
                    attn_item<false>(F, itm >> 7, (itm >> 5) & 3, itm & 31, DQ, DK, DVT, nullptr, MIX, lam, lam_init, sg, (const float*)(wsl + WS_KN));
                }
            }
            for (int r = 0; r < 4; ++r) {
                for (int g = F.wg; g < 256; g += F.G) {
                    const int itm = ATTN_ITEMS.v[256 * r + ((r & 1) ? 255 - g : g)];
                    attn_item<true>(F, itm >> 7, (itm >> 5) & 3, itm & 31, SQ, SK, SVT, MASK, MIX, 0.f, 0.f, nullptr, (const float*)(wsl + WS_KN));
                }
            }
#else
            for (int r = 0; r < 4; ++r) {
                for (int g = F.wg; g < 256; g += F.G) {
                    const int xb = g & 7, c = g >> 3, itm = ATTN_ITEMS1.v[32 * r + ((r & 1) ? 31 - c : c)];
                    attn_item<false>(F, xb, itm >> 5, itm & 31, DQ, DK, DVT, nullptr, MIX, lam, lam_init, sg, (const float*)(wsl + WS_KN));
                }
            }
            for (int r = 0; r < 4; ++r) {
                for (int g = F.wg; g < 256; g += F.G) {
                    const int xb = g & 7, c = g >> 3, itm = ATTN_ITEMS1.v[32 * r + ((r & 1) ? 31 - c : c)];
                    attn_item<true>(F, xb, itm >> 5, itm & 31, SQ, SK, SVT, MASK, MIX, 0.f, 0.f, nullptr, (const float*)(wsl + WS_KN));
                }
            }
#endif
        }
        GRP_BAR(pb + 2);
        if (((PHASE_MASK >> 4) & 1) && IN(pb + 3)) for (int rep_ = 0; rep_ < REP(4); ++rep_) { PHASE_ARGS();
            pg8::Gemm g{MIX, (const bf16_t*)(wsl + WS_WOUT) + (size_t)l * D * D, T, D, D}; pg8::StaticOrder S; if (F.G == 256) S.init_tile(D, TILE_PM, TILE_PAR); else S.init(T, D, F.G, F.wg);
            epi::OutRes E{H, RF};
            pg8::gemm_phase<epi::OutRes, pg8::StaticOrder, true, true>(F.lds + LDS_A, g, S, E, WAVE_FRESH());
        }
        PAIR_BAR(pb + 3);
        if (((PHASE_MASK >> 5) & 1) && IN(pb + 4)) for (int rep_ = 0; rep_ < REP(5); ++rep_) { PHASE_ARGS();
            ln_rows_bf(RF, ap->ln1_g + (size_t)l * D, ap->ln1_b + (size_t)l * D, H1, nullptr, TROW_BASE, TROW_STRIDE, TROW_END, lane_id_fresh());
        }
        PAIR_BAR(pb + 4);
        if (((PHASE_MASK >> 6) & 1) && IN(pb + 5)) for (int rep_ = 0; rep_ < REP(6); ++rep_) { PHASE_ARGS();
            pg8::Gemm g{H1, (const bf16_t*)(wsl + WS_WPQ) + (size_t)l * 2048 * D, T, 2048, D}; pg8::StaticOrder S; if (F.G == 256) S.init_tile(2048, TILE_PM, TILE_PAR); else S.init(T, 2048, F.G, F.wg);
            epi::PlainBf16 E{PQ, 512, 1, 1, (unsigned)PQ_PLANE};
            pg8::gemm_phase<epi::PlainBf16, pg8::StaticOrder, true, true>(F.lds + LDS_A, g, S, E, WAVE_FRESH());
        }
        PAIR_BAR(pb + 5);
        if (((PHASE_MASK >> 7) & 1) && IN(pb + 6)) for (int rep_ = 0; rep_ < REP(7); ++rep_) { PHASE_ARGS(); peer_topk_phase(F, PQ, (const bf16_t*)(wsl + WS_SUBK) + (size_t)l * 8 * 2 * 128 * 128, EG); }
        PAIR_BAR(pb + 6);
        if (((PHASE_MASK >> 8) & 1) && IN(pb + 7)) for (int rep_ = 0; rep_ < REP(8); ++rep_) { PHASE_ARGS(); peer_gather_phase(F, H1, EG, ws + WS_U8 + (size_t)l * 16384 * 512, ws + WS_V8 + (size_t)l * 16384 * 512, (const float*)(wsl + WS_USC) + (size_t)l * 16384, (const float*)(wsl + WS_VSC) + (size_t)l * 16384, R2); }
        PAIR_BAR(pb + 7);
        if (((PHASE_MASK >> 9) & 1) && IN(pb + 8)) for (int rep_ = 0; rep_ < REP(9); ++rep_) { PHASE_ARGS();
            { pg8::Gemm g{(const bf16_t*)(wsl + WS_P16) + (size_t)l * T * 256, (const bf16_t*)(wsl + WS_WP) + (size_t)l * D * 256, T, D, 256}; pg8::StaticOrder S; if (F.G == 256) S.init_tile(D, TILE_PM, TILE_PAR); else S.init(T, D, F.G, F.wg);
              epi::PlainBf16 E{PP, D, 8, 255, 0u};
              pg8::gemm_phase<epi::PlainBf16, pg8::StaticOrder, true, true>(F.lds + LDS_A, g, S, E, WAVE_FRESH()); }
            VM_WAIT(); __syncthreads();
            { pg8::Gemm g{R2, (const bf16_t*)(wsl + WS_WG) + (size_t)l * D * D, T, D, D}; pg8::StaticOrder S; if (F.G == 256) S.init_tile(D, TILE_PM, TILE_PAR); else S.init(T, D, F.G, F.wg);
              epi::Gate E{R2, PP, ap->ple_bg + (size_t)l * D, RF};
              pg8::gemm_phase<epi::Gate, pg8::StaticOrder, true, true>(F.lds + LDS_A, g, S, E, WAVE_FRESH()); }
        }
        PAIR_BAR(pb + 8);
        if (((PHASE_MASK >> 10) & 1) && IN(pb + 9)) for (int rep_ = 0; rep_ < REP(10); ++rep_) { PHASE_ARGS();
            const bool last = (l == DEPTH - 1);
            ln_rows_bf(RF, ap->ln2_g + (size_t)l * D, ap->ln2_b + (size_t)l * D, last ? nullptr : H, last ? ap->out : nullptr, TROW_BASE, TROW_STRIDE, TROW_END, lane_id_fresh());
        }
        if (l + 1 < DEPTH) GRP_BAR(pb + 9);
    }
#undef IN
#undef BOTH
#undef H
#undef H1
#undef MIX
#undef R2
#undef RF
#undef DQ
#undef DK
#undef DVT
#undef SQ
#undef SK
#undef SVT
#undef IQ
#undef IK
#undef IW
#undef PQ
#undef EG
#undef MASK
#undef PP
}

extern "C" void kernel_launch(void* const* d_in, const int* in_sizes, int n_in, void* d_out, int out_size, void* d_ws, size_t ws_size, hipStream_t stream) {
    static int grid = 0;
    if (grid == 0) {
        if (n_in != 19 || in_sizes[0] != T * D || out_size != T * D || ws_size < WS_END) {
            fprintf(stderr, "kernel_launch: unexpected problem: n_in %d in0 %d out %d ws %zu (need %zu); nothing launched\n", n_in, n_in > 0 ? in_sizes[0] : -1, out_size, ws_size, (size_t)WS_END); grid = -1; return; }
        int dev = 0, cus = 0, per_cu = 0;
        if (hipGetDevice(&dev) != hipSuccess || hipDeviceGetAttribute(&cus, hipDeviceAttributeMultiprocessorCount, dev) != hipSuccess) { fprintf(stderr, "kernel_launch: device query failed\n"); grid = -1; return; }
        if (hipFuncSetAttribute((const void*)fwd_kernel, hipFuncAttributeMaxDynamicSharedMemorySize, LDS_BYTES) != hipSuccess) { fprintf(stderr, "kernel_launch: hipFuncSetAttribute failed\n"); grid = -1; return; }
        if (hipOccupancyMaxActiveBlocksPerMultiprocessor(&per_cu, (const void*)fwd_kernel, NTHREADS, LDS_BYTES) != hipSuccess || per_cu < 1) { fprintf(stderr, "kernel_launch: occupancy query says %d blocks per CU\n", per_cu); }
        (void)hipGetLastError();
        grid = cus < 256 ? cus : 256;
    }
    if (grid < 0) return;
    if (hipMemsetAsync((char*)d_ws + WS_CTL, 0, CTL_ZERO_BYTES, stream) != hipSuccess) { fprintf(stderr, "kernel_launch: memset failed\n"); return; }
    Args a{};
    a.x = (const float*)d_in[0]; a.p = (const float*)d_in[1]; a.ln_in_g = (const float*)d_in[2]; a.ln_in_b = (const float*)d_in[3]; a.w_in = (const float*)d_in[4]; a.w_out = (const float*)d_in[5];
    a.diff_lambda = (const float*)d_in[6]; a.diff_subln_g = (const float*)d_in[7]; a.ln1_g = (const float*)d_in[8]; a.ln1_b = (const float*)d_in[9]; a.peer_wq = (const float*)d_in[10];
    a.peer_subkeys = (const float*)d_in[11]; a.peer_u = (const float*)d_in[12]; a.peer_v = (const float*)d_in[13]; a.ple_wg = (const float*)d_in[14]; a.ple_bg = (const float*)d_in[15];
    a.ple_wp = (const float*)d_in[16]; a.ln2_g = (const float*)d_in[17]; a.ln2_b = (const float*)d_in[18];
    a.out = (float*)d_out; a.ws = (unsigned char*)d_ws;
#if MK_PER_PHASE
    for (int ph = 0; ph < N_PHASES; ++ph) { a.ph_lo = ph; a.ph_hi = ph + 1; hipLaunchKernelGGL(fwd_kernel, dim3(grid), dim3(NTHREADS), LDS_BYTES, stream, a); }
#else
    a.ph_lo = 0; a.ph_hi = N_PHASES;
    hipLaunchKernelGGL(fwd_kernel, dim3(grid), dim3(NTHREADS), LDS_BYTES, stream, a);
#endif
    const hipError_t le = hipPeekAtLastError();
    if (le != hipSuccess) fprintf(stderr, "kernel_launch: launch failed: %s\n", hipGetErrorName(le));
}
```

```cpp
#include <hip/hip_runtime.h>
#include <cstdio>
#include <cstdint>
#include <cmath>

#ifndef MK_PER_PHASE
#define MK_PER_PHASE 0
#endif

#define LAS __attribute__((address_space(3)))
typedef unsigned short bf16_t;
typedef short bf16x8 __attribute__((ext_vector_type(8)));
typedef float f32x4 __attribute__((ext_vector_type(4)));
typedef float f32x2 __attribute__((ext_vector_type(2)));
typedef unsigned u32x4 __attribute__((ext_vector_type(4)));
typedef unsigned u32x2 __attribute__((ext_vector_type(2)));
typedef unsigned long long u64;

constexpr int D = 1024, BATCH = 8, SEQ = 4096, DEPTH = 4, T = BATCH * SEQ;
constexpr int IN_COLS = 3396;
constexpr int NMAIN = 2560;
constexpr int NVV = 1024;
constexpr int NWAVES = 8, NTHREADS = 512;
constexpr float LN_EPS = 1e-5f;
constexpr float ALPHA = 1.6817928305074290f;
constexpr float LOG2E = 1.4426950408889634f;

constexpr size_t MiB = 1u << 20;
constexpr size_t WS_CTL = 0, CTL_ZERO_BYTES = 1 * MiB;
constexpr size_t WS_WIN = 1 * MiB;
constexpr size_t WS_WINV = 21 * MiB;
constexpr size_t WS_WOUT = 29 * MiB;
constexpr size_t WS_WPQ = 37 * MiB;
constexpr size_t WS_WG = 53 * MiB;
constexpr size_t WS_WP = 61 * MiB;
constexpr size_t WS_SUBK = 63 * MiB;
constexpr size_t WS_U8 = 65 * MiB;
constexpr size_t WS_V8 = 129 * MiB;
constexpr size_t WS_USC = 193 * MiB;
constexpr size_t WS_VSC = 194 * MiB;
constexpr size_t WS_KN = 195 * MiB;
constexpr size_t WS_P16 = 321 * MiB;
constexpr size_t WS_H = 385 * MiB;
constexpr size_t WS_H1 = 449 * MiB;
constexpr size_t WS_MIX = 513 * MiB;
constexpr size_t WS_R2 = 577 * MiB;
constexpr size_t WS_RF = 641 * MiB;
constexpr size_t WS_PROJ = 769 * MiB;
constexpr size_t WS_DQ = WS_PROJ + 0 * MiB, WS_DK = WS_PROJ + 32 * MiB, WS_DVT = WS_PROJ + 64 * MiB, WS_SQ = WS_PROJ + 96 * MiB, WS_SK = WS_PROJ + 128 * MiB,
                 WS_SVT = WS_PROJ + 160 * MiB, WS_IQ = WS_PROJ + 192 * MiB, WS_IK = WS_PROJ + 208 * MiB, WS_IW = WS_PROJ + 212 * MiB;
constexpr size_t WS_PQ = WS_PROJ;
constexpr size_t PQ_PLANE = 32 * MiB / 2;
constexpr size_t WS_EG = WS_PROJ + 128 * MiB;
constexpr size_t WS_MASK = 993 * MiB;
constexpr size_t WS_END = 1009 * MiB;

constexpr int LDS_A = 0;
constexpr int LDS_B = 131072;
constexpr int LDS_CTL = 153600;
constexpr int LDS_BYTES = 155648;

typedef __bf16 bf16x2_t __attribute__((ext_vector_type(2)));
__device__ __forceinline__ unsigned cvt_pk_bf16(float lo, float hi) { const f32x2 v_ = (f32x2){lo, hi}; const bf16x2_t b_ = __builtin_convertvector(v_, bf16x2_t); return __builtin_bit_cast(unsigned, b_); }
__device__ __forceinline__ float bf_lo(unsigned w) { return __uint_as_float(w << 16); }
__device__ __forceinline__ float bf_hi(unsigned w) { return __uint_as_float(w & 0xffff0000u); }
template <int CTRL, int RM, int BM> __device__ __forceinline__ float dpp_f(float old, float v) { return __int_as_float(__builtin_amdgcn_update_dpp(__float_as_int(old), __float_as_int(v), CTRL, RM, BM, false)); }
template <int CTRL, int RM, int BM> __device__ __forceinline__ unsigned dpp_u(unsigned old, unsigned v) { return (unsigned)__builtin_amdgcn_update_dpp((int)old, (int)v, CTRL, RM, BM, false); }
__device__ __forceinline__ float lane_f(float v, int l) { return __int_as_float(__builtin_amdgcn_readlane(__float_as_int(v), l)); }
__device__ __forceinline__ float wave_sum(float v) {
    v += dpp_f<0xB1, 0xf, 0xf>(v, v); v += dpp_f<0x4E, 0xf, 0xf>(v, v); v += dpp_f<0x141, 0xf, 0xf>(v, v); v += dpp_f<0x140, 0xf, 0xf>(v, v);
    return (lane_f(v, 0) + lane_f(v, 16)) + (lane_f(v, 32) + lane_f(v, 48));
}
__device__ __forceinline__ float wave_max(float v) {
    v = fmaxf(v, dpp_f<0xB1, 0xf, 0xf>(v, v)); v = fmaxf(v, dpp_f<0x4E, 0xf, 0xf>(v, v)); v = fmaxf(v, dpp_f<0x141, 0xf, 0xf>(v, v)); v = fmaxf(v, dpp_f<0x140, 0xf, 0xf>(v, v));
    return fmaxf(fmaxf(lane_f(v, 0), lane_f(v, 16)), fmaxf(lane_f(v, 32), lane_f(v, 48)));
}
__device__ __forceinline__ unsigned wave_prefix_sum(unsigned x) {
    unsigned p = x;
    p += dpp_u<0x111, 0xf, 0xf>(0u, p); p += dpp_u<0x112, 0xf, 0xf>(0u, p); p += dpp_u<0x114, 0xf, 0xf>(0u, p); p += dpp_u<0x118, 0xf, 0xf>(0u, p);
    p += dpp_u<0x142, 0xa, 0xf>(0u, p); p += dpp_u<0x143, 0xc, 0xf>(0u, p);
    return p;
}
__device__ __forceinline__ int wave_sum_i(int v) {
    v += __builtin_amdgcn_update_dpp(v, v, 0xB1, 0xf, 0xf, false); v += __builtin_amdgcn_update_dpp(v, v, 0x4E, 0xf, 0xf, false);
    v += __builtin_amdgcn_update_dpp(v, v, 0x141, 0xf, 0xf, false); v += __builtin_amdgcn_update_dpp(v, v, 0x140, 0xf, 0xf, false);
    return (__builtin_amdgcn_readlane(v, 0) + __builtin_amdgcn_readlane(v, 16)) + (__builtin_amdgcn_readlane(v, 32) + __builtin_amdgcn_readlane(v, 48));
}
__device__ __forceinline__ float xhalf_max(float v) { auto r_ = __builtin_amdgcn_permlane32_swap(__float_as_uint(v), __float_as_uint(v), false, false); return fmaxf(__uint_as_float(r_[0]), __uint_as_float(r_[1])); }
__device__ __forceinline__ unsigned f2sort(float f) { const unsigned u = __float_as_uint(f); return (u & 0x80000000u) ? ~u : (u | 0x80000000u); }
__device__ __forceinline__ float sort2f(unsigned s) { const unsigned u = (s & 0x80000000u) ? (s & 0x7fffffffu) : ~s; return __uint_as_float(u); }
__device__ __forceinline__ int lane_id_fresh() { int l; asm volatile("v_mbcnt_lo_u32_b32 %0, -1, 0\n\tv_mbcnt_hi_u32_b32 %0, -1, %0" : "=v"(l)); return l; }
#define WAVE_FRESH() ({ int w_ = F.wave; asm volatile("" : "+s"(w_)); w_; })
#define LDS_WAIT() asm volatile("s_waitcnt lgkmcnt(0)" ::: "memory")
#define VM_WAIT() asm volatile("s_waitcnt vmcnt(0)" ::: "memory")
namespace pg8 {
#define PG8_LAS __attribute__((address_space(3)))
constexpr int BM = 256, BK = 64, HALF = 128, HTB = HALF * BK * 2  , STAGE_BYTES = 8 * HTB, NXCD = 8, WGM = 8;

__host__ __device__ __forceinline__ int lds_byte(int r, int c) { const int st = (r >> 4) * 2 + (c >> 5), rr = r & 15, cc = c & 31, ob = rr * 64 + cc * 2; return st * 1024 + (ob ^ (((ob >> 9) & 1) << 5)); }
__host__ __device__ __forceinline__ void stage_rc(int b, int& R, int& C) { const int st = b / 1024, sb = b % 1024, swz = sb ^ (((sb >> 9) & 1) << 5); R = (st >> 1) * 16 + swz / 64; C = (st & 1) * 32 + (swz % 64) / 2; }
__host__ __device__ __forceinline__ int perm32(int rho) { const int n = rho >> 4, i = rho & 15; return 8 * (i >> 2) + 4 * n + (i & 3); }

struct Unit { int pm, pn; };
struct Gemm { const bf16_t* A; const bf16_t* Bt; int M, N, K; };

struct StaticOrder {
    int nM, nN, nwg, G, c, tile;
    __host__ __device__ void init(int M, int N, int G_, int c_) { nM = M / BM; nN = N / BM; nwg = nM * nN; G = G_; c = c_; tile = -1; }
    __host__ __device__ void init_tile(int N, int tile_, int par) { nM = 0; nN = N / BM; nwg = 0; G = 0; c = par; tile = tile_; }
    __host__ __device__ bool next(int i, Unit& u) const {
        if (tile >= 0) { const int pn = c + 2 * i; if (pn >= nN) return false; u.pm = tile; u.pn = pn; return true; }
        const long L = (long)i * G + c; if (L >= nwg) return false;
        int wgid = (int)L; { const int q = nwg / NXCD, r = nwg % NXCD, xcd = wgid % NXCD, off = wgid / NXCD; wgid = (xcd < r ? xcd * (q + 1) : r * (q + 1) + (xcd - r) * q) + off; }
        const int nig = WGM * nN, gid = wgid / nig, fm = gid * WGM, gsz = (nM - fm) < WGM ? (nM - fm) : WGM;
        u.pm = fm + ((wgid % nig) % gsz); u.pn = (wgid % nig) / gsz; return true;
    }
    __device__ __forceinline__ void a_ready(const Unit&) const {}
    __device__ __forceinline__ void done(const Unit&) const {}
};

template <class Epi, class Sched, bool ALIGN_EPI = false, bool SP2 = false>
__device__ __forceinline__ void gemm_phase(PG8_LAS unsigned char* lds, const Gemm g, const Sched& S, const Epi& E, int wave_id) {
    const int lane = lane_id_fresh(), wid = wave_id, tid = wid * 64 + lane,
              wr = wid >> 2, wc = wid & 3, fr = lane & 15, fq = lane >> 4;
    const int K = g.K, nt = K / BK;
    unsigned voffA[2], voffB[2];
#pragma unroll
    for (int i = 0; i < 2; ++i) { int R, C; stage_rc(tid * 16 + i * 8192, R, C); const int Rb = Epi::PERM ? ((R & ~31) + perm32(R & 31)) : R;
        voffA[i] = (unsigned)(R * K + C) * 2u; voffB[i] = (unsigned)(Rb * K + C) * 2u; }
    const size_t kstep = (size_t)(BK * 2);
    const size_t hstep = (size_t)HALF * K * 2;
    const size_t tstep = 2 * hstep;
    const unsigned ldsw = (unsigned)wid * 1024u;
    const int aoff = lds_byte(wr * 64 + fr, fq * 8), boff = lds_byte(wc * 32 + fr, fq * 8);
#define PG8_SA(b, h) (((b) * 2 + (h)) * HTB)
#define PG8_SB(b, h) ((4 + (b) * 2 + (h)) * HTB)
#define PG8_STAGE(bufoff, gbase, voff) do { _Pragma("unroll") for (int _i = 0; _i < 2; ++_i) \
        __builtin_amdgcn_global_load_lds((const unsigned*)((const char*)(gbase) + (voff)[_i]), (PG8_LAS unsigned*)(lds + (bufoff) + ldsw + _i * 8192), 16, 0, 0); } while (0)
#define PG8_LDA(dst, b, h) do { _Pragma("unroll") for (int m = 0; m < 4; ++m) _Pragma("unroll") for (int k = 0; k < 2; ++k) dst[m][k] = *(const PG8_LAS bf16x8*)(lds + PG8_SA(b, h) + aoff + m * 2048 + k * 1024); } while (0)
#define PG8_LDB(dst, b, h) do { _Pragma("unroll") for (int n = 0; n < 2; ++n) _Pragma("unroll") for (int k = 0; k < 2; ++k) dst[n][k] = *(const PG8_LAS bf16x8*)(lds + PG8_SB(b, h) + boff + n * 2048 + k * 1024); } while (0)
#define PG8_MMA(ai, bj, At, Bt) do { __builtin_amdgcn_s_setprio(1); _Pragma("unroll") for (int m = 0; m < 4; ++m) _Pragma("unroll") for (int n = 0; n < 2; ++n) _Pragma("unroll") for (int k = 0; k < 2; ++k) \
        acc[ai][bj][m][n] = Epi::SWAP ? __builtin_amdgcn_mfma_f32_16x16x32_bf16(At[m][k], Bt[n][k], acc[ai][bj][m][n], 0, 0, 0) : __builtin_amdgcn_mfma_f32_16x16x32_bf16(Bt[n][k], At[m][k], acc[ai][bj][m][n], 0, 0, 0); __builtin_amdgcn_s_setprio(0); } while (0)
#define PG8_WAIT_V(n) asm volatile("s_waitcnt vmcnt(" #n ")" ::: "memory")
#define PG8_WAIT_L(n) asm volatile("s_waitcnt lgkmcnt(" #n ")" ::: "memory")
#define PG8_BAR __builtin_amdgcn_s_barrier()
#define PG8_SCHED __builtin_amdgcn_sched_barrier(0)
    Unit cur, nxt; int ui = 0;
    if (!S.next(0, cur)) return;
    f32x4 acc[2][2][4][2];
#pragma unroll
    for (int a = 0; a < 2; ++a)
#pragma unroll
        for (int b = 0; b < 2; ++b)
#pragma unroll
            for (int m = 0; m < 4; ++m)
#pragma unroll
                for (int n = 0; n < 2; ++n) acc[a][b][m][n] = (f32x4){0.f, 0.f, 0.f, 0.f};
    bf16x8 At[4][2], B0[2][2], B1[2][2];
    const char* cA = (const char*)g.A + (size_t)cur.pm * tstep; const char* cB = (const char*)g.Bt + (size_t)cur.pn * tstep;
    S.a_ready(cur);
    if constexpr (SP2) {
        PG8_STAGE(PG8_SB(0, 0), cB, voffB); PG8_STAGE(PG8_SB(0, 1), cB + hstep, voffB); PG8_STAGE(PG8_SA(0, 0), cA, voffA); PG8_STAGE(PG8_SA(0, 1), cA + hstep, voffA);
        if (wr == 1) PG8_BAR;
        PG8_WAIT_V(2); PG8_BAR;
        PG8_STAGE(PG8_SB(1, 0), cB + kstep, voffB); PG8_STAGE(PG8_SA(1, 0), cA + kstep, voffA); PG8_STAGE(PG8_SB(1, 1), cB + hstep + kstep, voffB);
        PG8_WAIT_V(6); PG8_BAR;
    } else {
        PG8_STAGE(PG8_SB(0, 0), cB, voffB); PG8_STAGE(PG8_SA(0, 0), cA, voffA); PG8_STAGE(PG8_SB(0, 1), cB + hstep, voffB); PG8_STAGE(PG8_SA(0, 1), cA + hstep, voffA);
        if (wr == 1) PG8_BAR;
        PG8_WAIT_V(4); PG8_BAR;
        PG8_STAGE(PG8_SB(1, 0), cB + kstep, voffB); PG8_STAGE(PG8_SA(1, 0), cA + kstep, voffA); PG8_STAGE(PG8_SB(1, 1), cB + hstep + kstep, voffB);
        PG8_WAIT_V(6); PG8_BAR;
    }
    for (;;) {
        const bool has_next = S.next(ui + 1, nxt);
        const char* nA = has_next ? (const char*)g.A + (size_t)nxt.pm * tstep : cA; const char* nB = has_next ? (const char*)g.Bt + (size_t)nxt.pn * tstep : cB;
        for (int t = 0; t < nt; t += 2) {
            const bool last = (t == nt - 2);
            const char* a1 = cA + (size_t)(t + 1) * kstep;
            const char* a2 = last ? nA : cA + (size_t)(t + 2) * kstep; const char* b2 = last ? nB : cB + (size_t)(t + 2) * kstep;
            const char* a3 = a2 + kstep; const char* b3 = b2 + kstep;
            if (last && has_next) S.a_ready(nxt);
            if constexpr (SP2) {
            PG8_LDB(B0, 0, 0); PG8_LDB(B1, 0, 1); PG8_SCHED; PG8_LDA(At, 0, 0); PG8_STAGE(PG8_SA(1, 1), a1 + hstep, voffA);
            PG8_WAIT_V(8); PG8_WAIT_L(0); PG8_BAR; PG8_MMA(0, 0, At, B0); PG8_MMA(0, 1, At, B1); PG8_BAR; PG8_SCHED;
            PG8_LDA(At, 0, 1); PG8_STAGE(PG8_SB(0, 0), b2, voffB); PG8_STAGE(PG8_SB(0, 1), b2 + hstep, voffB); PG8_STAGE(PG8_SA(0, 0), a2, voffA);
            PG8_WAIT_V(8); PG8_WAIT_L(0); PG8_BAR; PG8_MMA(1, 0, At, B0); PG8_MMA(1, 1, At, B1); PG8_BAR; PG8_SCHED;
            PG8_LDB(B0, 1, 0); PG8_LDB(B1, 1, 1); PG8_SCHED; PG8_LDA(At, 1, 0); PG8_STAGE(PG8_SA(0, 1), a2 + hstep, voffA);
            PG8_WAIT_V(8); PG8_WAIT_L(0); PG8_BAR; PG8_MMA(0, 0, At, B0); PG8_MMA(0, 1, At, B1); PG8_BAR; PG8_SCHED;
            PG8_LDA(At, 1, 1); PG8_STAGE(PG8_SB(1, 0), b3, voffB); PG8_STAGE(PG8_SB(1, 1), b3 + hstep, voffB); PG8_STAGE(PG8_SA(1, 0), a3, voffA);
            PG8_WAIT_V(8); PG8_WAIT_L(0); PG8_BAR; PG8_MMA(1, 0, At, B0); PG8_MMA(1, 1, At, B1); PG8_BAR; PG8_SCHED;
            } else {
            PG8_LDB(B0, 0, 0); PG8_SCHED; PG8_LDA(At, 0, 0); PG8_STAGE(PG8_SA(1, 1), a1 + hstep, voffA);
            PG8_WAIT_L(8); PG8_BAR; PG8_WAIT_L(0); PG8_MMA(0, 0, At, B0); PG8_BAR; PG8_SCHED;
            PG8_LDB(B1, 0, 1); PG8_STAGE(PG8_SB(0, 0), b2, voffB);
            PG8_BAR; PG8_WAIT_L(0); PG8_MMA(0, 1, At, B1); PG8_BAR;
            PG8_LDA(At, 0, 1); PG8_STAGE(PG8_SA(0, 0), a2, voffA);
            PG8_BAR; PG8_WAIT_L(0); PG8_MMA(1, 0, At, B0); PG8_BAR; PG8_SCHED;
            PG8_STAGE(PG8_SB(0, 1), b2 + hstep, voffB);
            PG8_WAIT_V(6); PG8_BAR; PG8_MMA(1, 1, At, B1); PG8_BAR;
            PG8_LDB(B0, 1, 0); PG8_SCHED; PG8_LDA(At, 1, 0); PG8_STAGE(PG8_SA(0, 1), a2 + hstep, voffA);
            PG8_WAIT_L(8); PG8_BAR; PG8_WAIT_L(0); PG8_MMA(0, 0, At, B0); PG8_BAR; PG8_SCHED;
            PG8_LDB(B1, 1, 1); PG8_STAGE(PG8_SB(1, 0), b3, voffB);
            PG8_BAR; PG8_WAIT_L(0); PG8_MMA(0, 1, At, B1); PG8_BAR;
            PG8_LDA(At, 1, 1); PG8_STAGE(PG8_SA(1, 0), a3, voffA);
            PG8_BAR; PG8_WAIT_L(0); PG8_MMA(1, 0, At, B0); PG8_BAR; PG8_SCHED;
            PG8_STAGE(PG8_SB(1, 1), b3 + hstep, voffB);
            PG8_WAIT_V(6); PG8_BAR; PG8_MMA(1, 1, At, B1); PG8_BAR;
            }
        }
        if constexpr (ALIGN_EPI) { if (wr == 0) PG8_BAR; }
        if constexpr (!Epi::AFTER_DRAIN) { E(acc, cur, wr, wc, fr, fq); S.done(cur); }
        if (!has_next) break;
#pragma unroll
        for (int a = 0; a < 2; ++a)
#pragma unroll
            for (int b = 0; b < 2; ++b)
#pragma unroll
                for (int m = 0; m < 4; ++m)
#pragma unroll
                    for (int n = 0; n < 2; ++n) acc[a][b][m][n] = (f32x4){0.f, 0.f, 0.f, 0.f};
        cur = nxt; cA = nA; cB = nB; ++ui;
        if constexpr (ALIGN_EPI) { if (wr == 1) PG8_BAR; }
    }
    PG8_WAIT_V(0);
    if constexpr (!ALIGN_EPI) { if (wr == 0) PG8_BAR; }
    PG8_BAR;
    if constexpr (Epi::AFTER_DRAIN) { E.fused(acc, cur, wr, wc, fr, fq, lds, wid, lane); S.done(cur); }
#undef PG8_SA
#undef PG8_SB
#undef PG8_STAGE
#undef PG8_LDA
#undef PG8_LDB
#undef PG8_MMA
#undef PG8_WAIT_V
#undef PG8_WAIT_L
#undef PG8_BAR
#undef PG8_SCHED
}
}
namespace epi {
using pg8::Unit;
struct Proj {
    static constexpr bool PERM = true, AFTER_DRAIN = false, SWAP = false;
    bf16_t *DQ, *DK, *SQ, *SK, *IQ, *IK; float* IW;
    __device__ __forceinline__ void operator()(const f32x4 (&acc)[2][2][4][2], const Unit& u, int wr, int wc, int fr, int fq) const {
        const int row0 = u.pm * 256 + wr * 64 + fr;
#pragma unroll
        for (int bj = 0; bj < 2; ++bj) {
            const int cbase = u.pn * 256 + bj * 128 + wc * 32;
            if (cbase >= 2400) continue;
            const int c8 = cbase + 8 * fq;
            if (cbase >= 2368) {
                if (fq == 0) {
#pragma unroll
                    for (int ai = 0; ai < 2; ++ai)
#pragma unroll
                        for (int m = 0; m < 4; ++m) { const int row = row0 + ai * 128 + m * 16; *(f32x4*)(IW + (size_t)row * 4) = acc[ai][bj][m][0] * 0.5f; }
                }
                continue;
            }
            bf16_t* dst; int nh, hh; float sc = 1.0f;
            if (cbase < 512) { dst = DQ; nh = 8; hh = cbase >> 6; sc = 0.125f * LOG2E; }
            else if (cbase < 1024) { dst = DK; nh = 8; hh = (cbase - 512) >> 6; }
            else if (cbase < 1536) { dst = SQ; nh = 8; hh = (cbase - 1024) >> 6; sc = 0.125f * LOG2E; }
            else if (cbase < 2048) { dst = SK; nh = 8; hh = (cbase - 1536) >> 6; }
            else if (cbase < 2304) { dst = IQ; nh = 4; hh = (cbase - 2048) >> 6; sc = 0.125f; }
            else { dst = IK; nh = 1; hh = 0; }
            const int d = c8 & 63;
#pragma unroll
            for (int ai = 0; ai < 2; ++ai)
#pragma unroll
                for (int m = 0; m < 4; ++m) {
                    const int row = row0 + ai * 128 + m * 16, b = row >> 12, s = row & 4095;
                    const f32x4 v0 = acc[ai][bj][m][0] * sc, v1 = acc[ai][bj][m][1] * sc;
                    u32x4 w; w.x = cvt_pk_bf16(v0[0], v0[1]); w.y = cvt_pk_bf16(v0[2], v0[3]); w.z = cvt_pk_bf16(v1[0], v1[1]); w.w = cvt_pk_bf16(v1[2], v1[3]);
                    *(u32x4*)(dst + ((size_t)((b * nh + hh) * 4096 + s)) * 64 + d) = w;
                }
        }
    }
};
struct ProjV {
    static constexpr bool PERM = false, AFTER_DRAIN = false, SWAP = true;
    bf16_t *DVT, *SVT;
    __device__ __forceinline__ void operator()(const f32x4 (&acc)[2][2][4][2], const Unit& u, int wr, int wc, int fr, int fq) const {
#pragma unroll
        for (int ai = 0; ai < 2; ++ai)
#pragma unroll
            for (int m = 0; m < 4; ++m) {
                const int tok0 = u.pm * 256 + ai * 128 + wr * 64 + m * 16 + 4 * fq, b = tok0 >> 12, s0 = tok0 & 4095;
                const int pos = (s0 & ~63) + 16 * m + 8 * (fq & 1) + 4 * (fq >> 1);
#pragma unroll
                for (int bj = 0; bj < 2; ++bj)
#pragma unroll
                    for (int n = 0; n < 2; ++n) {
                        const int col = u.pn * 256 + bj * 128 + wc * 32 + n * 16 + fr;
                        bf16_t* dst;
                        if (col < 512) dst = DVT + ((size_t)((b * 4 + (col >> 7)) * 128 + (col & 127))) * 4096 + pos;
                        else { const int c2 = col - 512; dst = SVT + ((size_t)((b * 8 + (c2 >> 6)) * 64 + (c2 & 63))) * 4096 + pos; }
                        const f32x4 v = acc[ai][bj][m][n];
                        u32x2 w; w.x = cvt_pk_bf16(v[0], v[1]); w.y = cvt_pk_bf16(v[2], v[3]);
                        *(u32x2*)dst = w;
                    }
            }
    }
};
struct PlainBf16 {
    static constexpr bool PERM = true, AFTER_DRAIN = false, SWAP = false;
    bf16_t* O; int ldc; int psh, pmask; unsigned pstride;
    __device__ __forceinline__ void operator()(const f32x4 (&acc)[2][2][4][2], const Unit& u, int wr, int wc, int fr, int fq) const {
        const int row0 = u.pm * 256 + wr * 64 + fr, col0 = (u.pn & pmask) * 256 + wc * 32 + 8 * fq;
        bf16_t* Op = O + (size_t)((unsigned)(u.pn >> psh) * pstride);
#pragma unroll
        for (int ai = 0; ai < 2; ++ai)
#pragma unroll
            for (int m = 0; m < 4; ++m) { bf16_t* rowp = Op + (size_t)(row0 + ai * 128 + m * 16) * ldc + col0;
#pragma unroll
                for (int bj = 0; bj < 2; ++bj) { const f32x4 v0 = acc[ai][bj][m][0], v1 = acc[ai][bj][m][1];
                    u32x4 w; w.x = cvt_pk_bf16(v0[0], v0[1]); w.y = cvt_pk_bf16(v0[2], v0[3]); w.z = cvt_pk_bf16(v1[0], v1[1]); w.w = cvt_pk_bf16(v1[2], v1[3]);
                    *(u32x4*)(rowp + bj * 128) = w; } }
    }
};
struct OutRes {
    static constexpr bool PERM = true, AFTER_DRAIN = false, SWAP = false;
    const bf16_t* H; bf16_t* RF;
    __device__ __forceinline__ void operator()(const f32x4 (&acc)[2][2][4][2], const Unit& u, int wr, int wc, int fr, int fq) const {
        const int row0 = u.pm * 256 + wr * 64 + fr, col0 = u.pn * 256 + wc * 32 + 8 * fq;
#pragma unroll
        for (int ai = 0; ai < 2; ++ai)
#pragma unroll
            for (int m = 0; m < 4; ++m) { const size_t off = (size_t)(row0 + ai * 128 + m * 16) * D + col0;
#pragma unroll
                for (int bj = 0; bj < 2; ++bj) { const u32x4 h = *(const u32x4*)(H + off + bj * 128);
                    f32x4 o0, o1;
                    o0[0] = ALPHA * bf_lo(h.x) + acc[ai][bj][m][0][0]; o0[1] = ALPHA * bf_hi(h.x) + acc[ai][bj][m][0][1]; o0[2] = ALPHA * bf_lo(h.y) + acc[ai][bj][m][0][2]; o0[3] = ALPHA * bf_hi(h.y) + acc[ai][bj][m][0][3];
                    o1[0] = ALPHA * bf_lo(h.z) + acc[ai][bj][m][1][0]; o1[1] = ALPHA * bf_hi(h.z) + acc[ai][bj][m][1][1]; o1[2] = ALPHA * bf_lo(h.w) + acc[ai][bj][m][1][2]; o1[3] = ALPHA * bf_hi(h.w) + acc[ai][bj][m][1][3];
                    u32x4 w; w.x = cvt_pk_bf16(o0[0], o0[1]); w.y = cvt_pk_bf16(o0[2], o0[3]); w.z = cvt_pk_bf16(o1[0], o1[1]); w.w = cvt_pk_bf16(o1[2], o1[3]);
                    *(u32x4*)(RF + off + bj * 128) = w; }
                asm volatile("" ::: "memory"); }
    }
};
struct Gate {
    static constexpr bool PERM = true, AFTER_DRAIN = false, SWAP = false;
    const bf16_t* R2; const bf16_t* PP; const float* bg; bf16_t* RF;
    __device__ __forceinline__ float sg(float x) const { return __builtin_amdgcn_rcpf(1.0f + __builtin_amdgcn_exp2f(-LOG2E * x)); }
    __device__ __forceinline__ void operator()(const f32x4 (&acc)[2][2][4][2], const Unit& u, int wr, int wc, int fr, int fq) const {
        const int row0 = u.pm * 256 + wr * 64 + fr, col0 = u.pn * 256 + wc * 32 + 8 * fq;
        f32x4 bv[2][2];
#pragma unroll
        for (int bj = 0; bj < 2; ++bj) { bv[bj][0] = *(const f32x4*)(bg + col0 + bj * 128); bv[bj][1] = *(const f32x4*)(bg + col0 + bj * 128 + 4); }
#pragma unroll
        for (int ai = 0; ai < 2; ++ai)
#pragma unroll
            for (int m = 0; m < 4; ++m) { const size_t off = (size_t)(row0 + ai * 128 + m * 16) * D + col0;
#pragma unroll
                for (int bj = 0; bj < 2; ++bj) { const u32x4 r = *(const u32x4*)(R2 + off + bj * 128), p = *(const u32x4*)(PP + off + bj * 128);
                    const f32x4 a0 = acc[ai][bj][m][0] + bv[bj][0], a1 = acc[ai][bj][m][1] + bv[bj][1];
                    f32x4 o0, o1;
                    o0[0] = bf_lo(r.x) + sg(a0[0]) * bf_lo(p.x); o0[1] = bf_hi(r.x) + sg(a0[1]) * bf_hi(p.x); o0[2] = bf_lo(r.y) + sg(a0[2]) * bf_lo(p.y); o0[3] = bf_hi(r.y) + sg(a0[3]) * bf_hi(p.y);
                    o1[0] = bf_lo(r.z) + sg(a1[0]) * bf_lo(p.z); o1[1] = bf_hi(r.z) + sg(a1[1]) * bf_hi(p.z); o1[2] = bf_lo(r.w) + sg(a1[2]) * bf_lo(p.w); o1[3] = bf_hi(r.w) + sg(a1[3]) * bf_hi(p.w);
                    u32x4 w; w.x = cvt_pk_bf16(o0[0], o0[1]); w.y = cvt_pk_bf16(o0[2], o0[3]); w.z = cvt_pk_bf16(o1[0], o1[1]); w.w = cvt_pk_bf16(o1[2], o1[3]);
                    *(u32x4*)(RF + off + bj * 128) = w; }
                asm volatile("" ::: "memory"); }
    }
};
}
#define XB_TMO      128
#define XB_XCNT(j)  (256  + 64 * (j))
#define XB_XSUB(j)  (1280 + 64 * (j))
#define XB_XGEN(j)  (2304 + 64 * (j))
#define XB_TOP      3328
#define XB_TOPGEN   3392
#define XCD_BAR_WORDS 3456
#define XB_SPIN_CAP (1u << 22)

__device__ __forceinline__ unsigned xb_ld(unsigned* p)              { return __hip_atomic_load(p, __ATOMIC_RELAXED, __HIP_MEMORY_SCOPE_AGENT); }
__device__ __forceinline__ unsigned xb_add(unsigned* p, unsigned v) { return __hip_atomic_fetch_add(p, v, __ATOMIC_RELAXED, __HIP_MEMORY_SCOPE_AGENT); }
__device__ __forceinline__ unsigned xb_xcc_id() { return (unsigned)__builtin_amdgcn_s_getreg((3 << 11) | 20) & 0xFu; }
#define XB_SPIN(cond, bar) do { unsigned _sp = 0; while (cond) { __builtin_amdgcn_s_sleep(1); \
    if ((++_sp & 255u) == 0u) { if (xb_ld(&(bar)[XB_TMO])) break; if (_sp > XB_SPIN_CAP) { atomicAdd(&(bar)[XB_TMO], 1u); break; } } } } while (0)

struct XcdBarrier {
    unsigned* bar; unsigned x;
    volatile LAS unsigned* st;
};

__device__ __forceinline__ XcdBarrier xcd_barrier_post(unsigned* bar, volatile LAS unsigned* st) {
    XcdBarrier b; b.bar = bar; b.x = xb_xcc_id(); b.st = st;
    if (threadIdx.x == 0) (void)xb_add(&bar[XB_XCNT(b.x)], 1u);
    return b;
}
__device__ __forceinline__ void xcd_barrier_complete(unsigned* bar, unsigned x, unsigned& nloc, unsigned& nx) {
    const unsigned G = gridDim.x * gridDim.y * gridDim.z;
    unsigned sum, cnt, mine, sp = 0u;
    for (;;) {
        sum = 0u; cnt = 0u; mine = 0u;
#pragma unroll
        for (unsigned j = 0; j < 16; ++j) { const unsigned c = xb_ld(&bar[XB_XCNT(j)]); sum += c; cnt += (c > 0u) ? 1u : 0u; mine = (j == x) ? c : mine; }
        if (sum == G) break;
        __builtin_amdgcn_s_sleep(1);
        if ((++sp & 255u) == 0u) { if (xb_ld(&bar[XB_TMO])) break; if (sp > XB_SPIN_CAP) { atomicAdd(&bar[XB_TMO], 1u); break; } }
    }
    nloc = mine > 0u ? mine : 1u; nx = cnt > 0u ? cnt : 1u;
}

__device__ __forceinline__ void xcd_barrier(const XcdBarrier& b) {
    asm volatile("s_waitcnt vmcnt(0)" ::: "memory");
    __syncthreads();
    if (threadIdx.x == 0) {
        unsigned* bar = b.bar;
        __builtin_amdgcn_s_waitcnt(0);
        unsigned nloc = b.st[0], nx = b.st[1];
        if (nloc == 0u) { xcd_barrier_complete(bar, b.x, nloc, nx); b.st[0] = nloc; b.st[1] = nx; }
        const unsigned old = xb_add(&bar[XB_XSUB(b.x)], 1u);
        const unsigned gen = old / nloc;
        if (old + 1u == (gen + 1u) * nloc) {
            __builtin_amdgcn_fence(__ATOMIC_RELEASE, "agent");
            asm volatile("s_waitcnt vmcnt(0)" ::: "memory");
            const unsigned og = xb_add(&bar[XB_TOP], 1u);
            const unsigned tg = og / nx;
            if (og + 1u == (tg + 1u) * nx) xb_add(&bar[XB_TOPGEN], 1u);
            else XB_SPIN(xb_ld(&bar[XB_TOPGEN]) == tg, bar);
            __builtin_amdgcn_fence(__ATOMIC_ACQUIRE, "agent");
            xb_add(&bar[XB_XGEN(b.x)], 1u);
            asm volatile("s_waitcnt vmcnt(0)" ::: "memory");
        } else {
            XB_SPIN(xb_ld(&bar[XB_XGEN(b.x)]) == gen, bar);
            __builtin_amdgcn_fence(__ATOMIC_ACQUIRE, "agent");
            asm volatile("s_waitcnt vmcnt(0)" ::: "memory");
        }
    }
    __syncthreads();
}

#define XB_GRP(j) (3520 + 64 * (j))
#define XB_GMASK(j) (3520 + 64 * (j) + 32)
#define XB_PAIR(j) (8192 + 64 * (j))
__device__ __forceinline__ void group_barrier(const XcdBarrier& b, unsigned cword, unsigned gsize, int gslot = 2) {
    asm volatile("s_waitcnt vmcnt(0)" ::: "memory");
    __syncthreads();
    if (threadIdx.x == 0) {
        unsigned* bar = b.bar;
        __builtin_amdgcn_s_waitcnt(0);
        if (b.st[3] == 0u) {
            __builtin_amdgcn_fence(__ATOMIC_RELEASE, "agent");
            asm volatile("s_waitcnt vmcnt(0)" ::: "memory");
        }
        const unsigned gen = b.st[gslot];
        (void)xb_add(&bar[cword], 1u);
        const unsigned target = (gen + 1u) * gsize;
        XB_SPIN(xb_ld(&bar[cword]) < target, bar);
        __builtin_amdgcn_fence(__ATOMIC_ACQUIRE, "agent");
        asm volatile("s_waitcnt vmcnt(0)" ::: "memory");
        b.st[gslot] = gen + 1u;
    }
    __syncthreads();
}

__device__ __forceinline__ void group_post(const XcdBarrier& b, unsigned grp) { if (threadIdx.x == 0) (void)__hip_atomic_fetch_or(&b.bar[XB_GMASK(grp)], 1u << b.x, __ATOMIC_RELAXED, __HIP_MEMORY_SCOPE_AGENT); }
__device__ __forceinline__ void group_resolve(const XcdBarrier& b, unsigned grp) {
    if (threadIdx.x == 0) { const unsigned m = xb_ld(&b.bar[XB_GMASK(grp)]); b.st[3] = (m != 0u && (m & (m - 1u)) == 0u) ? 1u : 0u; }
    __syncthreads();
}
struct Frame {
    LAS unsigned char* lds;
    int tid, lane, wave, G, wg;
    unsigned char* ws;
};

__device__ __forceinline__ void transpose_item(const float* __restrict__ W, int K, int ldn, int src_c0, int nvalid, bf16_t* __restrict__ WT, LAS float* scr, int kb, int nb, int lane) {
    const int k0 = 64 * kb, n0 = 32 * nb, nn = n0 + (lane & 31);
    const bool ok = nn < nvalid;
#pragma unroll 8
    for (int i = 0; i < 32; ++i) { const int kk = 2 * i + (lane >> 5); scr[kk * 33 + (lane & 31)] = ok ? W[(size_t)(k0 + kk) * ldn + src_c0 + nn] : 0.0f; }
    LDS_WAIT();
    const int c = lane & 7;
#pragma unroll
    for (int j = 0; j < 4; ++j) { const int n = (lane >> 3) + 8 * j; const LAS float* s = scr + (8 * c) * 33 + n;
        u32x4 o; o.x = cvt_pk_bf16(s[0 * 33], s[1 * 33]); o.y = cvt_pk_bf16(s[2 * 33], s[3 * 33]); o.z = cvt_pk_bf16(s[4 * 33], s[5 * 33]); o.w = cvt_pk_bf16(s[6 * 33], s[7 * 33]);
        *(u32x4*)(WT + (size_t)(n0 + n) * K + k0 + 8 * c) = o; }
    LDS_WAIT();
}
__device__ __forceinline__ void ln_row(const float* __restrict__ xrow, const float* __restrict__ g, const float* __restrict__ bta, bf16_t* obf, float* of32, int lane) {
    const f32x4* xr = (const f32x4*)xrow + lane;
    f32x4 v[4]; float s = 0.f;
#pragma unroll
    for (int j = 0; j < 4; ++j) { v[j] = xr[64 * j]; s += (v[j][0] + v[j][1]) + (v[j][2] + v[j][3]); }
    const float mean = wave_sum(s) * (1.f / D); float s2 = 0.f;
#pragma unroll
    for (int j = 0; j < 4; ++j) { v[j] = v[j] - mean; s2 += (v[j][0] * v[j][0] + v[j][1] * v[j][1]) + (v[j][2] * v[j][2] + v[j][3] * v[j][3]); }
    const float rstd = 1.f / sqrtf(wave_sum(s2) * (1.f / D) + LN_EPS);
#pragma unroll
    for (int j = 0; j < 4; ++j) {
        const f32x4 gg = ((const f32x4*)g)[lane + 64 * j], bb = ((const f32x4*)bta)[lane + 64 * j];
        const f32x4 y = v[j] * rstd * gg + bb;
        if (obf) { u32x2 w; w.x = cvt_pk_bf16(y[0], y[1]); w.y = cvt_pk_bf16(y[2], y[3]); ((u32x2*)obf)[lane + 64 * j] = w; }
        if (of32) ((f32x4*)of32)[lane + 64 * j] = y;
    }
}
__device__ __forceinline__ void ln_row_bf(const bf16_t* __restrict__ xrow, const float* __restrict__ g, const float* __restrict__ bta, bf16_t* obf, float* of32, int lane) {
    const u32x4 a0 = *(const u32x4*)(xrow + 16 * lane), a1 = *(const u32x4*)(xrow + 16 * lane + 8);
    float v[16] = {bf_lo(a0.x), bf_hi(a0.x), bf_lo(a0.y), bf_hi(a0.y), bf_lo(a0.z), bf_hi(a0.z), bf_lo(a0.w), bf_hi(a0.w), bf_lo(a1.x), bf_hi(a1.x), bf_lo(a1.y), bf_hi(a1.y), bf_lo(a1.z), bf_hi(a1.z), bf_lo(a1.w), bf_hi(a1.w)};
    float s = 0.f;
#pragma unroll
    for (int i = 0; i < 16; ++i) s += v[i];
    const float mean = wave_sum(s) * (1.f / D); float s2 = 0.f;
#pragma unroll
    for (int i = 0; i < 16; ++i) { v[i] -= mean; s2 += v[i] * v[i]; }
    const float rstd = 1.f / sqrtf(wave_sum(s2) * (1.f / D) + LN_EPS);
    float y[16];
#pragma unroll
    for (int j = 0; j < 4; ++j) { const f32x4 gg = ((const f32x4*)g)[4 * lane + j], bb = ((const f32x4*)bta)[4 * lane + j];
#pragma unroll
        for (int i = 0; i < 4; ++i) y[4 * j + i] = v[4 * j + i] * rstd * gg[i] + bb[i]; }
    if (obf) { u32x4 w0, w1; w0.x = cvt_pk_bf16(y[0], y[1]); w0.y = cvt_pk_bf16(y[2], y[3]); w0.z = cvt_pk_bf16(y[4], y[5]); w0.w = cvt_pk_bf16(y[6], y[7]);
        w1.x = cvt_pk_bf16(y[8], y[9]); w1.y = cvt_pk_bf16(y[10], y[11]); w1.z = cvt_pk_bf16(y[12], y[13]); w1.w = cvt_pk_bf16(y[14], y[15]);
        *(u32x4*)(obf + 16 * lane) = w0; *(u32x4*)(obf + 16 * lane + 8) = w1; }
    if (of32) {
#pragma unroll
        for (int j = 0; j < 4; ++j) ((f32x4*)of32)[4 * lane + j] = (f32x4){y[4 * j], y[4 * j + 1], y[4 * j + 2], y[4 * j + 3]}; }
}
__device__ __forceinline__ void ln_rows_bf(const bf16_t* __restrict__ X, const float* __restrict__ g, const float* __restrict__ bta, bf16_t* obf, float* of32, int gw, int ngw, int mend, int lane) {
    f32x4 gg[4], bb[4];
#pragma unroll
    for (int j = 0; j < 4; ++j) { gg[j] = ((const f32x4*)g)[4 * lane + j]; bb[j] = ((const f32x4*)bta)[4 * lane + j]; }
    int m = gw;
    u32x4 n0 = (u32x4){0u, 0u, 0u, 0u}, n1 = n0;
    if (m < mend) { n0 = *(const u32x4*)(X + (size_t)m * D + 16 * lane); n1 = *(const u32x4*)(X + (size_t)m * D + 16 * lane + 8); }
#pragma unroll 1
    for (; m < mend; m += ngw) {
        const u32x4 a0 = n0, a1 = n1;
        if (m + ngw < mend) { n0 = *(const u32x4*)(X + (size_t)(m + ngw) * D + 16 * lane); n1 = *(const u32x4*)(X + (size_t)(m + ngw) * D + 16 * lane + 8); }
        float v[16] = {bf_lo(a0.x), bf_hi(a0.x), bf_lo(a0.y), bf_hi(a0.y), bf_lo(a0.z), bf_hi(a0.z), bf_lo(a0.w), bf_hi(a0.w), bf_lo(a1.x), bf_hi(a1.x), bf_lo(a1.y), bf_hi(a1.y), bf_lo(a1.z), bf_hi(a1.z), bf_lo(a1.w), bf_hi(a1.w)};
        float s = 0.f;
#pragma unroll
        for (int i = 0; i < 16; ++i) s += v[i];
        const float mean = wave_sum(s) * (1.f / D); float s2 = 0.f;
#pragma unroll
        for (int i = 0; i < 16; ++i) { v[i] -= mean; s2 += v[i] * v[i]; }
        const float rstd = 1.f / sqrtf(wave_sum(s2) * (1.f / D) + LN_EPS);
        float y[16];
#pragma unroll
        for (int j = 0; j < 4; ++j)
#pragma unroll
            for (int i = 0; i < 4; ++i) y[4 * j + i] = v[4 * j + i] * rstd * gg[j][i] + bb[j][i];
        if (obf) { u32x4 w0, w1; w0.x = cvt_pk_bf16(y[0], y[1]); w0.y = cvt_pk_bf16(y[2], y[3]); w0.z = cvt_pk_bf16(y[4], y[5]); w0.w = cvt_pk_bf16(y[6], y[7]);
            w1.x = cvt_pk_bf16(y[8], y[9]); w1.y = cvt_pk_bf16(y[10], y[11]); w1.z = cvt_pk_bf16(y[12], y[13]); w1.w = cvt_pk_bf16(y[14], y[15]);
            *(u32x4*)(obf + (size_t)m * D + 16 * lane) = w0; *(u32x4*)(obf + (size_t)m * D + 16 * lane + 8) = w1; }
        if (of32) {
#pragma unroll
            for (int j = 0; j < 4; ++j) ((f32x4*)(of32 + (size_t)m * D))[4 * lane + j] = (f32x4){y[4 * j], y[4 * j + 1], y[4 * j + 2], y[4 * j + 3]}; }
    }
}
__device__ __forceinline__ void convert_f32_bf16(const float* __restrict__ src, bf16_t* __restrict__ dst, size_t n, size_t gtid, size_t gthreads) {
    const size_t n8 = n >> 3;
    for (size_t i = gtid; i < n8; i += gthreads) {
        const f32x4 a = ((const f32x4*)src)[2 * i], b = ((const f32x4*)src)[2 * i + 1];
        u32x4 o; o.x = cvt_pk_bf16(a[0], a[1]); o.y = cvt_pk_bf16(a[2], a[3]); o.z = cvt_pk_bf16(b[0], b[1]); o.w = cvt_pk_bf16(b[2], b[3]);
        ((u32x4*)dst)[i] = o;
    }
}

__device__ __forceinline__ float fp8_row_scale(float amax, float* inv) {
    const int ex = (int)((__float_as_uint(amax) >> 23) & 0xffu);
    if (ex < 16 || ex > 240) { *inv = 1.0f; return 1.0f; }
    *inv = __uint_as_float((unsigned)(ex - 7) << 23);
    return __uint_as_float((unsigned)(261 - ex) << 23);
}
__device__ __forceinline__ unsigned pack4_fp8(float a, float b, float c, float d) {
    int w = __builtin_amdgcn_cvt_pk_fp8_f32(a, b, 0, false);
    w = __builtin_amdgcn_cvt_pk_fp8_f32(c, d, w, true);
    return (unsigned)w;
}
__device__ __forceinline__ void convert_rows_fp8(const float* __restrict__ src, unsigned char* __restrict__ dst, float* __restrict__ inv_scale, int nrows, int gw, int ngw, int lane) {
    for (int row = gw; row < nrows; row += ngw) {
        const f32x4* xr = (const f32x4*)(src + (size_t)row * D) + lane;
        f32x4 v[4]; float am = 0.f;
#pragma unroll
        for (int j = 0; j < 4; ++j) { v[j] = xr[64 * j]; am = fmaxf(am, fmaxf(fmaxf(fabsf(v[j][0]), fabsf(v[j][1])), fmaxf(fabsf(v[j][2]), fabsf(v[j][3])))); }
        am = wave_max(am);
        float inv; const float sc = fp8_row_scale(am, &inv);
#pragma unroll
        for (int j = 0; j < 4; ++j) ((unsigned*)(dst + (size_t)row * D))[lane + 64 * j] = pack4_fp8(v[j][0] * sc, v[j][1] * sc, v[j][2] * sc, v[j][3] * sc);
        if (lane == 0) inv_scale[row] = inv;
    }
}

__device__ __forceinline__ void convert_rows_i4(const float* __restrict__ src, unsigned char* __restrict__ dst, float* __restrict__ step_out, int nrows, int gw, int ngw, int lane) {
    f32x4 nv[4];
#pragma unroll
    for (int j = 0; j < 4; ++j) nv[j] = (f32x4){0.f, 0.f, 0.f, 0.f};
    if (gw < nrows) {
#pragma unroll
        for (int j = 0; j < 4; ++j) nv[j] = ((const f32x4*)(src + (size_t)gw * D + 16 * lane))[j]; }
#pragma unroll 1
    for (int row = gw; row < nrows; row += ngw) {
        f32x4 v[4]; float am = 0.f;
#pragma unroll
        for (int j = 0; j < 4; ++j) v[j] = nv[j];
        if (row + ngw < nrows) {
#pragma unroll
            for (int j = 0; j < 4; ++j) nv[j] = ((const f32x4*)(src + (size_t)(row + ngw) * D + 16 * lane))[j]; }
#pragma unroll
        for (int j = 0; j < 4; ++j) { am = fmaxf(am, fmaxf(fmaxf(fabsf(v[j][0]), fabsf(v[j][1])), fmaxf(fabsf(v[j][2]), fabsf(v[j][3])))); }
        am = wave_max(am);
        float ss = 0.f;
#pragma unroll
        for (int j = 0; j < 4; ++j) ss += (v[j][0] * v[j][0] + v[j][1] * v[j][1]) + (v[j][2] * v[j][2] + v[j][3] * v[j][3]);
        ss = wave_sum(ss);
        const float s_rms = 0.335f * sqrtf(ss * (1.0f / D)), s_lo = am * (1.0f / 15.0f), s_hi = am * (1.0f / 7.5f);
        const float step = am > 0.f ? fminf(fmaxf(s_rms, s_lo), s_hi) : 1.0f, rs = 1.0f / step;
        unsigned n[16];
#pragma unroll
        for (int j = 0; j < 4; ++j)
#pragma unroll
            for (int i = 0; i < 4; ++i) { const int q = (int)(v[j][i] * rs + 8.0f); n[4 * j + i] = (unsigned)(q < 0 ? 0 : (q > 15 ? 15 : q)); }
        u32x2 w; w.x = 0u; w.y = 0u;
#pragma unroll
        for (int k = 0; k < 4; ++k) { w.x |= (n[k] | (n[k + 8] << 4)) << (8 * k); w.y |= (n[4 + k] | (n[12 + k] << 4)) << (8 * k); }
        *(u32x2*)(dst + (size_t)row * 512 + 8 * lane) = w;
        if (lane == 0) step_out[row] = step;
    }
}

__device__ __forceinline__ void convert_rows_fp4(const float* __restrict__ src, unsigned char* __restrict__ dst, float* __restrict__ step_out, int nrows, int gw, int ngw, int lane) {
    f32x4 nv[4];
#pragma unroll
    for (int j = 0; j < 4; ++j) nv[j] = (f32x4){0.f, 0.f, 0.f, 0.f};
    if (gw < nrows) {
#pragma unroll
        for (int j = 0; j < 4; ++j) nv[j] = ((const f32x4*)(src + (size_t)gw * D + 16 * lane))[j]; }
#pragma unroll 1
    for (int row = gw; row < nrows; row += ngw) {
        f32x4 v[4]; float am = 0.f;
#pragma unroll
        for (int j = 0; j < 4; ++j) v[j] = nv[j];
        if (row + ngw < nrows) {
#pragma unroll
            for (int j = 0; j < 4; ++j) nv[j] = ((const f32x4*)(src + (size_t)(row + ngw) * D + 16 * lane))[j]; }
#pragma unroll
        for (int j = 0; j < 4; ++j) { am = fmaxf(am, fmaxf(fmaxf(fabsf(v[j][0]), fabsf(v[j][1])), fmaxf(fabsf(v[j][2]), fabsf(v[j][3])))); }
        am = wave_max(am);
        float ss = 0.f;
#pragma unroll
        for (int j = 0; j < 4; ++j) ss += (v[j][0] * v[j][0] + v[j][1] * v[j][1]) + (v[j][2] * v[j][2] + v[j][3] * v[j][3]);
        ss = wave_sum(ss);
        const float s_rms = 0.48f * sqrtf(ss * (1.0f / D)), s_lo = am * (1.0f / 12.0f), s_hi = am * (1.0f / 6.0f);
        const float step = am > 0.f ? fminf(fmaxf(s_rms, s_lo), s_hi) : 1.0f, rs = 1.0f / step;
        unsigned n[16];
#pragma unroll
        for (int j = 0; j < 4; ++j)
#pragma unroll
            for (int i = 0; i < 4; ++i) { const float y = v[j][i] * rs, ay = fabsf(y);
                const unsigned mag = (ay >= 0.25f ? 1u : 0u) + (ay >= 0.75f ? 1u : 0u) + (ay >= 1.25f ? 1u : 0u) + (ay >= 1.75f ? 1u : 0u) + (ay >= 2.5f ? 1u : 0u) + (ay >= 3.5f ? 1u : 0u) + (ay >= 5.0f ? 1u : 0u);
                n[4 * j + i] = mag | ((y < 0.f && mag != 0u) ? 8u : 0u); }
        u32x2 w; w.x = 0u; w.y = 0u;
#pragma unroll
        for (int k = 0; k < 4; ++k) { w.x |= (n[2 * k] | (n[2 * k + 1] << 4)) << (8 * k); w.y |= (n[8 + 2 * k] | (n[9 + 2 * k] << 4)) << (8 * k); }
        *(u32x2*)(dst + (size_t)row * 512 + 8 * lane) = w;
        if (lane == 0) step_out[row] = step;
    }
}

__device__ __forceinline__ float relu1(float d) { float r; asm("v_max_f32 %0, 0, %1" : "=v"(r) : "v"(d)); return r; }
__device__ __forceinline__ bool scan_hist_row(const LAS unsigned* row, int lane, unsigned target, unsigned& dsel, unsigned& ca, unsigned& csel, unsigned& tot_all) {
    unsigned wd[8];
#pragma unroll
    for (int i = 0; i < 8; ++i) wd[i] = row[8 * lane + i];
    unsigned tot = 0;
#pragma unroll
    for (int i = 0; i < 8; ++i) tot += (wd[i] & 0xffffu) + (wd[i] >> 16);
    unsigned pre_ = wave_prefix_sum(tot);
    asm volatile("" : "+v"(pre_));
    tot_all = (unsigned)__builtin_amdgcn_readlane((int)pre_, 63);
    const unsigned incl = tot_all - pre_ + tot;
    const unsigned above = incl - tot;
    dsel = 0; ca = above; csel = 0;
    if (!(above < target && target <= incl)) return false;
    bool found = false;
#pragma unroll
    for (int i = 15; i >= 0; --i) { const unsigned c = (i & 1) ? (wd[i >> 1] >> 16) : (wd[i >> 1] & 0xffffu);
        if (!found) { if (ca + c >= target) { found = true; dsel = (unsigned)(16 * lane + i); csel = c; } else ca += c; } }
    return true;
}
__device__ __forceinline__ void select_exact_wave(const LAS float* S, int ng, LAS unsigned* wh, u64* __restrict__ mq, int lane) {
    unsigned prefix = 0u, need = 256u;
#pragma unroll 1
    for (int pass = 0; pass < 4; ++pass) {
        const int shift = 24 - 8 * pass;
        *(LAS u32x4*)(wh + 4 * lane) = (u32x4){0u, 0u, 0u, 0u};
        asm volatile("s_waitcnt lgkmcnt(0)" ::: "memory");
#pragma unroll 4
        for (int g = 0; g < ng; ++g) { const unsigned u = f2sort(S[g * 64 + lane]);
            if (((u >> shift) >> 8) == prefix) __hip_atomic_fetch_add(wh + ((u >> shift) & 255u), 1u, __ATOMIC_RELAXED, __HIP_MEMORY_SCOPE_WORKGROUP); }
        asm volatile("s_waitcnt lgkmcnt(0)" ::: "memory");
        unsigned cc[4];
#pragma unroll
        for (int i = 0; i < 4; ++i) cc[i] = wh[4 * lane + i];
        const unsigned tot = cc[0] + cc[1] + cc[2] + cc[3];
        unsigned incl = tot;
#pragma unroll
        for (int off = 1; off < 64; off <<= 1) { const unsigned t = __shfl_down(incl, off); if (lane + off < 64) incl += t; }
        const unsigned above = incl - tot;
        const bool hit = above < need && need <= incl;
        unsigned ca = above, dsel = 0u; bool found = false;
#pragma unroll
        for (int i = 3; i >= 0; --i) if (!found) { if (ca + cc[i] >= need) { found = true; dsel = (unsigned)(4 * lane + i); } else ca += cc[i]; }
        const u64 hm = __ballot(hit); const int hl = hm ? (int)__builtin_ctzll(hm) : 0;
        const unsigned bsel = (unsigned)__shfl((int)dsel, hl), bca = (unsigned)__shfl((int)ca, hl);
        prefix = (prefix << 8) | bsel; need -= bca;
        asm volatile("" ::: "memory");
    }
    unsigned rem = need;
#pragma unroll 2
    for (int g = 0; g < ng; ++g) { const unsigned u = f2sort(S[g * 64 + lane]);
        const u64 gt = __ballot(u > prefix), eq = __ballot(u == prefix);
        const unsigned below = __builtin_amdgcn_mbcnt_hi((unsigned)(eq >> 32), __builtin_amdgcn_mbcnt_lo((unsigned)eq, 0u));
        const u64 pick = __ballot(u == prefix && below < rem);
        const unsigned np = (unsigned)__builtin_popcountll(pick);
        rem -= np;
        if (lane == 0) mq[(size_t)g * 4096] = gt | pick; }
}
template <int MODE>
__device__ __forceinline__ void select_sweep(const bf16_t* __restrict__ ikb, const bf16x8 (&bq)[4][2], const f32x4 wq, int kh, int ng, int fr, int fq, bool active, unsigned P0, unsigned P1,
                                             LAS unsigned* hrow, u64* __restrict__ mrow, float flo = 0.f, float finv = 0.f, float* amax = nullptr, LAS unsigned* lcnt = nullptr, LAS u64* lrow = nullptr, unsigned cap = 0u, unsigned zg = 0u, unsigned zk = 0u, unsigned fs = 0u, bool dmp = false, LAS float* scb = nullptr) {
    const float tin = (P0 == 0u) ? -INFINITY : (float)P0;
    const float tsel = (P1 & 1u) ? tin : ((P0 >= 1023u) ? INFINITY : (float)(P0 + 1u));
    bf16x8 ka[8];
#define SEL_LOAD1(G, KT) do { const bf16_t* kp = ikb + (size_t)((G) * 64 + (KT) * 16 + fr) * 64 + 8 * fq; ka[2 * (KT)] = *(const bf16x8*)kp; ka[2 * (KT) + 1] = *(const bf16x8*)(kp + 32); } while (0)
    int g = kh;
    if (g < ng) {
#pragma unroll
        for (int kt = 0; kt < 4; ++kt) SEL_LOAD1(g, kt);
    }
#pragma unroll 1
    for (; g < ng; g += 2) {
        unsigned lo_ = 0u, hi_ = 0u, zlo_ = 0u, zhi_ = 0u;
        const bool more = (g + 2 < ng);
#pragma unroll
        for (int kt = 0; kt < 4; ++kt) {
            f32x4 dd[4];
#pragma unroll
            for (int j = 0; j < 4; ++j) {
                dd[j] = __builtin_amdgcn_mfma_f32_16x16x32_bf16(ka[2 * kt], bq[j][0], (f32x4){0.f, 0.f, 0.f, 0.f}, 0, 0, 0);
                dd[j] = __builtin_amdgcn_mfma_f32_16x16x32_bf16(ka[2 * kt + 1], bq[j][1], dd[j], 0, 0, 0);
            }
            if (more) SEL_LOAD1(g + 2, kt);
            f32x4 sc = (f32x4){0.f, 0.f, 0.f, 0.f};
#pragma unroll
            for (int j = 0; j < 4; ++j)
#pragma unroll
                for (int r = 0; r < 4; ++r) sc[r] += wq[j] * relu1(dd[j][r]);
            unsigned nib = 0u, znib = 0u;
#pragma unroll
            for (int r = 0; r < 4; ++r) {
                const unsigned u = f2sort(sc[r] + 0.0f), inv = (unsigned)(4095 - (g * 64 + kt * 16 + 4 * fq + r));
                if (MODE == 5) { nib |= ((u > P0) || (u == P0 && inv >= P1)) ? (1u << r) : 0u; }
                else if (MODE == 6) { *amax = fmaxf(*amax, fabsf(sc[r])); }
                else if (MODE == 7) { const unsigned bi = (unsigned)(int)fminf(fmaxf(__builtin_fmaf(sc[r], finv, 512.0f), 0.f), 1023.f);
                    if (bi >= P0) __hip_atomic_fetch_add(hrow + (bi >> 1), (bi & 1u) ? 65536u : 1u, __ATOMIC_RELAXED, __HIP_MEMORY_SCOPE_WORKGROUP);
                    if (lcnt != nullptr && sc[r] == 0.0f) znib += 1u; }
                else if (MODE == 8) { const float tb = __builtin_fmaf(sc[r], finv, 512.0f);
                    const bool s1 = fs == 0u && tb >= tsel;
                    nib |= s1 ? (1u << r) : 0u;
                    if (fs == 0u && !s1 && tb >= tin) {
                        if ((P1 & 2u) != 0u && sc[r] == 0.0f) znib |= (1u << r);
                        else { const unsigned pos = __hip_atomic_fetch_add(lcnt, 1u, __ATOMIC_RELAXED, __HIP_MEMORY_SCOPE_WORKGROUP); if (pos < cap) lrow[pos] = ((u64)u << 12) | (u64)inv; } } }
                else if (MODE == 9) { }
                else { bool match; unsigned dg;
                    if (MODE == 0) { match = active; dg = u >> 22; }
                    else if (MODE == 1) { match = active && (u >> 22) == P0; dg = (u >> 12) & 1023u; }
                    else if (MODE == 2) { match = active && (u >> 12) == P0; dg = (u >> 2) & 1023u; }
                    else if (MODE == 3) { match = active && (u >> 2) == P0; dg = ((u & 3u) << 8) | (inv >> 4); }
                    else { match = active && u == P0 && (inv >> 4) == P1; dg = inv & 15u; }
                    if (match) __hip_atomic_fetch_add(hrow + (dg >> 1), (dg & 1u) ? 65536u : 1u, __ATOMIC_RELAXED, __HIP_MEMORY_SCOPE_WORKGROUP); }
            }
            if (MODE == 8 || MODE == 9) { if (dmp) *(LAS f32x4*)(scb + g * 64 + kt * 16 + 4 * fq) = sc + 0.0f; }
            if (MODE == 5 || MODE == 8) { const unsigned sh = (unsigned)((kt & 1) * 16 + 4 * fq); if (kt < 2) lo_ |= nib << sh; else hi_ |= nib << sh; }
            if (MODE == 8) { const unsigned sh = (unsigned)((kt & 1) * 16 + 4 * fq); if (kt < 2) zlo_ |= znib << sh; else zhi_ |= znib << sh; }
            if (MODE == 7) { if (znib != 0u) __hip_atomic_fetch_add(lcnt + (g >> 1), znib << (16 * (g & 1)), __ATOMIC_RELAXED, __HIP_MEMORY_SCOPE_WORKGROUP); }
        }
        if (MODE == 5 || MODE == 8) { lo_ |= __shfl_xor(lo_, 16); lo_ |= __shfl_xor(lo_, 32); hi_ |= __shfl_xor(hi_, 16); hi_ |= __shfl_xor(hi_, 32);
            u64 word = ((u64)hi_ << 32) | (u64)lo_;
            if (MODE == 8 && (P1 & 2u) != 0u) {
                zlo_ |= __shfl_xor(zlo_, 16); zlo_ |= __shfl_xor(zlo_, 32); zhi_ |= __shfl_xor(zhi_, 16); zhi_ |= __shfl_xor(zhi_, 32);
                u64 zm = ((u64)zhi_ << 32) | (u64)zlo_;
                if (g > (int)zg) zm = 0ull; else if (g == (int)zg) { u64 pick = 0ull; for (unsigned i = 0; i < zk; ++i) { const u64 bb = zm & (0ull - zm); pick |= bb; zm ^= bb; } zm = pick; }
                word |= zm; }
            if (fq == 0 && (MODE != 8 || fs == 0u)) mrow[(size_t)g * 4096] = word; }
    }
#undef SEL_LOAD1
}
__device__ __forceinline__ void select_item(const Frame& F, int b, int qb, const bf16_t* __restrict__ IQ, const bf16_t* __restrict__ IK, const float* __restrict__ IW, u64* __restrict__ MASK) {
    constexpr int HS = 513;
    LAS unsigned* hist = (LAS unsigned*)(F.lds + LDS_A);
    LAS u64* Pq = (LAS u64*)(F.lds + LDS_B + 2048);
    LAS u64* Thr = (LAS u64*)(F.lds + LDS_B + 2048 + 512);
    LAS unsigned* Need = (LAS unsigned*)(F.lds + LDS_B + 2048 + 1024);
    LAS unsigned* Done = (LAS unsigned*)(F.lds + LDS_B + 2048 + 1280);
    LAS unsigned* NDone = (LAS unsigned*)(F.lds + LDS_B + 2048 + 1536);
    const int lane = lane_id_fresh(), w = WAVE_FRESH(), qg = w & 3, kh = w >> 2, fr = lane & 15, fq = lane >> 4;
    const int q0 = qb * 64, ql = 16 * qg + fr, ng = qb + 1, tid = w * 64 + lane;
    u64* mrow = MASK + (size_t)b * 64 * 4096 + (q0 + ql);
    if (qb < 4) {
        for (int g = kh; g < ng; g += 2) if (fq == 0) mrow[(size_t)g * 4096] = ~0ull;
        return;
    }
    bf16x8 bq[4][2]; f32x4 wq;
#pragma unroll
    for (int j = 0; j < 4; ++j)
#pragma unroll
        for (int ks = 0; ks < 2; ++ks) bq[j][ks] = *(const bf16x8*)(IQ + ((size_t)((b * 4 + j) * 4096 + q0 + ql)) * 64 + 32 * ks + 8 * fq);
    wq = *(const f32x4*)(IW + (size_t)(b * 4096 + q0 + ql) * 4);
    const bf16_t* ikb = IK + (size_t)b * 4096 * 64;
    {
        constexpr unsigned CAP = 128u, NSLOT = 4u;
        LAS unsigned* AMX = (LAS unsigned*)(F.lds + LDS_B + 2048 + 1792);
        LAS unsigned* LCN = (LAS unsigned*)(F.lds + LDS_B + 2048 + 2048);
        LAS unsigned* ALQ = (LAS unsigned*)(F.lds + LDS_B + 2048 + 2304);
        LAS u64* LST = (LAS u64*)(F.lds + LDS_A);
        LAS unsigned* ZH = (LAS unsigned*)(F.lds + LDS_B + 8192);
        LAS unsigned* ZGK = (LAS unsigned*)(F.lds + LDS_B + 2048 + 3072);
        LAS unsigned* OVF = (LAS unsigned*)(F.lds + LDS_B + 2048 + 2560);
        LAS unsigned* FSL = (LAS unsigned*)(F.lds + LDS_B + 2048 + 3328);
        LAS unsigned* FQS = (LAS unsigned*)(F.lds + LDS_B + 2048 + 3840);
        LAS unsigned* NFL = (LAS unsigned*)(F.lds + LDS_B + 2048 + 3584);
        LAS float* SCB = (LAS float*)(F.lds + LDS_A + 65536);
        u64 zero64_ = 0ull; asm volatile("" : "+v"(zero64_));
        if (tid < 64) { AMX[tid] = 0u; LCN[tid] = 0u; ALQ[tid] = 0u; Need[tid] = 256u; Pq[tid] = zero64_; ZGK[tid] = 0u; FSL[tid] = 0u; }
        if (tid == 0) { OVF[0] = 0u; NFL[0] = 0u; }
#define SEL_RESCUE(Q) do { const unsigned s_ = __hip_atomic_fetch_add(NFL, 1u, __ATOMIC_RELAXED, __HIP_MEMORY_SCOPE_WORKGROUP); if (s_ < 64u) { FSL[Q] = s_ + 1u; FQS[s_] = (unsigned)(Q); } else OVF[0] = 1u; } while (0)
        for (int i = tid; i < 64 * 32; i += NTHREADS) ZH[i] = 0u;
        for (int i = tid; i < (64 * HS + 3) / 4; i += NTHREADS) ((LAS u32x4*)hist)[i] = (u32x4){0u, 0u, 0u, 0u};
        __syncthreads();
        { float am = 0.f;
          select_sweep<6>(ikb, bq, wq, kh, 2, fr, fq, true, 0u, 0u, hist, mrow, 0.f, 0.f, &am);
          am = fmaxf(am, __shfl_xor(am, 16)); am = fmaxf(am, __shfl_xor(am, 32));
          if (fq == 0) __hip_atomic_fetch_max(AMX + ql, __float_as_uint(am), __ATOMIC_RELAXED, __HIP_MEMORY_SCOPE_WORKGROUP); }
        __syncthreads();
        const float fhi = __uint_as_float(((AMX[ql] >> 23) + 2u) << 23), flo = -fhi, finv = 512.0f / fhi;
        LAS unsigned* LBN = (LAS unsigned*)(F.lds + LDS_B + 2048 + 2816);
        select_sweep<7>(ikb, bq, wq, kh, 2, fr, fq, true, 0u, 0u, hist + ql * HS, mrow, flo, finv);
        __syncthreads();
        { const unsigned nvis = 64u * (unsigned)ng; unsigned msel = (128u * 256u * 3u + nvis - 1u) / nvis + 8u;
          for (int qi = 0; qi < 8; ++qi) { const int q = 8 * w + qi; unsigned dsel, ca, csel, tall;
              const bool hit = scan_hist_row(hist + q * HS, lane, msel, dsel, ca, csel, tall);
              if (msel >= 128u) { if (lane == 0) LBN[q] = 0u; } else if (hit) LBN[q] = dsel; } }
        __syncthreads();
        for (int i = tid; i < (64 * HS + 3) / 4; i += NTHREADS) ((LAS u32x4*)hist)[i] = (u32x4){0u, 0u, 0u, 0u};
        __syncthreads();
        select_sweep<7>(ikb, bq, wq, kh, ng, fr, fq, true, LBN[ql], 0u, hist + ql * HS, mrow, flo, finv, nullptr, ZH + ql * 32);
        __syncthreads();
        for (int qi = 0; qi < 8; ++qi) {
            const int q = 8 * w + qi; unsigned dsel, ca, csel, tall;
            const bool hit = scan_hist_row(hist + q * HS, lane, 256u, dsel, ca, csel, tall);
            if (lane == 0 && tall < 256u) SEL_RESCUE(q);
            const u64 hm = __ballot(hit); const int hl = hm ? (int)__builtin_ctzll(hm) : 0;
            const unsigned bsel = (unsigned)__shfl((int)dsel, hl), bca = (unsigned)__shfl((int)ca, hl), bcs = (unsigned)__shfl((int)csel, hl);
            if (hm != 0ull) {
                const unsigned nneed = 256u - bca;
                if (lane == 0) { Pq[q] = (u64)bsel; Need[q] = nneed; }
                if (bcs == nneed) { if (lane == 0) ALQ[q] = 1u; }
                else { const float qhi = __uint_as_float(((AMX[q] >> 23) + 2u) << 23); const unsigned bz = (unsigned)(int)fminf(fmaxf((0.0f + qhi) * (512.0f / qhi), 0.f), 1023.f);
                    unsigned cl = bcs;
                    if (bsel == bz) {
                        const unsigned zz = ZH[q * 32 + (lane >> 1)], zc = (lane & 1) ? (zz >> 16) : (zz & 0xffffu);
                        unsigned incl = zc;
#pragma unroll
                        for (int off = 1; off < 64; off <<= 1) { const unsigned t = (unsigned)__shfl_up((int)incl, off); if (lane >= off) incl += t; }
                        const unsigned Z = (unsigned)__shfl((int)incl, 63);
                        const unsigned p = bcs - Z;
                        const unsigned zsel = nneed > p ? (nneed - p < Z ? nneed - p : Z) : 0u;
                        const u64 gm = __ballot(incl >= zsel && zsel != 0u); const int gl = gm ? (int)__builtin_ctzll(gm) : 0;
                        const unsigned gex = (unsigned)__shfl((int)(incl - zc), gl);
                        const unsigned G = zsel ? (unsigned)gl : 0u, kin = zsel ? zsel - gex : 0u;
                        if (lane == 0) ZGK[q] = ((G << 8) | kin) + 1u;
                        cl = p; }
                    if (cl > CAP && lane == 0) SEL_RESCUE(q); } }
        }
        __syncthreads();
        if (OVF[0] == 0u) {
            LAS u64* lrow = LST + ql * CAP;
            const unsigned zgk = ZGK[ql], fs = FSL[ql];
            select_sweep<8>(ikb, bq, wq, kh, ng, fr, fq, true, (unsigned)Pq[ql], ALQ[ql] | (zgk != 0u ? 2u : 0u), hist, mrow, flo, finv, nullptr, LCN + ql, lrow, CAP, (zgk - 1u) >> 8, (zgk - 1u) & 255u, fs, fs != 0u && fs <= NSLOT, SCB + ((fs - 1u) & (NSLOT - 1u)) * 4096u);
            asm volatile("s_waitcnt vmcnt(0)" ::: "memory");
            __syncthreads();
            for (int qi = 0; qi < 8; ++qi) {
                const int q = 8 * w + qi;
                if (ALQ[q] != 0u || FSL[q] != 0u) continue;
                const unsigned c = LCN[q], need = Need[q];
                const LAS u64* lq = LST + q * CAP;
                u64 ci[2]; unsigned rank[2];
#pragma unroll
                for (int m = 0; m < 2; ++m) { ci[m] = ((unsigned)(lane + 64 * m) < c) ? lq[lane + 64 * m] : ~0ull; rank[m] = 0u; }
                for (unsigned j = 0; j < c; ++j) { const u64 cj = lq[j];
#pragma unroll
                    for (int m = 0; m < 2; ++m) rank[m] += (cj > ci[m]) ? 1u : 0u; }
                u64* mq = MASK + (size_t)b * 64 * 4096 + (q0 + q);
#pragma unroll
                for (int m = 0; m < 2; ++m) if ((unsigned)(lane + 64 * m) < c && rank[m] < need) { const unsigned key = 4095u - (unsigned)(ci[m] & 4095ull);
                    __hip_atomic_fetch_or(mq + (size_t)(key >> 6) * 4096, 1ull << (key & 63u), __ATOMIC_RELAXED, __HIP_MEMORY_SCOPE_AGENT); }
            }
            const unsigned nfl = NFL[0];
            if ((unsigned)w < (nfl < NSLOT ? nfl : NSLOT)) { const unsigned q = FQS[w];
                select_exact_wave(SCB + w * 4096, ng, ZH + w * 256, MASK + (size_t)b * 64 * 4096 + (q0 + (int)q), lane); }
            if (__builtin_expect(nfl > NSLOT, 0))
_Pragma("unroll 1")
            for (unsigned base = NSLOT; base < nfl; base += 8u) {
                __syncthreads();
                const bool dm = fs > base && fs <= base + 8u;
                select_sweep<9>(ikb, bq, wq, kh, ng, fr, fq, true, 0u, 0u, hist, mrow, 0.f, 0.f, nullptr, nullptr, nullptr, 0u, 0u, 0u, fs, dm, (LAS float*)(F.lds + LDS_A) + ((fs - base - 1u) & 7u) * 4096u);
                __syncthreads();
                if (base + (unsigned)w < nfl) { const unsigned q = FQS[base + w];
                    select_exact_wave((LAS float*)(F.lds + LDS_A) + w * 4096, ng, ZH + w * 256, MASK + (size_t)b * 64 * 4096 + (q0 + (int)q), lane); }
            }
            __syncthreads();
            return;
        }
#undef SEL_RESCUE
    }
    if (tid < 64) { Pq[tid] = 0ull; Need[tid] = 256u; Done[tid] = 0u; Thr[tid] = 0ull; }
    if (tid == 0) NDone[0] = 0u;
    __syncthreads();
    for (int pass = 0; pass < 5; ++pass) {
        const int sh_hi = 44 - 10 * pass, wbits = sh_hi < 10 ? sh_hi : 10, sh_lo = sh_hi - wbits;
        for (int i = tid; i < (64 * HS + 3) / 4; i += NTHREADS) ((LAS u32x4*)hist)[i] = (u32x4){0u, 0u, 0u, 0u};
        __syncthreads();
        const u64 myP = Pq[ql]; const bool active = Done[ql] == 0u;
        LAS unsigned* hrow = hist + ql * HS;
        if (pass == 0) select_sweep<0>(ikb, bq, wq, kh, ng, fr, fq, active, 0u, 0u, hrow, mrow);
        else if (pass == 1) select_sweep<1>(ikb, bq, wq, kh, ng, fr, fq, active, (unsigned)myP, 0u, hrow, mrow);
        else if (pass == 2) select_sweep<2>(ikb, bq, wq, kh, ng, fr, fq, active, (unsigned)myP, 0u, hrow, mrow);
        else if (pass == 3) select_sweep<3>(ikb, bq, wq, kh, ng, fr, fq, active, (unsigned)myP, 0u, hrow, mrow);
        else select_sweep<4>(ikb, bq, wq, kh, ng, fr, fq, active, (unsigned)(myP >> 8), (unsigned)myP & 255u, hrow, mrow);
        __syncthreads();
        for (int qi = 0; qi < 8; ++qi) {
            const int q = 8 * w + qi;
            if (Done[q] != 0u) continue;
            unsigned wd[8];
#pragma unroll
            for (int i = 0; i < 8; ++i) wd[i] = hist[q * HS + 8 * lane + i];
            unsigned tot = 0;
#pragma unroll
            for (int i = 0; i < 8; ++i) tot += (wd[i] & 0xffffu) + (wd[i] >> 16);
            unsigned incl = tot;
#pragma unroll
            for (int off = 1; off < 64; off <<= 1) { const unsigned t = __shfl_down(incl, off); if (lane + off < 64) incl += t; }
            const unsigned above = incl - tot, need = Need[q];
            if (above < need && need <= incl) {
                unsigned ca = above, dsel = 0, csel = 0; bool found = false;
#pragma unroll
                for (int i = 15; i >= 0; --i) { const unsigned c = (i & 1) ? (wd[i >> 1] >> 16) : (wd[i >> 1] & 0xffffu);
                    if (!found) { if (ca + c >= need) { found = true; dsel = (unsigned)(16 * lane + i); csel = c; } else ca += c; } }
                const unsigned nneed = need - ca;
                const u64 np = (Pq[q] << wbits) | (u64)dsel;
                Pq[q] = np; Need[q] = nneed;
                if (csel == nneed || sh_lo == 0) { Done[q] = 1u; Thr[q] = np << sh_lo; __hip_atomic_fetch_add(NDone, 1u, __ATOMIC_RELAXED, __HIP_MEMORY_SCOPE_WORKGROUP); }
            }
        }
        __syncthreads();
        if (NDone[0] >= 64u) break;
    }
    const u64 thr = Thr[ql];
    select_sweep<5>(ikb, bq, wq, kh, ng, fr, fq, true, (unsigned)(thr >> 12), (unsigned)thr & 4095u, hist, mrow);
    __syncthreads();
}

__device__ __forceinline__ void knorm_item(const Frame& F, const bf16_t* __restrict__ Kt, float* __restrict__ out) {
    const int lane = lane_id_fresh(), tid = F.wave * 64 + lane;
    float mx = 0.f;
    for (int r = tid; r < 2048; r += NTHREADS) {
        const u32x4* p = (const u32x4*)(Kt + (size_t)r * 64); float s = 0.f;
#pragma unroll
        for (int c = 0; c < 8; ++c) { const u32x4 v = p[c];
            s += bf_lo(v.x) * bf_lo(v.x) + bf_hi(v.x) * bf_hi(v.x) + bf_lo(v.y) * bf_lo(v.y) + bf_hi(v.y) * bf_hi(v.y) + bf_lo(v.z) * bf_lo(v.z) + bf_hi(v.z) * bf_hi(v.z) + bf_lo(v.w) * bf_lo(v.w) + bf_hi(v.w) * bf_hi(v.w); }
        mx = fmaxf(mx, s);
    }
    mx = wave_max(mx);
    LAS float* red = (LAS float*)(F.lds + LDS_B + 6144);
    if (lane == 0) red[F.wave] = mx;
    __syncthreads();
    if (tid == 0) { float m = red[0];
#pragma unroll
        for (int i = 1; i < NWAVES; ++i) m = fmaxf(m, red[i]);
        *out = m; }
    __syncthreads();
}
typedef float f32x16 __attribute__((ext_vector_type(16)));
__device__ __forceinline__ float fadd_s(float a, float b) { float r; asm("v_add_f32 %0, %1, %2" : "=v"(r) : "v"(a), "v"(b)); return r; }
template <bool DSA>
__device__ __forceinline__ void attn_item(const Frame& F, int b, int hsel, int QB, const bf16_t* __restrict__ Qg, const bf16_t* __restrict__ Kg, const bf16_t* __restrict__ VTg,
                                          const u64* __restrict__ MASK, bf16_t* __restrict__ MIX, float lam, float lam_init, const float* __restrict__ subln_g, const float* __restrict__ KN) {
    constexpr int NDB = DSA ? 2 : 4;
    constexpr float THR = 6.0f;
    const int lane = lane_id_fresh(), w = WAVE_FRESH(), tid = w * 64 + lane, st = w >> 2, wq = w & 3, r32 = lane & 31, hh = lane >> 5;
    const int q0 = QB * 128, tq = q0 + 32 * wq + r32, nt = 2 * QB + 2, mychunk = 2 * QB + (wq >> 1);
    const int head = 2 * hsel + st;
    const float slope = DSA ? exp2f(-(float)(head + 1)) : exp2f(-2.0f * (float)(hsel + 1));
    const float SL = slope * LOG2E;
    LAS int* DN = (LAS int*)(F.lds + LDS_B + 4096);
    if (lane == 0) DN[w] = -1;
    int mydn = -1;
    const int lrow = 8 * w + (lane >> 3), lc = (lane & 7) ^ ((lrow >> 1) & 7);
    const unsigned koff = (unsigned)(lrow * 64 + lc * 8) * 2u, voff = (unsigned)(lrow * 4096 + lc * 8) * 2u;
    const unsigned char* gb[4];
    gb[0] = (const unsigned char*)(Kg + ((size_t)((b * 8 + 2 * hsel + 0) * 4096)) * 64);
    gb[1] = (const unsigned char*)(Kg + ((size_t)((b * 8 + 2 * hsel + 1) * 4096)) * 64);
    if (DSA) { gb[2] = (const unsigned char*)(VTg + ((size_t)((b * 8 + 2 * hsel + 0) * 64)) * 4096); gb[3] = (const unsigned char*)(VTg + ((size_t)((b * 8 + 2 * hsel + 1) * 64)) * 4096); }
    else     { gb[2] = (const unsigned char*)(VTg + ((size_t)((b * 4 + hsel) * 128)) * 4096);         gb[3] = (const unsigned char*)(VTg + ((size_t)((b * 4 + hsel) * 128 + 64)) * 4096); }
    const u64* mgsrc = DSA ? (MASK + ((size_t)b * 64 * 4096 + q0) + 2 * lane) : nullptr;
    LAS unsigned char* const ring = F.lds + LDS_A + w * 1024;
    LAS unsigned char* const mring = F.lds + LDS_B + 12288;
#ifdef PROBE_DMA2
#define ATT_REP_ 2
#else
#define ATT_REP_ 1
#endif
#define ATT_ISSUE(TT, STG) do { const int tt_ = (TT) < 0 ? 0 : (TT); \
        _Pragma("unroll") for (int rr_ = 0; rr_ < ATT_REP_; ++rr_) _Pragma("unroll") for (int i_ = 0; i_ < 4; ++i_) __builtin_amdgcn_global_load_lds((const unsigned*)(gb[i_] + (i_ < 2 ? (size_t)tt_ * 8192 : (size_t)tt_ * 128) + (i_ < 2 ? koff : voff)), (LAS unsigned*)(ring + (STG) * 32768 + i_ * 8192), 16, 0, 0); \
        if (DSA && w == 0) __builtin_amdgcn_global_load_lds((const unsigned*)(mgsrc + (size_t)tt_ * 4096), (LAS unsigned*)(mring + (STG) * 1024), 16, 0, 0); } while (0)
    const int swz = (r32 >> 1) & 7;
    const int kbase = st * 8192 + r32 * 128, vbase = 16384 + ((DSA ? st * 64 : 0) + r32) * 128;
    f32x16 o[NDB];
#pragma unroll
    for (int i = 0; i < NDB; ++i)
#pragma unroll
        for (int r = 0; r < 16; ++r) o[i][r] = 0.f;
    float mref = -INFINITY, lsum = 0.f;
    float one_ = 1.0f; asm volatile("" : "+v"(one_));
    ATT_ISSUE(nt - 1, 0); ATT_ISSUE(nt - 2, 1);
    bf16x8 qf[4];
    { const bf16_t* qp = Qg + ((size_t)((b * 8 + head) * 4096 + tq)) * 64 + 8 * hh;
#pragma unroll
      for (int ks = 0; ks < 4; ++ks) qf[ks] = *(const bf16x8*)(qp + 16 * ks); }
    float BQK;
    { float q2 = 0.f;
#pragma unroll
      for (int ks = 0; ks < 4; ++ks) { const u32x4 qw = __builtin_bit_cast(u32x4, qf[ks]);
          q2 += bf_lo(qw.x) * bf_lo(qw.x) + bf_hi(qw.x) * bf_hi(qw.x) + bf_lo(qw.y) * bf_lo(qw.y) + bf_hi(qw.y) * bf_hi(qw.y) + bf_lo(qw.z) * bf_lo(qw.z) + bf_hi(qw.z) * bf_hi(qw.z) + bf_lo(qw.w) * bf_lo(qw.w) + bf_hi(qw.w) * bf_hi(qw.w); }
      q2 += __shfl_xor(q2, 32);
#pragma unroll
      for (int o = 1; o < 32; o <<= 1) q2 = fmaxf(q2, __shfl_xor(q2, o));
      const float* knp = KN + ((b * 16 + (DSA ? 8 : 0) + head) * 2);
      BQK = sqrtf(q2) * sqrtf(fmaxf(knp[0], knp[1])) * 1.0001f + 0.01f; }
    asm volatile("" : "+v"(BQK));
    for (int ip = 0; ip < nt / 2; ++ip) {
        asm volatile("s_waitcnt vmcnt(0)" ::: "memory");
        __builtin_amdgcn_s_barrier();
        asm volatile("" ::: "memory");
        if (ip > 0) {
            const u32x4 d0 = *(const LAS u32x4*)DN, d1 = *(const LAS u32x4*)(DN + 4);
            const int dm = min(min(min((int)d0.x, (int)d0.y), min((int)d0.z, (int)d0.w)), min(min((int)d1.x, (int)d1.y), min((int)d1.z, (int)d1.w)));
            if (dm >= nt - 1 - 2 * ip) break;
        }
        if (ip + 1 < nt / 2) { ATT_ISSUE(nt - 3 - 2 * ip, 2 * ((ip + 1) & 1)); ATT_ISSUE(nt - 4 - 2 * ip, 2 * ((ip + 1) & 1) + 1); }
#pragma unroll
        for (int sub = 0; sub < 2; ++sub) {
        const int t = nt - 1 - 2 * ip - sub, stg = 2 * (ip & 1) + sub;
        LAS unsigned char* sb = F.lds + LDS_A + stg * 32768;
        if (t <= mychunk && t > mydn) {
            bf16x8 pb[4];
            bf16x8 kf[8];
#pragma unroll
            for (int kb = 0; kb < 2; ++kb)
#pragma unroll
                for (int ks = 0; ks < 4; ++ks) kf[kb * 4 + ks] = *(const LAS bf16x8*)(sb + kbase + kb * 4096 + (((2 * ks + hh) ^ swz) << 4));
            const bool unset = (mref == -INFINITY);
            const float mr = unset ? 0.f : mref;
            const float relq = (float)(tq - 64 * t - 4 * hh);
            unsigned mlo = 0u, mhi = 0u;
            if (DSA) { const u64 mw = *(const LAS u64*)(mring + stg * 1024 + (32 * wq + r32) * 8) >> (4 * hh); mlo = (unsigned)mw; mhi = (unsigned)(mw >> 32); }
            f32x16 s[2];
            if (t == mychunk) {
#pragma unroll
                for (int kb = 0; kb < 2; ++kb)
#pragma unroll
                    for (int r = 0; r < 16; ++r) { const float c = (float)(32 * kb + (r & 3) + 8 * (r >> 2)); s[kb][r] = -SL * fabsf(relq - c) - mr; }
            } else {
                const float B0 = -SL * relq - mr, SL8 = 8.0f * SL;
                float gb_ = B0;
#pragma unroll
                for (int kb = 0; kb < 2; ++kb)
#pragma unroll
                    for (int g4 = 0; g4 < 4; ++g4) {
                        float e_ = gb_; s[kb][4 * g4] = e_;
#pragma unroll
                        for (int j = 1; j < 4; ++j) { e_ = fadd_s(e_, SL); s[kb][4 * g4 + j] = e_; }
                        gb_ = fadd_s(gb_, SL8);
                    }
            }
            if (DSA) {
#pragma unroll
                for (int kb = 0; kb < 2; ++kb)
#pragma unroll
                    for (int r = 0; r < 16; ++r) { const int tm = __builtin_amdgcn_sbfe((int)(kb ? mhi : mlo), (r & 3) + 8 * (r >> 2), 1);
                        const float sv = s[kb][r]; s[kb][r] = __int_as_float((__float_as_int(sv) & tm) | (~tm & (int)0xff800000)); }
            }
#pragma unroll
            for (int kb = 0; kb < 2; ++kb)
#pragma unroll
                for (int ks = 0; ks < 4; ++ks) s[kb] = __builtin_amdgcn_mfma_f32_32x32x16_bf16(kf[kb * 4 + ks], qf[ks], s[kb], 0, 0, 0);
            __builtin_amdgcn_sched_group_barrier(0x100, 4, 0);
#pragma unroll
            for (int i = 0; i < 4; ++i) { __builtin_amdgcn_sched_group_barrier(0x008, 1, 0); __builtin_amdgcn_sched_group_barrier(0x100, 1, 0); }
            __builtin_amdgcn_sched_group_barrier(0x008, 4, 0);
            float mx = -INFINITY;
#pragma unroll
            for (int kb = 0; kb < 2; ++kb)
#pragma unroll
                for (int r = 0; r < 16; ++r) mx = fmaxf(mx, s[kb][r]);
            mx = xhalf_max(mx);
            const bool need = unset ? (mx != -INFINITY) : (mx > THR);
            if (__any(need)) {
                const float delta = need ? mx : 0.f;
                const float scl = (unset || !need) ? 1.f : __builtin_amdgcn_exp2f(-delta);
#pragma unroll
                for (int kb = 0; kb < 2; ++kb)
#pragma unroll
                    for (int r = 0; r < 16; ++r) s[kb][r] -= delta;
#pragma unroll
                for (int i = 0; i < NDB; ++i)
#pragma unroll
                    for (int r = 0; r < 16; ++r) o[i][r] *= scl;
                lsum *= scl;
                mref = need ? (mr + delta) : mref;
            }
            float ps0 = 0.f, ps1 = 0.f;
#pragma unroll
            for (int r = 0; r < 16; ++r) { const float p0 = __builtin_amdgcn_exp2f(s[0][r]), p1 = __builtin_amdgcn_exp2f(s[1][r]); s[0][r] = p0; s[1][r] = p1; ps0 += p0; ps1 = __builtin_fmaf(p1, one_, ps1); }
            lsum += ps0 + ps1;
#pragma unroll
            for (int kb = 0; kb < 2; ++kb)
#pragma unroll
                for (int s2 = 0; s2 < 2; ++s2) {
                    u32x4 pk; pk.x = cvt_pk_bf16(s[kb][8 * s2 + 0], s[kb][8 * s2 + 1]); pk.y = cvt_pk_bf16(s[kb][8 * s2 + 2], s[kb][8 * s2 + 3]);
                    pk.z = cvt_pk_bf16(s[kb][8 * s2 + 4], s[kb][8 * s2 + 5]); pk.w = cvt_pk_bf16(s[kb][8 * s2 + 6], s[kb][8 * s2 + 7]);
                    pb[2 * kb + s2] = __builtin_bit_cast(bf16x8, pk);
                }
#pragma unroll
            for (int db = 0; db < NDB; ++db)
#pragma unroll
                for (int sg = 0; sg < 4; ++sg) {
                    const bf16x8 a = *(const LAS bf16x8*)(sb + vbase + db * 4096 + (((2 * sg + hh) ^ swz) << 4));
                    o[db] = __builtin_amdgcn_mfma_f32_32x32x16_bf16(a, pb[sg], o[db], 0, 0, 0);
                }
            __builtin_amdgcn_sched_group_barrier(0x100, 4, 1);
#pragma unroll
            for (int i = 0; i < 4 * NDB - 4; ++i) { __builtin_amdgcn_sched_group_barrier(0x008, 1, 1); __builtin_amdgcn_sched_group_barrier(0x100, 1, 1); }
            __builtin_amdgcn_sched_group_barrier(0x008, 4, 1);
            if (t > 0) {
                const float dmin = (float)(q0 + 32 * wq - 64 * t + 1);
                const bool okk = (mref != -INFINITY) && (BQK - SL * dmin - mref < -150.0f);
                if (__all(okk)) { mydn = t - 1; if (lane == 0) DN[w] = t - 1; }
            }
        }
        }
    }
    asm volatile("s_waitcnt vmcnt(0)" ::: "memory");
#undef ATT_ISSUE
    __syncthreads();
    lsum += __shfl_xor(lsum, 32);
    const float inv = 1.0f / lsum;
    const size_t tok = (size_t)b * 4096 + tq;
    if (DSA) {
#pragma unroll
        for (int db = 0; db < NDB; ++db)
#pragma unroll
            for (int g4 = 0; g4 < 4; g4 += 2) {
                const float z = inv;
                u32x2 pa, pb2;
                pa.x = cvt_pk_bf16(o[db][4 * g4 + 0] * z, o[db][4 * g4 + 1] * z); pa.y = cvt_pk_bf16(o[db][4 * g4 + 2] * z, o[db][4 * g4 + 3] * z);
                pb2.x = cvt_pk_bf16(o[db][4 * g4 + 4] * z, o[db][4 * g4 + 5] * z); pb2.y = cvt_pk_bf16(o[db][4 * g4 + 6] * z, o[db][4 * g4 + 7] * z);
                { auto r_ = __builtin_amdgcn_permlane32_swap(pa.x, pb2.x, false, false); pa.x = r_[0]; pb2.x = r_[1]; }
                { auto r_ = __builtin_amdgcn_permlane32_swap(pa.y, pb2.y, false, false); pa.y = r_[0]; pb2.y = r_[1]; }
                *(u32x4*)(MIX + tok * D + 512 + head * 64 + 32 * db + 8 * g4 + 8 * hh) = (u32x4){pa.x, pa.y, pb2.x, pb2.y}; }
    } else {
        LAS float* XB = (LAS float*)(F.lds + LDS_A);
        const int xq = (32 * wq + r32) * 132 + 4 * hh;
        if (st == 1) {
#pragma unroll
            for (int db = 0; db < NDB; ++db)
#pragma unroll
                for (int g4 = 0; g4 < 4; ++g4) *(LAS f32x4*)(XB + xq + 32 * db + 8 * g4) = (f32x4){o[db][4 * g4] * inv, o[db][4 * g4 + 1] * inv, o[db][4 * g4 + 2] * inv, o[db][4 * g4 + 3] * inv};
        }
        __syncthreads();
        if (st == 0) {
            float ss = 0.f;
#pragma unroll
            for (int db = 0; db < NDB; ++db)
#pragma unroll
                for (int g4 = 0; g4 < 4; ++g4) { const f32x4 o1 = *(const LAS f32x4*)(XB + xq + 32 * db + 8 * g4);
#pragma unroll
                    for (int j = 0; j < 4; ++j) { const float a = o[db][4 * g4 + j] * inv - o1[j] * lam; o[db][4 * g4 + j] = a; ss += a * a; } }
            ss += __shfl_xor(ss, 32);
            const float rn = (1.0f / sqrtf(ss * (1.0f / 128.0f) + LN_EPS)) * (1.0f - lam_init);
#pragma unroll
            for (int db = 0; db < NDB; ++db)
#pragma unroll
                for (int g4 = 0; g4 < 4; g4 += 2) { const f32x4 ga = *(const f32x4*)(subln_g + 32 * db + 8 * g4 + 4 * hh), gb = *(const f32x4*)(subln_g + 32 * db + 8 * g4 + 8 + 4 * hh);
                    u32x2 pa, pb2;
                    pa.x = cvt_pk_bf16(o[db][4 * g4 + 0] * rn * ga[0], o[db][4 * g4 + 1] * rn * ga[1]); pa.y = cvt_pk_bf16(o[db][4 * g4 + 2] * rn * ga[2], o[db][4 * g4 + 3] * rn * ga[3]);
                    pb2.x = cvt_pk_bf16(o[db][4 * g4 + 4] * rn * gb[0], o[db][4 * g4 + 5] * rn * gb[1]); pb2.y = cvt_pk_bf16(o[db][4 * g4 + 6] * rn * gb[2], o[db][4 * g4 + 7] * rn * gb[3]);
                    { auto r_ = __builtin_amdgcn_permlane32_swap(pa.x, pb2.x, false, false); pa.x = r_[0]; pb2.x = r_[1]; }
                    { auto r_ = __builtin_amdgcn_permlane32_swap(pa.y, pb2.y, false, false); pa.y = r_[0]; pb2.y = r_[1]; }
                    *(u32x4*)(MIX + tok * D + hsel * 128 + 32 * db + 8 * g4 + 8 * hh) = (u32x4){pa.x, pa.y, pb2.x, pb2.y}; }
        }
        __syncthreads();
    }
}
struct CandTab { unsigned char a[52], b[52]; };
__host__ __device__ constexpr CandTab make_cand_tab() {
    CandTab t{}; int n = 0;
    for (int a = 0; a < 16; ++a) for (int b = 0; b < 16; ++b) if ((a + 1) * (b + 1) <= 16) { t.a[n] = (unsigned char)a; t.b[n] = (unsigned char)b; ++n; }
    for (; n < 52; ++n) { t.a[n] = 0; t.b[n] = 0; }
    return t;
}
constexpr CandTab CAND = make_cand_tab();
constexpr int NCAND = 50;

#define PK_CEX(A, B) do { const unsigned hi_ = (A) > (B) ? (A) : (B), lo_ = (A) > (B) ? (B) : (A); (A) = hi_; (B) = lo_; } while (0)
__device__ __forceinline__ void pk_bitonic_merge16(unsigned (&x)[16]) {
#pragma unroll
    for (int j = 8; j >= 1; j >>= 1)
#pragma unroll
        for (int i = 0; i < 16; ++i) { const int l = i ^ j; if (l > i) PK_CEX(x[i], x[l]); }
}
__device__ __forceinline__ void pk_sort16(unsigned (&x)[16]) {
#pragma unroll
    for (int p = 1; p < 16; p <<= 1)
#pragma unroll
        for (int k = p; k >= 1; k >>= 1)
#pragma unroll
            for (int j = k % p; j + k < 16; j += 2 * k)
#pragma unroll
                for (int i = 0; i < k; ++i)
                    if (i + j + k < 16 && (i + j) / (2 * p) == (i + j + k) / (2 * p)) PK_CEX(x[i + j], x[i + j + k]);
}
template <int XM>
__device__ __forceinline__ void pk_merge_lanes16(unsigned (&x)[16]) {
    unsigned y[16];
#pragma unroll
    for (int i = 0; i < 16; ++i) y[i] = (unsigned)__shfl_xor((int)x[15 - i], XM);
#pragma unroll
    for (int i = 0; i < 16; ++i) x[i] = x[i] > y[i] ? x[i] : y[i];
    pk_bitonic_merge16(x);
}
__device__ __forceinline__ void peer_topk_phase(const Frame& F, const bf16_t* __restrict__ PQ, const bf16_t* __restrict__ SUBK_l, int* __restrict__ EG) {
    const int lane = lane_id_fresh(), w = WAVE_FRESH(), tid = w * 64 + lane, fr = lane & 15, fq = lane >> 4;
    LAS unsigned char* sk = F.lds + LDS_A;
    LAS unsigned* LST = (LAS unsigned*)(F.lds + LDS_A + 65536) + w * 512;
#pragma unroll 1
    for (int lg = F.wg; lg < 256; lg += F.G) {
    const int pm = 16 * (lg & 7) + (lg >> 4), par = (lg >> 3) & 1;
#pragma unroll 1
    for (int hi = 0; hi < 4; ++hi) {
    const int h = par + 2 * hi;
    __syncthreads();
#pragma unroll
    for (int i = 0; i < 8; ++i) { const int id = tid + 512 * i, cs = id >> 11, row = (id >> 4) & 127, c16 = id & 15;
        const u32x4 v = *(const u32x4*)(SUBK_l + ((size_t)((h * 2 + cs) * 128 + row)) * 128 + c16 * 8);
        *(LAS u32x4*)(sk + cs * 32768 + row * 256 + ((c16 ^ (row & 15)) << 4)) = v; }
    __syncthreads();
    for (int it = 0; it < 2; ++it) {
        const int tt = 16 * pm + 2 * w + it, token = tt * 16 + fr;
#pragma unroll 1
        for (int cs = 0; cs < 2; ++cs) {
            bf16x8 qf[4];
#pragma unroll
            for (int ks = 0; ks < 4; ++ks) qf[ks] = *(const bf16x8*)(PQ + (size_t)(h >> 1) * PQ_PLANE + (size_t)token * 512 + (h & 1) * 256 + cs * 128 + 32 * ks + 8 * fq);
            unsigned x0[16], x1[16];
#pragma unroll
            for (int kt = 0; kt < 8; ++kt) {
                f32x4 sc = (f32x4){0.f, 0.f, 0.f, 0.f};
#pragma unroll
                for (int ks = 0; ks < 4; ++ks) { const int row = 16 * kt + fr, c16 = ks * 4 + fq;
                    const bf16x8 a = *(const LAS bf16x8*)(sk + cs * 32768 + row * 256 + ((c16 ^ (row & 15)) << 4));
                    sc = __builtin_amdgcn_mfma_f32_16x16x32_bf16(a, qf[ks], sc, 0, 0, 0); }
#pragma unroll
                for (int r = 0; r < 4; ++r) { const unsigned key = (f2sort(sc[r]) & ~127u) | (unsigned)(127 - (16 * kt + 4 * fq + r));
                    if (kt < 4) x0[kt * 4 + r] = key; else x1[(kt - 4) * 4 + r] = key; }
            }
            pk_sort16(x0); pk_sort16(x1);
#pragma unroll
            for (int i = 0; i < 16; ++i) x0[i] = x0[i] > x1[15 - i] ? x0[i] : x1[15 - i];
            pk_bitonic_merge16(x0);
            pk_merge_lanes16<16>(x0);
            pk_merge_lanes16<32>(x0);
            if (fq == 0) {
#pragma unroll
                for (int i = 0; i < 4; ++i) *(LAS u32x4*)(LST + cs * 256 + fr * 16 + 4 * i) = (u32x4){x0[4 * i], x0[4 * i + 1], x0[4 * i + 2], x0[4 * i + 3]};
            }
        }
        LDS_WAIT();
        unsigned win[16];
#pragma unroll
        for (int t = 0; t < 16; ++t) win[t] = 0u;
#pragma unroll
        for (int t = 0; t < 13; ++t) {
            const int a = fq == 0 ? CAND.a[t] : fq == 1 ? CAND.a[13 + t] : fq == 2 ? CAND.a[26 + t] : CAND.a[39 + t];
            const int bb = fq == 0 ? CAND.b[t] : fq == 1 ? CAND.b[13 + t] : fq == 2 ? CAND.b[26 + t] : CAND.b[39 + t];
            const unsigned k1 = LST[fr * 16 + a], k2 = LST[256 + fr * 16 + bb];
            const float cv = sort2f(k1 & ~127u) + sort2f(k2 & ~127u);
            const unsigned key = (f2sort(cv) & ~255u) | (unsigned)(255 - (a * 16 + bb));
            win[t] = (fq * 13 + t < NCAND) ? key : 0u;
        }
        pk_sort16(win);
        pk_merge_lanes16<16>(win);
        pk_merge_lanes16<32>(win);
        const float v0 = sort2f(win[0] & ~255u);
        float ev[16], es = 0.f;
#pragma unroll
        for (int k = 0; k < 16; ++k) { ev[k] = __expf(sort2f(win[k] & ~255u) - v0); es += ev[k]; }
        const float rs = 1.0f / es;
        int* egp = EG + ((size_t)token * 128 + h * 16) * 2;
#pragma unroll
        for (int k = 0; k < 16; ++k) {
            if ((k >> 2) == fq) {
                const unsigned flat = 255u - (win[k] & 255u), a = flat >> 4, bb = flat & 15u;
                const unsigned i1 = 127u - (LST[fr * 16 + a] & 127u), i2 = 127u - (LST[256 + fr * 16 + bb] & 127u);
                u32x2 e; e.x = i1 * 128u + i2; e.y = __float_as_uint(ev[k] * rs);
                *(u32x2*)(egp + 2 * k) = e;
            }
        }
        LDS_WAIT();
    }
    }
    }
    __syncthreads();
}

__device__ __forceinline__ float cvt_ubyte(unsigned x, int k) {
    float r;
    if (k == 0) asm("v_cvt_f32_ubyte0 %0, %1" : "=v"(r) : "v"(x));
    else if (k == 1) asm("v_cvt_f32_ubyte1 %0, %1" : "=v"(r) : "v"(x));
    else if (k == 2) asm("v_cvt_f32_ubyte2 %0, %1" : "=v"(r) : "v"(x));
    else asm("v_cvt_f32_ubyte3 %0, %1" : "=v"(r) : "v"(x));
    return r;
}
__device__ __forceinline__ void peer_gather_phase(const Frame& F, const bf16_t* __restrict__ H1, const int* __restrict__ EG, const unsigned char* __restrict__ U8, const unsigned char* __restrict__ V8,
                                                  const float* __restrict__ USC, const float* __restrict__ VSC, bf16_t* __restrict__ R2) {
    const int lane = lane_id_fresh(), w = WAVE_FRESH(), fr = lane & 15, fq = lane >> 4;
    LAS unsigned char* wl = F.lds + LDS_A + w * 12288;
    LAS float* WL16 = (LAS float*)(wl + 4096);
    LAS unsigned char* XS = wl; LAS float* WL = (LAS float*)(wl + 1024); LAS int* EL = (LAS int*)(wl + 1536); LAS float* USL = (LAS float*)(wl + 2048); LAS float* VSL = (LAS float*)(wl + 2560);
    for (int gwi = (F.G == 256 ? 256 * (F.wg & 7) + 8 * (F.wg >> 3) + w : F.wg * NWAVES + w); gwi < T / 16; gwi += (F.G == 256 ? T / 16 : F.G * NWAVES)) {
    for (int it = 0; it < 16; ++it) {
        const int token = gwi * 16 + it;
        const int* eg = EG + (size_t)token * 256;
        unsigned uoff[8];
#pragma unroll
        for (int hh = 0; hh < 8; ++hh) uoff[hh] = (unsigned)eg[(hh * 16 + fr) * 2] * 512u + 16u * fq;
        const int e0 = eg[lane * 2], e1 = eg[(64 + lane) * 2];
        const float us0 = USC[e0], us1 = USC[e1], vs0 = VSC[e0], vs1 = VSC[e1], g0 = __int_as_float(eg[lane * 2 + 1]), g1 = __int_as_float(eg[(64 + lane) * 2 + 1]);
        const u32x4 x0 = *(const u32x4*)(H1 + (size_t)token * D + 16 * lane), x1 = *(const u32x4*)(H1 + (size_t)token * D + 16 * lane + 8);
        float xf[16] = {bf_lo(x0.x), bf_hi(x0.x), bf_lo(x0.y), bf_hi(x0.y), bf_lo(x0.z), bf_hi(x0.z), bf_lo(x0.w), bf_hi(x0.w), bf_lo(x1.x), bf_hi(x1.x), bf_lo(x1.y), bf_hi(x1.y), bf_lo(x1.z), bf_hi(x1.z), bf_lo(x1.w), bf_hi(x1.w)};
        float am = 0.f;
#pragma unroll
        for (int i = 0; i < 16; ++i) am = fmaxf(am, fabsf(xf[i]));
        am = wave_max(am);
        const float xinv = am > 0.f ? am * (1.0f / 127.0f) : 1.0f, xsc = 1.0f / xinv;
        int xsum = 0;
        { unsigned xp[4] = {0u, 0u, 0u, 0u};
#pragma unroll
          for (int i = 0; i < 16; ++i) { int q = (int)rintf(xf[i] * xsc); q = q < -127 ? -127 : (q > 127 ? 127 : q); xsum += q; xp[i >> 2] |= ((unsigned)q & 0xffu) << (8 * (i & 3)); }
          *(LAS u32x4*)(XS + 16 * lane) = (u32x4){xp[0], xp[1], xp[2], xp[3]}; }
        xsum = wave_sum_i(xsum);
        LDS_WAIT();
        typedef int i32x4 __attribute__((ext_vector_type(4)));
        i32x4 acc[8];
#pragma unroll
        for (int hh = 0; hh < 8; ++hh) acc[hh] = (i32x4){0, 0, 0, 0};
#define U_LOAD(SET, P) do { _Pragma("unroll") for (int hh = 0; hh < 8; ++hh) SET[hh] = *(const u32x4*)(U8 + uoff[hh] + 64 * (P)); } while (0)
#define U_MMA(SET, P) do { const i32x4 xb0 = *(const LAS i32x4*)(XS + 128 * (P) + 32 * fq), xb1 = *(const LAS i32x4*)(XS + 128 * (P) + 32 * fq + 16); \
            _Pragma("unroll") for (int hh = 0; hh < 8; ++hh) { \
                const i32x4 a0 = (i32x4){(int)(SET[hh].x & 0x0f0f0f0fu), (int)(SET[hh].y & 0x0f0f0f0fu), (int)((SET[hh].x >> 4) & 0x0f0f0f0fu), (int)((SET[hh].y >> 4) & 0x0f0f0f0fu)}; \
                const i32x4 a1 = (i32x4){(int)(SET[hh].z & 0x0f0f0f0fu), (int)(SET[hh].w & 0x0f0f0f0fu), (int)((SET[hh].z >> 4) & 0x0f0f0f0fu), (int)((SET[hh].w >> 4) & 0x0f0f0f0fu)}; \
                acc[hh] = __builtin_amdgcn_mfma_i32_16x16x64_i8(a0, xb0, acc[hh], 0, 0, 0); \
                acc[hh] = __builtin_amdgcn_mfma_i32_16x16x64_i8(a1, xb1, acc[hh], 0, 0, 0); } } while (0)
        u32x4 ua[8], ub[8];
        U_LOAD(ua, 0); U_LOAD(ub, 1);
#pragma unroll 1
        for (int p = 0; p < 6; p += 2) {
            U_MMA(ua, p); U_LOAD(ua, p + 2);
            U_MMA(ub, p + 1); U_LOAD(ub, p + 3);
        }
        U_MMA(ua, 6); U_MMA(ub, 7);
#undef U_LOAD
#undef U_MMA
        LAS int* AL = (LAS int*)(wl + 1536);
        if (fr == 0) {
#pragma unroll
            for (int hh = 0; hh < 8; ++hh) *(LAS i32x4*)(AL + hh * 16 + 4 * fq) = acc[hh];
        }
        LDS_WAIT();
        { const float d0 = ((float)AL[lane] - 7.5f * (float)xsum) * us0 * xinv, d1 = ((float)AL[64 + lane] - 7.5f * (float)xsum) * us1 * xinv;
          WL16[it * 128 + lane] = g0 * (0.5f * d0 * (1.0f + erff(d0 * 0.70710678118654752f))) * vs0;
          WL16[it * 128 + 64 + lane] = g1 * (0.5f * d1 * (1.0f + erff(d1 * 0.70710678118654752f))) * vs1; }
        LDS_WAIT();
    }
    for (int it = 0; it < 16; ++it) {
        const int token = gwi * 16 + it;
        const int* eg = EG + (size_t)token * 256;
        const int e0 = eg[lane * 2], e1 = eg[(64 + lane) * 2];
        const u32x4 x0 = *(const u32x4*)(H1 + (size_t)token * D + 16 * lane), x1 = *(const u32x4*)(H1 + (size_t)token * D + 16 * lane + 8);
        const float xf[16] = {bf_lo(x0.x), bf_hi(x0.x), bf_lo(x0.y), bf_hi(x0.y), bf_lo(x0.z), bf_hi(x0.z), bf_lo(x0.w), bf_hi(x0.w), bf_lo(x1.x), bf_hi(x1.x), bf_lo(x1.y), bf_hi(x1.y), bf_lo(x1.z), bf_hi(x1.z), bf_lo(x1.w), bf_hi(x1.w)};
        LAS float* WL = WL16 + it * 128;
        f32x2 o2[8];
#pragma unroll
        for (int i = 0; i < 8; ++i) o2[i] = (f32x2){0.f, 0.f};
        const float wr0 = WL[lane], wr1 = WL[64 + lane];
        const unsigned vlane = 8u * (unsigned)lane;

#define V_LOAD(SET, EREG, S0) do { _Pragma("unroll") for (int i = 0; i < 16; ++i) { const unsigned e = (unsigned)__builtin_amdgcn_readlane(EREG, (S0) + i); \
            SET[i] = *(const u32x2*)(V8 + (size_t)e * 512u + vlane); } } while (0)
#define V_FMA(SET, WREG, S0) do { _Pragma("unroll") for (int i = 0; i < 16; ++i) { const float ws = __builtin_bit_cast(float, __builtin_amdgcn_readlane(__builtin_bit_cast(int, WREG), (S0) + i)); \
              \
            const f32x2 w2_ = (f32x2){ws, ws}; \
            o2[0] = w2_ * __builtin_amdgcn_cvt_scalef32_pk_f32_fp4(SET[i].x, 1.0f, 0) + o2[0]; o2[1] = w2_ * __builtin_amdgcn_cvt_scalef32_pk_f32_fp4(SET[i].x, 1.0f, 1) + o2[1]; \
            o2[2] = w2_ * __builtin_amdgcn_cvt_scalef32_pk_f32_fp4(SET[i].x, 1.0f, 2) + o2[2]; o2[3] = w2_ * __builtin_amdgcn_cvt_scalef32_pk_f32_fp4(SET[i].x, 1.0f, 3) + o2[3]; \
            o2[4] = w2_ * __builtin_amdgcn_cvt_scalef32_pk_f32_fp4(SET[i].y, 1.0f, 0) + o2[4]; o2[5] = w2_ * __builtin_amdgcn_cvt_scalef32_pk_f32_fp4(SET[i].y, 1.0f, 1) + o2[5]; \
            o2[6] = w2_ * __builtin_amdgcn_cvt_scalef32_pk_f32_fp4(SET[i].y, 1.0f, 2) + o2[6]; o2[7] = w2_ * __builtin_amdgcn_cvt_scalef32_pk_f32_fp4(SET[i].y, 1.0f, 3) + o2[7]; } } while (0)
        u32x2 va[16], vb2[16];
        V_LOAD(va, e0, 0); V_LOAD(vb2, e0, 16);
        V_FMA(va, wr0, 0); V_LOAD(va, e0, 32); V_FMA(vb2, wr0, 16); V_LOAD(vb2, e0, 48);
        V_FMA(va, wr0, 32); V_LOAD(va, e1, 0); V_FMA(vb2, wr0, 48); V_LOAD(vb2, e1, 16);
        V_FMA(va, wr1, 0); V_LOAD(va, e1, 32); V_FMA(vb2, wr1, 16); V_LOAD(vb2, e1, 48);
        V_FMA(va, wr1, 32); V_FMA(vb2, wr1, 48);
#undef V_LOAD
#undef V_FMA
        float out[16];
#pragma unroll
        for (int i = 0; i < 16; ++i) out[i] = o2[i >> 1][i & 1];
#ifdef PROBE_ZERO_PEER
#pragma unroll
        for (int i = 0; i < 16; ++i) out[i] = 0.f;
#endif
        u32x4 r0, r1;
        r0.x = cvt_pk_bf16(ALPHA * xf[0] + out[0], ALPHA * xf[1] + out[1]); r0.y = cvt_pk_bf16(ALPHA * xf[2] + out[2], ALPHA * xf[3] + out[3]);
        r0.z = cvt_pk_bf16(ALPHA * xf[4] + out[4], ALPHA * xf[5] + out[5]); r0.w = cvt_pk_bf16(ALPHA * xf[6] + out[6], ALPHA * xf[7] + out[7]);
        r1.x = cvt_pk_bf16(ALPHA * xf[8] + out[8], ALPHA * xf[9] + out[9]); r1.y = cvt_pk_bf16(ALPHA * xf[10] + out[10], ALPHA * xf[11] + out[11]);
        r1.z = cvt_pk_bf16(ALPHA * xf[12] + out[12], ALPHA * xf[13] + out[13]); r1.w = cvt_pk_bf16(ALPHA * xf[14] + out[14], ALPHA * xf[15] + out[15]);
        *(u32x4*)(R2 + (size_t)token * D + 16 * lane) = r0; *(u32x4*)(R2 + (size_t)token * D + 16 * lane + 8) = r1;
    }
    LDS_WAIT();
    }
}
struct AttnItems { unsigned short v[1024]; };
__host__ __device__ constexpr AttnItems make_attn_items() {
    AttnItems t{}; int n = 0;
    const int lim[4] = {11, 37, 64, 64};
    for (int c = 66; c >= 0; --c)
        for (int b = 0; b < 8; ++b) for (int h = 0; h < 4; ++h) for (int q = 0; q < 32; ++q) {
            int tiles = 2 * q + 2; if (tiles > lim[h]) tiles = lim[h];
            if (tiles + 2 == c) t.v[n++] = (unsigned short)((b << 7) | (h << 5) | q);
        }
    return t;
}
__device__ const AttnItems ATTN_ITEMS = make_attn_items();
struct AttnItems1 { unsigned char v[128]; };
__host__ __device__ constexpr AttnItems1 make_attn_items1() {
    AttnItems1 t{}; int n = 0;
    const int lim[4] = {11, 37, 64, 64};
    for (int c = 66; c >= 0; --c)
        for (int h = 0; h < 4; ++h) for (int q = 0; q < 32; ++q) {
            int tiles = 2 * q + 2; if (tiles > lim[h]) tiles = lim[h];
            if (tiles + 2 == c) t.v[n++] = (unsigned char)((h << 5) | q);
        }
    return t;
}
__device__ const AttnItems1 ATTN_ITEMS1 = make_attn_items1();
constexpr int PH_PER_LAYER = 10, N_PHASES = 1 + DEPTH * PH_PER_LAYER;
struct Args {
    const float *x, *p, *ln_in_g, *ln_in_b, *w_in, *w_out, *diff_lambda, *diff_subln_g, *ln1_g, *ln1_b, *peer_wq, *peer_subkeys, *peer_u, *peer_v, *ple_wg, *ple_bg, *ple_wp, *ln2_g, *ln2_b;
    float* out; unsigned char* ws; int ph_lo, ph_hi;
};
__global__ void __launch_bounds__(NTHREADS, 2) fwd_kernel(Args args) {
    extern __shared__ __attribute__((aligned(16))) unsigned char lds_raw[];
    Frame F;
    F.lds = (LAS unsigned char*)lds_raw;
    F.tid = threadIdx.x; F.lane = F.tid & 63; F.wave = __builtin_amdgcn_readfirstlane(F.tid >> 6);
    F.G = gridDim.x; F.wg = blockIdx.x; F.ws = args.ws;
    unsigned char* ws = args.ws;
    if (F.tid < 64) ((LAS unsigned*)(F.lds + LDS_CTL))[F.tid] = 0u;
    __syncthreads();
    const int lo = args.ph_lo, hi = args.ph_hi; (void)lo; (void)hi;
#ifndef PHASE_MASK
#define PHASE_MASK 0x7ff
#endif
#ifndef REPEAT_MASK
#define REPEAT_MASK 0
#endif
#define REP(k) (1 + ((REPEAT_MASK >> (k)) & 1))
#define IN(k) (lo <= (k) && (k) < hi)
#define BOTH(k) (IN(k) && IN((k) + 1))
#if MK_PER_PHASE
#define GRID_BAR(k) do { } while (0)
#define GRP_BAR(k) do { } while (0)
#define PAIR_BAR(k) do { } while (0)
#else
    XcdBarrier bar = xcd_barrier_post((unsigned*)(ws + WS_CTL) + 4096, (volatile LAS unsigned*)(F.lds + LDS_CTL));
    if (F.G == 256) group_post(bar, (unsigned)(F.wg & 7));
#define GRID_BAR(k) do { if (BOTH(k)) { unsigned z_ = 0u; asm volatile("" : "+s"(z_)); XcdBarrier b2_ = bar; b2_.bar = bar.bar + z_; asm volatile("" : "+s"(b2_.x)); xcd_barrier(b2_); } } while (0)
#define GRP_BAR(k) do { if (BOTH(k)) { unsigned z_ = 0u; asm volatile("" : "+s"(z_)); XcdBarrier b2_ = bar; b2_.bar = bar.bar + z_; asm volatile("" : "+s"(b2_.x)); \
        group_barrier(b2_, XB_GRP(F.G == 256 ? (unsigned)(F.wg & 7) : 0u), F.G == 256 ? 32u : (unsigned)F.G); } } while (0)
#define TILE_PM (16 * (F.wg & 7) + (F.wg >> 4))
#define TILE_PAR ((F.wg >> 3) & 1)
#define PAIR_BAR(k) do { if (BOTH(k)) { unsigned z_ = 0u; asm volatile("" : "+s"(z_)); XcdBarrier b2_ = bar; b2_.bar = bar.bar + z_; asm volatile("" : "+s"(b2_.x)); \
        if (F.G == 256) group_barrier(b2_, XB_PAIR((unsigned)(TILE_PM)), 2u, 4); else group_barrier(b2_, XB_GRP(0u), (unsigned)F.G); } } while (0)
#endif
    const int gw = F.wg * NWAVES + F.wave, NGW = F.G * NWAVES;
#define ROW_BASE (F.G == 256 ? 4096 * (F.wg & 7) + 8 * (F.wg >> 3) + F.wave : gw)
#define ROW_STRIDE (F.G == 256 ? 256 : NGW)
#define ROW_END (F.G == 256 ? 4096 * ((F.wg & 7) + 1) : T)
#define TROW_BASE (F.G == 256 ? 256 * (16 * (F.wg & 7) + (F.wg >> 4)) + 128 * ((F.wg >> 3) & 1) + F.wave : gw)
#define TROW_STRIDE (F.G == 256 ? 8 : NGW)
#define TROW_END (F.G == 256 ? 256 * (16 * (F.wg & 7) + (F.wg >> 4)) + 128 * ((F.wg >> 3) & 1) + 128 : T)
    typedef const __attribute__((address_space(4))) Args* kargs_t;
    const kargs_t kp0 = (kargs_t)__builtin_amdgcn_kernarg_segment_ptr();
#define PHASE_ARGS() kargs_t ap = kp0; asm volatile("" : "+s"(ap)); unsigned char* const wsl = ap->ws; (void)wsl
#define H ((bf16_t*)(wsl + WS_H))
#define H1 ((bf16_t*)(wsl + WS_H1))
#define MIX ((bf16_t*)(wsl + WS_MIX))
#define R2 ((bf16_t*)(wsl + WS_R2))
#define RF ((bf16_t*)(wsl + WS_RF))
#define DQ ((bf16_t*)(wsl + WS_DQ))
#define DK ((bf16_t*)(wsl + WS_DK))
#define DVT ((bf16_t*)(wsl + WS_DVT))
#define SQ ((bf16_t*)(wsl + WS_SQ))
#define SK ((bf16_t*)(wsl + WS_SK))
#define SVT ((bf16_t*)(wsl + WS_SVT))
#define IQ ((bf16_t*)(wsl + WS_IQ))
#define IK ((bf16_t*)(wsl + WS_IK))
#define IW ((float*)(wsl + WS_IW))
#define PQ ((bf16_t*)(wsl + WS_PQ))
#define EG ((int*)(wsl + WS_EG))
#define MASK ((u64*)(wsl + WS_MASK))
#define PP MIX

    if (((PHASE_MASK >> 0) & 1) && IN(0)) for (int rep_ = 0; rep_ < REP(0); ++rep_) {
        PHASE_ARGS();
        LAS float* scr = (LAS float*)(F.lds + LDS_A + F.wave * 8448);
        for (int l = 0; l < DEPTH; ++l) {
            const float* win = ap->w_in + (size_t)l * D * IN_COLS;
            bf16_t* WIN = (bf16_t*)(wsl + WS_WIN) + (size_t)l * NMAIN * D; bf16_t* WINV = (bf16_t*)(wsl + WS_WINV) + (size_t)l * NVV * D;
#define DO_SEG(sgi, W_, WT_, K_, ldn_, c0_, nvalid_, ncols_) do { const int nblk = (ncols_) / 32, items = ((K_) / 64) * nblk, rot = (l * 9 + (sgi)) * 397; \
                for (int it = (gw + rot) % NGW; it < items; it += NGW) transpose_item((W_), (K_), (ldn_), (c0_), (nvalid_), (WT_), scr, it / nblk, it % nblk, F.lane); } while (0)
            DO_SEG(0, win, WIN, D, IN_COLS, 0, 1024, 1024);
            DO_SEG(1, win, WIN + (size_t)1024 * D, D, IN_COLS, 1536, 1024, 1024);
            DO_SEG(2, win, WIN + (size_t)2048 * D, D, IN_COLS, 3072, 324, 512);
            DO_SEG(3, win, WINV, D, IN_COLS, 1024, 512, 512);
            DO_SEG(4, win, WINV + (size_t)512 * D, D, IN_COLS, 2560, 512, 512);
            DO_SEG(5, ap->w_out + (size_t)l * D * D, (bf16_t*)(wsl + WS_WOUT) + (size_t)l * D * D, D, D, 0, D, D);
            DO_SEG(6, ap->peer_wq + (size_t)l * D * 2048, (bf16_t*)(wsl + WS_WPQ) + (size_t)l * 2048 * D, D, 2048, 0, 2048, 2048);
            DO_SEG(7, ap->ple_wg + (size_t)l * D * D, (bf16_t*)(wsl + WS_WG) + (size_t)l * D * D, D, D, 0, D, D);
            DO_SEG(8, ap->ple_wp + (size_t)l * 256 * D, (bf16_t*)(wsl + WS_WP) + (size_t)l * D * 256, 256, D, 0, D, D);
#undef DO_SEG
        }
        const size_t gtid = (size_t)F.wg * NTHREADS + F.tid, gthreads = (size_t)F.G * NTHREADS;
        convert_rows_i4(ap->peer_u, ws + WS_U8, (float*)(wsl + WS_USC), DEPTH * 16384, gw, NGW, F.lane);
        convert_rows_fp4(ap->peer_v, ws + WS_V8, (float*)(wsl + WS_VSC), DEPTH * 16384, gw, NGW, F.lane);
        convert_f32_bf16(ap->p, (bf16_t*)(wsl + WS_P16), (size_t)DEPTH * T * 256, gtid, gthreads);
        convert_f32_bf16(ap->peer_subkeys, (bf16_t*)(wsl + WS_SUBK), (size_t)DEPTH * 8 * 2 * 128 * 128, gtid, gthreads);
        for (int m = ROW_BASE; m < ROW_END; m += ROW_STRIDE) ln_row(ap->x + (size_t)m * D, ap->ln_in_g, ap->ln_in_b, H + (size_t)m * D, nullptr, F.lane);
        __syncthreads();
    }
    GRID_BAR(0);
#if !MK_PER_PHASE
    if (F.G == 256 && BOTH(0)) group_resolve(bar, (unsigned)(F.wg & 7));
#endif

    for (int l = 0; l < DEPTH; ++l) {
        const int pb = 1 + PH_PER_LAYER * l;
        const float lam_init = 0.8f - 0.6f * expf(-0.3f * (float)l);
        if (((PHASE_MASK >> 1) & 1) && IN(pb + 0)) for (int rep_ = 0; rep_ < REP(1); ++rep_) { PHASE_ARGS();
            { pg8::Gemm g{H, (const bf16_t*)(wsl + WS_WIN) + (size_t)l * NMAIN * D, T, NMAIN, D}; pg8::StaticOrder S; S.init(T, NMAIN, F.G, F.wg);
              epi::Proj E{DQ, DK, SQ, SK, IQ, IK, IW};
              pg8::gemm_phase<epi::Proj, pg8::StaticOrder, true, true>(F.lds + LDS_A, g, S, E, WAVE_FRESH()); }
            { pg8::Gemm g{H, (const bf16_t*)(wsl + WS_WINV) + (size_t)l * NVV * D, T, NVV, D}; pg8::StaticOrder S; S.init(T, NVV, F.G, F.wg);
              epi::ProjV E{DVT, SVT};
              pg8::gemm_phase<epi::ProjV, pg8::StaticOrder, true, true>(F.lds + LDS_A, g, S, E, WAVE_FRESH()); }
        }
        GRP_BAR(pb + 0);
        if (((PHASE_MASK >> 2) & 1) && IN(pb + 1)) for (int rep_ = 0; rep_ < REP(2); ++rep_) { PHASE_ARGS();
            for (int g = F.wg; g < 256; g += F.G) {
                const int kb_ = g & 7, pr = g >> 3, h16 = pr >> 1, hf = pr & 1;
                const bf16_t* Kt = (h16 < 8 ? DK : SK) + ((size_t)((kb_ * 8 + (h16 & 7)) * 4096 + hf * 2048)) * 64;
                knorm_item(F, Kt, (float*)(wsl + WS_KN) + ((kb_ * 16 + h16) * 2 + hf));
            }
            for (int g = F.wg; g < 256; g += F.G) {
                const int b = g & 7, j = g >> 3;
#pragma unroll 1
                for (int k = 0; k < 2; ++k) select_item(F, b, k ? j : 63 - j, IQ, IK, IW, MASK);
            }
        }
        GRP_BAR(pb + 1);
        if (((PHASE_MASK >> 3) & 1) && IN(pb + 2)) for (int rep_ = 0; rep_ < REP(3); ++rep_) { PHASE_ARGS();
            LAS float* lamw = (LAS float*)(F.lds + LDS_B + 8192);
            if (F.wave == 0) {
                const float* lv = ap->diff_lambda + (size_t)l * 256; const int ln = lane_id_fresh();
                const float s01 = wave_sum(lv[ln] * lv[64 + ln]), s23 = wave_sum(lv[128 + ln] * lv[192 + ln]);
                if (ln == 0) lamw[0] = expf(s01) - expf(s23) + lam_init;
            }
            __syncthreads();
            const float lam = lamw[0];
            const float* sg = ap->diff_subln_g + (size_t)l * 128;
#ifdef ATTN_GLOBAL_DEAL
            for (int r = 0; r < 4; ++r) {
                for (int g = F.wg; g < 256; g += F.G) {
                    const int itm = ATTN_ITEMS.v[256 * r + ((r & 1) ? 255 - g : g)];
                    attn_item<false>(F, itm >> 7, (itm >> 5) & 3, itm & 31, DQ, DK, DVT, nullptr, MIX, lam, lam_init, sg, (const float*)(wsl + WS_KN));
                }
            }
            for (int r = 0; r < 4; ++r) {
                for (int g = F.wg; g < 256; g += F.G) {
                    const int itm = ATTN_ITEMS.v[256 * r + ((r & 1) ? 255 - g : g)];
                    attn_item<true>(F, itm >> 7, (itm >> 5) & 3, itm & 31, SQ, SK, SVT, MASK, MIX, 0.f, 0.f, nullptr, (const float*)(wsl + WS_KN));
                }
            }
#else
            for (int r = 0; r < 4; ++r) {
                for (int g = F.wg; g < 256; g += F.G) {
                    const int xb = g & 7, c = g >> 3, itm = ATTN_ITEMS1.v[32 * r + ((r & 1) ? 31 - c : c)];
                    attn_item<false>(F, xb, itm >> 5, itm & 31, DQ, DK, DVT, nullptr, MIX, lam, lam_init, sg, (const float*)(wsl + WS_KN));
                }
            }
            for (int r = 0; r < 4; ++r) {
                for (int g = F.wg; g < 256; g += F.G) {
                    const int xb = g & 7, c = g >> 3, itm = ATTN_ITEMS1.v[32 * r + ((r & 1) ? 31 - c : c)];
                    attn_item<true>(F, xb, itm >> 5, itm & 31, SQ, SK, SVT, MASK, MIX, 0.f, 0.f, nullptr, (const float*)(wsl + WS_KN));
                }
            }
#endif
        }
        GRP_BAR(pb + 2);
        if (((PHASE_MASK >> 4) & 1) && IN(pb + 3)) for (int rep_ = 0; rep_ < REP(4); ++rep_) { PHASE_ARGS();
            pg8::Gemm g{MIX, (const bf16_t*)(wsl + WS_WOUT) + (size_t)l * D * D, T, D, D}; pg8::StaticOrder S; if (F.G == 256) S.init_tile(D, TILE_PM, TILE_PAR); else S.init(T, D, F.G, F.wg);
            epi::OutRes E{H, RF};
            pg8::gemm_phase<epi::OutRes, pg8::StaticOrder, true, true>(F.lds + LDS_A, g, S, E, WAVE_FRESH());
        }
        PAIR_BAR(pb + 3);
        if (((PHASE_MASK >> 5) & 1) && IN(pb + 4)) for (int rep_ = 0; rep_ < REP(5); ++rep_) { PHASE_ARGS();
            ln_rows_bf(RF, ap->ln1_g + (size_t)l * D, ap->ln1_b + (size_t)l * D, H1, nullptr, TROW_BASE, TROW_STRIDE, TROW_END, lane_id_fresh());
        }
        PAIR_BAR(pb + 4);
        if (((PHASE_MASK >> 6) & 1) && IN(pb + 5)) for (int rep_ = 0; rep_ < REP(6); ++rep_) { PHASE_ARGS();
            pg8::Gemm g{H1, (const bf16_t*)(wsl + WS_WPQ) + (size_t)l * 2048 * D, T, 2048, D}; pg8::StaticOrder S; if (F.G == 256) S.init_tile(2048, TILE_PM, TILE_PAR); else S.init(T, 2048, F.G, F.wg);
            epi::PlainBf16 E{PQ, 512, 1, 1, (unsigned)PQ_PLANE};
            pg8::gemm_phase<epi::PlainBf16, pg8::StaticOrder, true, true>(F.lds + LDS_A, g, S, E, WAVE_FRESH());
        }
        PAIR_BAR(pb + 5);
        if (((PHASE_MASK >> 7) & 1) && IN(pb + 6)) for (int rep_ = 0; rep_ < REP(7); ++rep_) { PHASE_ARGS(); peer_topk_phase(F, PQ, (const bf16_t*)(wsl + WS_SUBK) + (size_t)l * 8 * 2 * 128 * 128, EG); }
        PAIR_BAR(pb + 6);
        if (((PHASE_MASK >> 8) & 1) && IN(pb + 7)) for (int rep_ = 0; rep_ < REP(8); ++rep_) { PHASE_ARGS(); peer_gather_phase(F, H1, EG, ws + WS_U8 + (size_t)l * 16384 * 512, ws + WS_V8 + (size_t)l * 16384 * 512, (const float*)(wsl + WS_USC) + (size_t)l * 16384, (const float*)(wsl + WS_VSC) + (size_t)l * 16384, R2); }
        PAIR_BAR(pb + 7);
        if (((PHASE_MASK >> 9) & 1) && IN(pb + 8)) for (int rep_ = 0; rep_ < REP(9); ++rep_) { PHASE_ARGS();
            { pg8::Gemm g{(const bf16_t*)(wsl + WS_P16) + (size_t)l * T * 256, (const bf16_t*)(wsl + WS_WP) + (size_t)l * D * 256, T, D, 256}; pg8::StaticOrder S; if (F.G == 256) S.init_tile(D, TILE_PM, TILE_PAR); else S.init(T, D, F.G, F.wg);
              epi::PlainBf16 E{PP, D, 8, 255, 0u};
              pg8::gemm_phase<epi::PlainBf16, pg8::StaticOrder, true, true>(F.lds + LDS_A, g, S, E, WAVE_FRESH()); }
            VM_WAIT(); __syncthreads();
            { pg8::Gemm g{R2, (const bf16_t*)(wsl + WS_WG) + (size_t)l * D * D, T, D, D}; pg8::StaticOrder S; if (F.G == 256) S.init_tile(D, TILE_PM, TILE_PAR); else S.init(T, D, F.G, F.wg);
              epi::Gate E{R2, PP, ap->ple_bg + (size_t)l * D, RF};
              pg8::gemm_phase<epi::Gate, pg8::StaticOrder, true, true>(F.lds + LDS_A, g, S, E, WAVE_FRESH()); }
        }
        PAIR_BAR(pb + 8);
        if (((PHASE_MASK >> 10) & 1) && IN(pb + 9)) for (int rep_ = 0; rep_ < REP(10); ++rep_) { PHASE_ARGS();
            const bool last = (l == DEPTH - 1);
            ln_rows_bf(RF, ap->ln2_g + (size_t)l * D, ap->ln2_b + (size_t)l * D, last ? nullptr : H, last ? ap->out : nullptr, TROW_BASE, TROW_STRIDE, TROW_END, lane_id_fresh());
        }
        if (l + 1 < DEPTH) GRP_BAR(pb + 9);
    }
#undef IN
#undef BOTH
#undef H
#undef H1
#undef MIX
#undef R2
#undef RF
#undef DQ
#undef DK
#undef DVT
#undef SQ
#undef SK
#undef SVT
#undef IQ
#undef IK
#undef IW
#undef PQ
#undef EG
#undef MASK
#undef PP
}

extern "C" void kernel_launch(void* const* d_in, const int* in_sizes, int n_in, void* d_out, int out_size, void* d_ws, size_t ws_size, hipStream_t stream) {
    static int grid = 0;
    if (grid == 0) {
        if (n_in != 19 || in_sizes[0] != T * D || out_size != T * D || ws_size < WS_END) {
            fprintf(stderr, "kernel_launch: unexpected problem: n_in %d in0 %d out %d ws %zu (need %zu); nothing launched\n", n_in, n_in > 0 ? in_sizes[0] : -1, out_size, ws_size, (size_t)WS_END); grid = -1; return; }
        int dev = 0, cus = 0, per_cu = 0;
        if (hipGetDevice(&dev) != hipSuccess || hipDeviceGetAttribute(&cus, hipDeviceAttributeMultiprocessorCount, dev) != hipSuccess) { fprintf(stderr, "kernel_launch: device query failed\n"); grid = -1; return; }
        if (hipFuncSetAttribute((const void*)fwd_kernel, hipFuncAttributeMaxDynamicSharedMemorySize, LDS_BYTES) != hipSuccess) { fprintf(stderr, "kernel_launch: hipFuncSetAttribute failed\n"); grid = -1; return; }
        if (hipOccupancyMaxActiveBlocksPerMultiprocessor(&per_cu, (const void*)fwd_kernel, NTHREADS, LDS_BYTES) != hipSuccess || per_cu < 1) { fprintf(stderr, "kernel_launch: occupancy query says %d blocks per CU\n", per_cu); }
        (void)hipGetLastError();
        grid = cus < 256 ? cus : 256;
    }
    if (grid < 0) return;
    if (hipMemsetAsync((char*)d_ws + WS_CTL, 0, CTL_ZERO_BYTES, stream) != hipSuccess) { fprintf(stderr, "kernel_launch: memset failed\n"); return; }
    Args a{};
    a.x = (const float*)d_in[0]; a.p = (const float*)d_in[1]; a.ln_in_g = (const float*)d_in[2]; a.ln_in_b = (const float*)d_in[3]; a.w_in = (const float*)d_in[4]; a.w_out = (const float*)d_in[5];
    a.diff_lambda = (const float*)d_in[6]; a.diff_subln_g = (const float*)d_in[7]; a.ln1_g = (const float*)d_in[8]; a.ln1_b = (const float*)d_in[9]; a.peer_wq = (const float*)d_in[10];
    a.peer_subkeys = (const float*)d_in[11]; a.peer_u = (const float*)d_in[12]; a.peer_v = (const float*)d_in[13]; a.ple_wg = (const float*)d_in[14]; a.ple_bg = (const float*)d_in[15];
    a.ple_wp = (const float*)d_in[16]; a.ln2_g = (const float*)d_in[17]; a.ln2_b = (const float*)d_in[18];
    a.out = (float*)d_out; a.ws = (unsigned char*)d_ws;
#if MK_PER_PHASE
    for (int ph = 0; ph < N_PHASES; ++ph) { a.ph_lo = ph; a.ph_hi = ph + 1; hipLaunchKernelGGL(fwd_kernel, dim3(grid), dim3(NTHREADS), LDS_BYTES, stream, a); }
#else
    a.ph_lo = 0; a.ph_hi = N_PHASES;
    hipLaunchKernelGGL(fwd_kernel, dim3(grid), dim3(NTHREADS), LDS_BYTES, stream, a);
#endif
    const hipError_t le = hipPeekAtLastError();
    if (le != hipSuccess) fprintf(stderr, "kernel_launch: launch failed: %s\n", hipGetErrorName(le));
}
```
